# Optimizing an MI355X kernel written in HIP

```python
import math
import jax
import jax.numpy as jnp
from jax import lax
import numpy as np

D_MODEL = 1024
BATCH = 4
SEQ = 8192
DEPTH = 1

CHUNK = 64
Q_BLOCK = 128
ROPE_THETA = 10000.0
NORM_EPS = 1e-6

DA_HEADS = 8
DA_HEAD_DIM = 64
DA_V_DIM = 2 * DA_HEAD_DIM
DA_QK_WIDTH = DA_HEADS * 2 * DA_HEAD_DIM
DA_V_WIDTH = DA_HEADS * DA_V_DIM

ML_HEADS = 4
ML_INNER = 2 * D_MODEL
ML_HEAD_DIM = ML_INNER // ML_HEADS
ML_CONV = 4
ML_QKV_BLOCK = 4

MEM_LEN = 256
CA_HEADS = 4
CA_HEAD_DIM = D_MODEL // CA_HEADS
CA_WIDTH = CA_HEADS * CA_HEAD_DIM

N_BRANCH = 3
IN_SIZES = (DA_QK_WIDTH, DA_QK_WIDTH, DA_V_WIDTH, ML_INNER, ML_INNER, CA_WIDTH, N_BRANCH * D_MODEL)
IN_WIDTH = DA_QK_WIDTH * 2 + DA_V_WIDTH + ML_INNER * 2 + CA_WIDTH + N_BRANCH * D_MODEL

N_EXPERTS = 32
TOP_K = 4
D_FF = D_MODEL
SWIGLU_LIMIT = 7.0
SWIGLU_ALPHA = 1.702

kernel_name = 'hybrid_diffattn_mlstm_memxattn_moe_block'


def rms_norm(x, g):
    xf = x.astype(jnp.float32)
    y = xf * lax.rsqrt(jnp.mean(xf * xf, axis=-1, keepdims=True) + NORM_EPS)
    return (y * g.astype(jnp.float32)).astype(x.dtype)


def rope(x, pos):
    d = x.shape[-1]
    half = d // 2
    inv = ROPE_THETA ** (-(jnp.arange(half, dtype=jnp.float32) * 2.0 / d))
    ang = pos.astype(jnp.float32)[:, None] * inv[None, :]
    cos, sin = jnp.cos(ang), jnp.sin(ang)
    xf = x.astype(jnp.float32)
    x1, x2 = xf[..., :half], xf[..., half:]
    out = jnp.concatenate([x1 * cos - x2 * sin, x2 * cos + x1 * sin], axis=-1)
    return out.astype(x.dtype)


def split_cols(t, sizes):
    outs, off = [], 0
    for s in sizes:
        outs.append(t[..., off:off + s])
        off += s
    return outs


def diff_attention(q, k, v, q_g, k_g, lq1, lk1, lq2, lk2, sub_g, lambda_init):
    B, S = q.shape[0], q.shape[1]
    pos = jnp.arange(S)
    q = rope(jnp.transpose(rms_norm(q, q_g), (0, 2, 3, 1, 4)), pos)
    k = rope(jnp.transpose(rms_norm(k, k_g), (0, 2, 3, 1, 4)), pos)
    v = jnp.transpose(v, (0, 2, 1, 3))
    f32 = jnp.float32
    lam = (jnp.exp(jnp.sum(lq1.astype(f32) * lk1.astype(f32)))
           - jnp.exp(jnp.sum(lq2.astype(f32) * lk2.astype(f32))) + lambda_init)
    n_blocks = S // Q_BLOCK
    qb = jnp.moveaxis(q.reshape(B, DA_HEADS, 2, n_blocks, Q_BLOCK, DA_HEAD_DIM), 3, 0)
    key_chunk = jnp.arange(S) // CHUNK
    scale = DA_HEAD_DIM ** -0.5

    def one_block(args):
        q_blk, blk = args
        q_chunk = (blk * Q_BLOCK + jnp.arange(Q_BLOCK)) // CHUNK
        allowed = key_chunk[None, :] <= q_chunk[:, None]
        s = jnp.einsum('bhcqd,bhckd->bhcqk', q_blk, k, preferred_element_type=f32) * scale
        p = jax.nn.softmax(jnp.where(allowed, s, -jnp.inf), axis=-1)
        a = p[:, :, 0] - lam * p[:, :, 1]
        return jnp.einsum('bhqk,bhkv->bhqv', a.astype(v.dtype), v)

    o = lax.map(one_block, (qb, jnp.arange(n_blocks)))
    o = jnp.moveaxis(o, 0, 2).reshape(B, DA_HEADS, S, DA_V_DIM).transpose(0, 2, 1, 3)
    o = rms_norm(o, sub_g) * (1.0 - lambda_init)
    return o.reshape(B, S, DA_V_WIDTH)


def causal_conv(x, w, b):
    K, C = w.shape
    y = lax.conv_general_dilated(x, w[:, None, :].astype(x.dtype), window_strides=(1,),
                                 padding=[(K - 1, 0)], dimension_numbers=('NWC', 'WIO', 'NWC'),
                                 feature_group_count=C)
    return y + b


def blockdiag(x, w):
    B, S, C = x.shape
    nb, bs, _ = w.shape
    return jnp.einsum('bsni,nio->bsno', x.reshape(B, S, nb, bs), w).reshape(B, S, C)


def mlstm_chunkwise(q, k, v, i_pre, f_pre):
    B, H, S, d = q.shape
    L = CHUNK
    NC = S // L

    def to_chunks(t):
        return jnp.moveaxis(t.reshape((B, H, NC, L) + t.shape[3:]), 2, 0)

    qc, kc, vc = to_chunks(q), to_chunks(k), to_chunks(v)
    ic = to_chunks(i_pre)
    bc = jnp.cumsum(to_chunks(jax.nn.log_sigmoid(f_pre)), axis=-1)
    causal = jnp.tril(jnp.ones((L, L), dtype=bool))

    def step(carry, inp):
        C, n, m = carry
        qt, kt, vt, it, bt = inp
        dlog = jnp.where(causal, bt[..., :, None] - bt[..., None, :] + it[..., None, :], -jnp.inf)
        inter_log = bt + m[..., None]
        m_row = jnp.maximum(inter_log, jnp.max(dlog, axis=-1))
        dw = jnp.exp(dlog - m_row[..., None])
        inter_w = jnp.exp(inter_log - m_row)
        s = jnp.einsum('bhld,bhsd->bhls', qt, kt) * dw
        num = jnp.einsum('bhls,bhsd->bhld', s, vt) + inter_w[..., None] * jnp.einsum('bhld,bhde->bhle', qt, C)
        den = jnp.sum(s, axis=-1) + inter_w * jnp.einsum('bhld,bhd->bhl', qt, n)
        h = num / jnp.maximum(jnp.abs(den), jnp.exp(-m_row))[..., None]
        b_last = bt[..., -1]
        state_log = b_last[..., None] - bt + it
        m_new = jnp.maximum(b_last + m, jnp.max(state_log, axis=-1))
        decay = jnp.exp(b_last + m - m_new)
        ws = jnp.exp(state_log - m_new[..., None])
        C_new = decay[..., None, None] * C + jnp.einsum('bhs,bhsd,bhse->bhde', ws, kt, vt)
        n_new = decay[..., None] * n + jnp.einsum('bhs,bhsd->bhd', ws, kt)
        return (C_new, n_new, m_new), h

    init = (jnp.zeros((B, H, d, d), jnp.float32), jnp.zeros((B, H, d), jnp.float32),
            jnp.zeros((B, H), jnp.float32))
    _, hs = lax.scan(step, init, (qc, kc, vc, ic, bc))
    return jnp.moveaxis(hs, 0, 2).reshape(B, H, S, d)


def mlstm_branch(x_m, z, conv_w, conv_b, wq, wk, wv, w_if, b_if, norm_g, skip):
    B, S, _ = x_m.shape
    x_c = jax.nn.silu(causal_conv(x_m, conv_w, conv_b))
    q = blockdiag(x_c, wq)
    k = blockdiag(x_c, wk)
    v = blockdiag(x_m, wv)
    gates = (jnp.concatenate([q, k, v], axis=-1) @ w_if + b_if).astype(jnp.float32)
    i_pre = jnp.transpose(gates[..., :ML_HEADS], (0, 2, 1))
    f_pre = jnp.transpose(gates[..., ML_HEADS:], (0, 2, 1))

    def heads(t):
        return t.reshape(B, S, ML_HEADS, ML_HEAD_DIM).transpose(0, 2, 1, 3).astype(jnp.float32)

    hh = mlstm_chunkwise(heads(q), heads(k) * (ML_HEAD_DIM ** -0.5), heads(v), i_pre, f_pre)
    mu = jnp.mean(hh, axis=-1, keepdims=True)
    var = jnp.mean(jnp.square(hh - mu), axis=-1, keepdims=True)
    hh = (hh - mu) * lax.rsqrt(var + NORM_EPS)
    hh = hh.transpose(0, 2, 1, 3).reshape(B, S, ML_INNER) * norm_g.astype(jnp.float32)
    return (hh.astype(x_m.dtype) + skip * x_c) * jax.nn.silu(z)


def memory_cross_attention(q, mem, mem_g, w_kv, q_g, k_g):
    B, S = q.shape[0], q.shape[1]
    M = mem.shape[1]
    q = rms_norm(q.reshape(B, S, CA_HEADS, CA_HEAD_DIM), q_g)
    kv = rms_norm(mem, mem_g) @ w_kv
    k = rms_norm(kv[..., :CA_WIDTH].reshape(B, M, CA_HEADS, CA_HEAD_DIM), k_g)
    v = kv[..., CA_WIDTH:].reshape(B, M, CA_HEADS, CA_HEAD_DIM)
    s = jnp.einsum('bshd,bmhd->bhsm', q, k, preferred_element_type=jnp.float32) * (CA_HEAD_DIM ** -0.5)
    p = jax.nn.softmax(s, axis=-1)
    o = jnp.einsum('bhsm,bmhd->bshd', p.astype(v.dtype), v)
    return o.reshape(B, S, CA_WIDTH)


def moe_ffn(xn, router_w, router_b, w_gate_up, b_gate_up, w_down, b_down):
    B, S, D = xn.shape
    T = B * S
    xt = xn.reshape(T, D)
    logits = (xt @ router_w).astype(jnp.float32) + router_b.astype(jnp.float32)
    top_v, top_i = lax.top_k(logits, TOP_K)
    top_w = jax.nn.softmax(top_v, axis=-1)
    e_flat = top_i.reshape(-1)
    order = jnp.argsort(e_flat)
    e_sorted = e_flat[order]
    tok = order // TOP_K
    group_sizes = jnp.bincount(e_flat, length=N_EXPERTS).astype(jnp.int32)
    xs = xt[tok]
    h = lax.ragged_dot(xs, w_gate_up, group_sizes) + b_gate_up[e_sorted]
    gate, up = h[:, :D_FF], h[:, D_FF:]
    gate = jnp.minimum(gate, SWIGLU_LIMIT)
    up = jnp.clip(up, -SWIGLU_LIMIT, SWIGLU_LIMIT)
    a = (up + 1.0) * (gate * jax.nn.sigmoid(SWIGLU_ALPHA * gate))
    y = lax.ragged_dot(a, w_down, group_sizes) + b_down[e_sorted]
    y = y * top_w.reshape(-1)[order][:, None].astype(y.dtype)
    out = jax.ops.segment_sum(y, tok, num_segments=T)
    return out.reshape(B, S, D)


def setup_inputs(seed: int = 0) -> dict:
    key = jax.random.key(seed)
    ks = iter(jax.random.split(key, 40))
    Ld = DEPTH

    def nrm(shape, scale):
        return jax.random.normal(next(ks), shape, jnp.float32) * scale

    def gain(shape):
        return 1.0 + nrm(shape, 0.02)

    inp = {}
    inp['x'] = nrm((BATCH, SEQ, D_MODEL), 1.0)
    inp['mem'] = nrm((BATCH, MEM_LEN, D_MODEL), 1.0)
    inp['attn_norm_g'] = gain((Ld, D_MODEL))
    inp['w_in'] = nrm((Ld, D_MODEL, IN_WIDTH), D_MODEL ** -0.5)
    inp['b_gate'] = nrm((Ld, N_BRANCH * D_MODEL), 0.02)
    inp['da_q_norm_g'] = gain((Ld, DA_HEAD_DIM))
    inp['da_k_norm_g'] = gain((Ld, DA_HEAD_DIM))
    inp['da_lambda_q1'] = nrm((Ld, DA_HEAD_DIM), 0.1)
    inp['da_lambda_k1'] = nrm((Ld, DA_HEAD_DIM), 0.1)
    inp['da_lambda_q2'] = nrm((Ld, DA_HEAD_DIM), 0.1)
    inp['da_lambda_k2'] = nrm((Ld, DA_HEAD_DIM), 0.1)
    inp['da_subln_g'] = gain((Ld, DA_V_DIM))
    inp['ml_conv_w'] = nrm((Ld, ML_CONV, ML_INNER), ML_CONV ** -0.5)
    inp['ml_conv_b'] = nrm((Ld, ML_INNER), 0.02)
    nb = ML_INNER // ML_QKV_BLOCK
    inp['ml_wq'] = nrm((Ld, nb, ML_QKV_BLOCK, ML_QKV_BLOCK), ML_QKV_BLOCK ** -0.5)
    inp['ml_wk'] = nrm((Ld, nb, ML_QKV_BLOCK, ML_QKV_BLOCK), ML_QKV_BLOCK ** -0.5)
    inp['ml_wv'] = nrm((Ld, nb, ML_QKV_BLOCK, ML_QKV_BLOCK), ML_QKV_BLOCK ** -0.5)
    inp['ml_w_if'] = nrm((Ld, 3 * ML_INNER, 2 * ML_HEADS), (3 * ML_INNER) ** -0.5)
    inp['ml_b_if'] = jnp.concatenate(
        [nrm((Ld, ML_HEADS), 0.01),
         jnp.linspace(3.0, 6.0, ML_HEADS, dtype=jnp.float32)[None, :] + nrm((Ld, ML_HEADS), 0.01)], axis=-1)
    inp['ml_out_norm_g'] = gain((Ld, ML_INNER))
    inp['ml_skip'] = gain((Ld, ML_INNER))
    inp['mem_norm_g'] = gain((Ld, D_MODEL))
    inp['ca_w_kv'] = nrm((Ld, D_MODEL, 2 * CA_WIDTH), D_MODEL ** -0.5)
    inp['ca_q_norm_g'] = gain((Ld, CA_HEAD_DIM))
    inp['ca_k_norm_g'] = gain((Ld, CA_HEAD_DIM))
    inp['w_branch_da'] = nrm((Ld, DA_V_WIDTH, D_MODEL), DA_V_WIDTH ** -0.5)
    inp['w_branch_ml'] = nrm((Ld, ML_INNER, D_MODEL), ML_INNER ** -0.5)
    inp['w_branch_ca'] = nrm((Ld, CA_WIDTH, D_MODEL), CA_WIDTH ** -0.5)
    inp['w_out'] = nrm((Ld, D_MODEL, D_MODEL), D_MODEL ** -0.5)
    inp['ffn_norm_g'] = gain((Ld, D_MODEL))
    inp['router_w'] = nrm((Ld, D_MODEL, N_EXPERTS), D_MODEL ** -0.5)
    inp['router_b'] = nrm((Ld, N_EXPERTS), 0.01)
    inp['w_gate_up'] = nrm((Ld, N_EXPERTS, D_MODEL, 2 * D_FF), D_MODEL ** -0.5)
    inp['b_gate_up'] = nrm((Ld, N_EXPERTS, 2 * D_FF), 0.02)
    inp['w_down'] = nrm((Ld, N_EXPERTS, D_FF, D_MODEL), D_FF ** -0.5)
    inp['b_down'] = nrm((Ld, N_EXPERTS, D_MODEL), 0.02)
    return inp


def reference(x, mem, attn_norm_g, w_in, b_gate, da_q_norm_g, da_k_norm_g, da_lambda_q1, da_lambda_k1,
              da_lambda_q2, da_lambda_k2, da_subln_g, ml_conv_w, ml_conv_b, ml_wq, ml_wk, ml_wv, ml_w_if,
              ml_b_if, ml_out_norm_g, ml_skip, mem_norm_g, ca_w_kv, ca_q_norm_g, ca_k_norm_g, w_branch_da,
              w_branch_ml, w_branch_ca, w_out, ffn_norm_g, router_w, router_b, w_gate_up, b_gate_up, w_down,
              b_down):
    B, S, D = x.shape
    h = x
    for l in range(DEPTH):
        lambda_init = 0.8 - 0.6 * math.exp(-0.3 * l)
        xn = rms_norm(h, attn_norm_g[l])
        proj = xn @ w_in[l]
        da_q, da_k, da_v, ml_x, ml_z, ca_q, gate_pre = split_cols(proj, IN_SIZES)
        y_da = diff_attention(da_q.reshape(B, S, DA_HEADS, 2, DA_HEAD_DIM),
                              da_k.reshape(B, S, DA_HEADS, 2, DA_HEAD_DIM),
                              da_v.reshape(B, S, DA_HEADS, DA_V_DIM),
                              da_q_norm_g[l], da_k_norm_g[l], da_lambda_q1[l], da_lambda_k1[l],
                              da_lambda_q2[l], da_lambda_k2[l], da_subln_g[l], lambda_init)
        y_ml = mlstm_branch(ml_x, ml_z, ml_conv_w[l], ml_conv_b[l], ml_wq[l], ml_wk[l], ml_wv[l],
                            ml_w_if[l], ml_b_if[l], ml_out_norm_g[l], ml_skip[l])
        y_ca = memory_cross_attention(ca_q, mem, mem_norm_g[l], ca_w_kv[l], ca_q_norm_g[l], ca_k_norm_g[l])
        g = jax.nn.sigmoid((gate_pre + b_gate[l]).astype(jnp.float32)).astype(h.dtype)
        g = g.reshape(B, S, N_BRANCH, D)
        mix = (g[:, :, 0] * (y_da @ w_branch_da[l])
               + g[:, :, 1] * (y_ml @ w_branch_ml[l])
               + g[:, :, 2] * (y_ca @ w_branch_ca[l]))
        h = h + mix @ w_out[l]
        h = h + moe_ffn(rms_norm(h, ffn_norm_g[l]), router_w[l], router_b[l], w_gate_up[l], b_gate_up[l],
                        w_down[l], b_down[l])
    return h
```

```cpp
#include <hip/hip_runtime.h>
#include <hip/hip_bf16.h>
#include <cstdio>
#include <cstdint>
#include <cmath>

#ifndef QNORM_IN_ATTN
#define QNORM_IN_ATTN 1
#endif
#ifndef CAQ_FOLD
#define CAQ_FOLD 1
#endif
#ifndef KNORM_FOLD
#define KNORM_FOLD 1
#endif
#ifndef KNORM_EPI_OFF
#define KNORM_EPI_OFF 0
#endif
#ifndef ALIGN_MID
#define ALIGN_MID 0
#endif
namespace pg8 {
#define PG8_LAS __attribute__((address_space(3)))
typedef unsigned short bf16_t;
typedef short bf16x8 __attribute__((ext_vector_type(8)));
typedef float f32x4 __attribute__((ext_vector_type(4)));
typedef unsigned u32x4 __attribute__((ext_vector_type(4)));
typedef unsigned u32x2 __attribute__((ext_vector_type(2)));
constexpr int BM = 256, BK = 64, HALF = 128, HTB = HALF * BK * 2, STAGE_BYTES = 8 * HTB;

__host__ __device__ __forceinline__ int lds_byte(int r, int c) { const int st = (r >> 4) * 2 + (c >> 5), rr = r & 15, cc = c & 31, ob = rr * 64 + cc * 2; return st * 1024 + (ob ^ (((ob >> 9) & 1) << 5)); }
__host__ __device__ __forceinline__ void stage_rc(int b, int& R, int& C) { const int st = b / 1024, sb = b % 1024, swz = sb ^ (((sb >> 9) & 1) << 5); R = (st >> 1) * 16 + swz / 64; C = (st & 1) * 32 + (swz % 64) / 2; }
__host__ __device__ __forceinline__ int perm32(int rho) { const int n = rho >> 4, i = rho & 15; return 8 * (i >> 2) + 4 * n + (i & 3); }

struct Unit { int pm, pn, z; };
typedef int v8i32 __attribute__((ext_vector_type(8))); typedef int v4i32 __attribute__((ext_vector_type(4)));
__device__ __forceinline__ v8i32 cat8(bf16x8 lo, bf16x8 hi) { const v4i32 a = __builtin_bit_cast(v4i32, lo), b = __builtin_bit_cast(v4i32, hi); return __builtin_shufflevector(a, b, 0, 1, 2, 3, 4, 5, 6, 7); }
struct UP { const char* a; const char* b; const char* a2; const char* b2; const char* a3; const char* b3; };

__device__ __forceinline__ unsigned cvt_pk_bf16(float lo, float hi) { unsigned r; asm volatile("v_cvt_pk_bf16_f32 %0, %1, %2" : "=v"(r) : "v"(lo), "v"(hi)); return r; }
__device__ __forceinline__ void st8(bf16_t* p, f32x4 v0, f32x4 v1) { u32x4 w; w.x = cvt_pk_bf16(v0[0], v0[1]); w.y = cvt_pk_bf16(v0[2], v0[3]); w.z = cvt_pk_bf16(v1[0], v1[1]); w.w = cvt_pk_bf16(v1[2], v1[3]); *(u32x4*)p = w; }

struct GridOrder {
    int nM, nN, nwg, G, c;
    __device__ __forceinline__ void init(int nM_, int nN_, int G_, int c_) { nM = nM_; nN = nN_; nwg = nM * nN; G = G_; c = c_; }
    __device__ __forceinline__ bool map(int i, int& pm, int& pn) const {
        const long L = (long)i * G + c; if (L >= nwg) return false;
        int wgid = (int)L; { const int q = nwg / 8, r = nwg % 8, xcd = wgid % 8, off = wgid / 8; wgid = (xcd < r ? xcd * (q + 1) : r * (q + 1) + (xcd - r) * q) + off; }
        const int nig = 8 * nN, gid = wgid / nig, fm = gid * 8, gsz = (nM - fm) < 8 ? (nM - fm) : 8;
        pm = fm + ((wgid % nig) % gsz); pn = (wgid % nig) / gsz; return true;
    }
};

template <class Epi, class Sched, bool ALIGN_EPI>
__device__ __forceinline__ void gemm_phase(PG8_LAS unsigned char* lds, const Sched& S, const Epi& E) {
    int tid_ = threadIdx.x; asm volatile("" : "+v"(tid_));
    const int tid = tid_, wid = __builtin_amdgcn_readfirstlane(tid >> 6), lane = tid & 63, wr = wid >> 2, wc = wid & 3, fr = lane & 15, fq = lane >> 4;
    constexpr int NSEG = Sched::NSEG; constexpr bool SEG2 = NSEG >= 2, SEG3 = NSEG >= 3, GATHER = Sched::GATHER; constexpr int ESZ = Sched::ESZ;
    int nt2_ = S.nt; if constexpr (SEG3) nt2_ = S.nt2;
    int nt = S.nt; const int nt1 = SEG2 ? S.nt1 : S.nt, nt2 = nt2_;
    int Rr[2], Cc[2], Rb[2];
#pragma unroll
    for (int i = 0; i < 2; ++i) { stage_rc(tid * 16 + i * 8192, Rr[i], Cc[i]); Rb[i] = Epi::PERM ? ((Rr[i] & ~31) + perm32(Rr[i] & 31)) : Rr[i]; }
    unsigned voffA[2], voffB[2], voffA2[2], voffB2[2];
#pragma unroll
    for (int i = 0; i < 2; ++i) { voffA[i] = (unsigned)(Rr[i] * S.lda * ESZ + Cc[i] * 2); voffB[i] = (unsigned)(Rb[i] * S.ldb * ESZ + Cc[i] * 2);
        voffA2[i] = SEG2 ? (unsigned)(Rr[i] * S.lda2 * ESZ + Cc[i] * 2) : 0u; voffB2[i] = SEG2 ? (unsigned)(Rb[i] * S.ldb2 * ESZ + Cc[i] * 2) : 0u; }
    const size_t hsA = GATHER ? 0 : (size_t)HALF * S.lda * ESZ, hsB = (size_t)HALF * S.ldb * ESZ, hsA2 = SEG2 ? (size_t)HALF * S.lda2 * ESZ : 0, hsB2 = SEG2 ? (size_t)HALF * S.ldb2 * ESZ : 0;
    const unsigned ldsw = (unsigned)wid * 1024u;
    const int aoff = lds_byte(wr * 64 + fr, fq * 8), boff = lds_byte(wc * 32 + fr, fq * 8);
#define PG8_SA(b, h) (((b) * 2 + (h)) * HTB)
#define PG8_SB(b, h) ((4 + (b) * 2 + (h)) * HTB)
#define PG8_GL(bufoff, p_, o0_, o1_) do { \
        __builtin_amdgcn_global_load_lds((const unsigned*)((p_) + (o0_)), (PG8_LAS unsigned*)(lds + (bufoff) + ldsw), 16, 0, 0); \
        __builtin_amdgcn_global_load_lds((const unsigned*)((p_) + (o1_)), (PG8_LAS unsigned*)(lds + (bufoff) + ldsw + 8192), 16, 0, 0); } while (0)
#define PG8_STAGE_A(bufoff, P, GO, tau, h) do { const bool s3_ = SEG3 && ((tau) >= nt2); const bool s2_ = SEG2 && ((tau) >= nt1) && !s3_; \
        const char* p_ = s3_ ? (P).a3 + (size_t)((tau) - nt2) * 128 + (size_t)(h) * hsA : s2_ ? (P).a2 + (size_t)((tau) - nt1) * 128 + (size_t)(h) * hsA2 : (P).a + (size_t)(tau) * 128 + (size_t)(h) * hsA; \
        const unsigned o0_ = GATHER ? GO[h][0] : (s2_ ? voffA2[0] : voffA[0]), o1_ = GATHER ? GO[h][1] : (s2_ ? voffA2[1] : voffA[1]); PG8_GL(bufoff, p_, o0_, o1_); } while (0)
#define PG8_STAGE_B(bufoff, P, tau, h) do { const bool s3_ = SEG3 && ((tau) >= nt2); const bool s2_ = SEG2 && ((tau) >= nt1) && !s3_; \
        const char* p_ = s3_ ? (P).b3 + (size_t)((tau) - nt2) * 128 + (size_t)(h) * hsB : s2_ ? (P).b2 + (size_t)((tau) - nt1) * 128 + (size_t)(h) * hsB2 : (P).b + (size_t)(tau) * 128 + (size_t)(h) * hsB; \
        const unsigned o0_ = s2_ ? voffB2[0] : voffB[0], o1_ = s2_ ? voffB2[1] : voffB[1]; PG8_GL(bufoff, p_, o0_, o1_); } while (0)
#define PG8_LDA(dst, b, h) do { _Pragma("unroll") for (int m = 0; m < 4; ++m) { if constexpr (ESZ == 2) { _Pragma("unroll") for (int k = 0; k < 2; ++k) dst[m][k] = *(const PG8_LAS bf16x8*)(lds + PG8_SA(b, h) + aoff + m * 2048 + k * 1024); } \
        else dst##8[m] = cat8(*(const PG8_LAS bf16x8*)(lds + PG8_SA(b, h) + aoff + m * 2048), *(const PG8_LAS bf16x8*)(lds + PG8_SA(b, h) + aoff + m * 2048 + 1024)); } } while (0)
#define PG8_LDB(dst, b, h) do { _Pragma("unroll") for (int n = 0; n < 2; ++n) { if constexpr (ESZ == 2) { _Pragma("unroll") for (int k = 0; k < 2; ++k) dst[n][k] = *(const PG8_LAS bf16x8*)(lds + PG8_SB(b, h) + boff + n * 2048 + k * 1024); } \
        else dst##8[n] = cat8(*(const PG8_LAS bf16x8*)(lds + PG8_SB(b, h) + boff + n * 2048), *(const PG8_LAS bf16x8*)(lds + PG8_SB(b, h) + boff + n * 2048 + 1024)); } } while (0)
#define PG8_MMA(ai, bj, At, Bt) do { __builtin_amdgcn_s_setprio(1); _Pragma("unroll") for (int m = 0; m < 4; ++m) _Pragma("unroll") for (int n = 0; n < 2; ++n) { \
        if constexpr (ESZ == 2) { _Pragma("unroll") for (int k = 0; k < 2; ++k) acc[ai][bj][m][n] = __builtin_amdgcn_mfma_f32_16x16x32_bf16(Bt[n][k], At[m][k], acc[ai][bj][m][n], 0, 0, 0); } \
        else { asm volatile("v_mfma_f32_16x16x128_f8f6f4 %0, %1, %2, %0" : "+v"(acc[ai][bj][m][n]) : "v"(Bt##8[n]), "v"(At##8[m])); } } \
        __builtin_amdgcn_s_setprio(0); } while (0)
#define PG8_WAIT_V(n) asm volatile("s_waitcnt vmcnt(" #n ")" ::: "memory")
#define PG8_WAIT_L(n) asm volatile("s_waitcnt lgkmcnt(" #n ")" ::: "memory")
#define PG8_BAR __builtin_amdgcn_s_barrier()
#define PG8_SCHED __builtin_amdgcn_sched_barrier(0)
    Unit cur, nxt; int ui = 0;
    if (!S.next(0, cur)) return;
    f32x4 acc[2][2][4][2];
#pragma unroll
    for (int a = 0; a < 2; ++a)
#pragma unroll
        for (int b = 0; b < 2; ++b)
#pragma unroll
            for (int m = 0; m < 4; ++m)
#pragma unroll
                for (int n = 0; n < 2; ++n) acc[a][b][m][n] = (f32x4){0.f, 0.f, 0.f, 0.f};
    bf16x8 At[4][2], B0[2][2], B1[2][2]; v8i32 At8[4], B08[2], B18[2];
    UP Pc, Pn; S.ptrs(cur, Pc);
    if constexpr (Sched::VARNT) nt = S.unit_nt(cur);
    unsigned gc[2][2] = {{0u, 0u}, {0u, 0u}}, gn[2][2] = {{0u, 0u}, {0u, 0u}};
    if constexpr (GATHER) {
#pragma unroll
        for (int h = 0; h < 2; ++h)
#pragma unroll
            for (int i = 0; i < 2; ++i) gc[h][i] = S.arow(cur, h * HALF + Rr[i]) * (unsigned)ESZ + (unsigned)Cc[i] * 2u;
    }
    PG8_STAGE_B(PG8_SB(0, 0), Pc, 0, 0); PG8_STAGE_B(PG8_SB(0, 1), Pc, 0, 1); PG8_STAGE_A(PG8_SA(0, 0), Pc, gc, 0, 0); PG8_STAGE_A(PG8_SA(0, 1), Pc, gc, 0, 1);
    if (wr == 1) PG8_BAR;
    PG8_WAIT_V(2); PG8_BAR;
    PG8_STAGE_B(PG8_SB(1, 0), Pc, 1, 0); PG8_STAGE_A(PG8_SA(1, 0), Pc, gc, 1, 0); PG8_STAGE_B(PG8_SB(1, 1), Pc, 1, 1);
    PG8_WAIT_V(6); PG8_BAR;
    for (;;) {
        const bool has_next = S.next(ui + 1, nxt);
        if (has_next) {
            S.ptrs(nxt, Pn);
            if constexpr (GATHER) {
#pragma unroll
                for (int h = 0; h < 2; ++h)
#pragma unroll
                    for (int i = 0; i < 2; ++i) gn[h][i] = S.arow(nxt, h * HALF + Rr[i]) * (unsigned)ESZ + (unsigned)Cc[i] * 2u;
            }
        } else { Pn = Pc;
#pragma unroll
            for (int h = 0; h < 2; ++h)
#pragma unroll
                for (int i = 0; i < 2; ++i) gn[h][i] = gc[h][i]; }
        for (int t = 0; t < nt; t += 2) {
            const bool last = (t == nt - 2);
            if constexpr (SEG2) { if (t == nt1) { if constexpr (ALIGN_MID) { if (wr == 0) PG8_BAR; } E.mid(acc, cur, wr, wc, fr, fq, 0); if constexpr (ALIGN_MID) { if (wr == 1) PG8_BAR; } } }
            if constexpr (SEG3) { if (t == nt2) { if constexpr (ALIGN_MID) { if (wr == 0) PG8_BAR; } E.mid(acc, cur, wr, wc, fr, fq, 1); if constexpr (ALIGN_MID) { if (wr == 1) PG8_BAR; } } }
            UP Pp; Pp.a = last ? Pn.a : Pc.a; Pp.b = last ? Pn.b : Pc.b; Pp.a2 = last ? Pn.a2 : Pc.a2; Pp.b2 = last ? Pn.b2 : Pc.b2; Pp.a3 = last ? Pn.a3 : Pc.a3; Pp.b3 = last ? Pn.b3 : Pc.b3;
            unsigned gp[2][2];
#pragma unroll
            for (int h = 0; h < 2; ++h)
#pragma unroll
                for (int i = 0; i < 2; ++i) gp[h][i] = last ? gn[h][i] : gc[h][i];
            const int t1 = t + 1, t2 = last ? 0 : t + 2, t3 = t2 + 1;
            PG8_LDB(B0, 0, 0); PG8_LDB(B1, 0, 1); PG8_SCHED; PG8_LDA(At, 0, 0); PG8_STAGE_A(PG8_SA(1, 1), Pc, gc, t1, 1);
            PG8_WAIT_V(8); PG8_WAIT_L(0); PG8_BAR; PG8_MMA(0, 0, At, B0); PG8_MMA(0, 1, At, B1); PG8_BAR; PG8_SCHED;
            PG8_LDA(At, 0, 1); PG8_STAGE_B(PG8_SB(0, 0), Pp, t2, 0); PG8_STAGE_B(PG8_SB(0, 1), Pp, t2, 1); PG8_STAGE_A(PG8_SA(0, 0), Pp, gp, t2, 0);
            PG8_WAIT_V(8); PG8_WAIT_L(0); PG8_BAR; PG8_MMA(1, 0, At, B0); PG8_MMA(1, 1, At, B1); PG8_BAR; PG8_SCHED;
            PG8_LDB(B0, 1, 0); PG8_LDB(B1, 1, 1); PG8_SCHED; PG8_LDA(At, 1, 0); PG8_STAGE_A(PG8_SA(0, 1), Pp, gp, t2, 1);
            PG8_WAIT_V(8); PG8_WAIT_L(0); PG8_BAR; PG8_MMA(0, 0, At, B0); PG8_MMA(0, 1, At, B1); PG8_BAR; PG8_SCHED;
            PG8_LDA(At, 1, 1); PG8_STAGE_B(PG8_SB(1, 0), Pp, t3, 0); PG8_STAGE_B(PG8_SB(1, 1), Pp, t3, 1); PG8_STAGE_A(PG8_SA(1, 0), Pp, gp, t3, 0);
            PG8_WAIT_V(8); PG8_WAIT_L(0); PG8_BAR; PG8_MMA(1, 0, At, B0); PG8_MMA(1, 1, At, B1); PG8_BAR; PG8_SCHED;
        }
        if constexpr (ALIGN_EPI) { if (wr == 0) PG8_BAR; }
        if constexpr (ESZ == 1) { asm volatile("s_nop 15\n\ts_nop 15" ::: "memory"); PG8_SCHED; }
        E(acc, cur, wr, wc, fr, fq);
        if (!has_next) break;
#pragma unroll
        for (int a = 0; a < 2; ++a)
#pragma unroll
            for (int b = 0; b < 2; ++b)
#pragma unroll
                for (int m = 0; m < 4; ++m)
#pragma unroll
                    for (int n = 0; n < 2; ++n) acc[a][b][m][n] = (f32x4){0.f, 0.f, 0.f, 0.f};
        cur = nxt; Pc = Pn; ++ui;
        if constexpr (Sched::VARNT) nt = S.unit_nt(cur);
#pragma unroll
        for (int h = 0; h < 2; ++h)
#pragma unroll
            for (int i = 0; i < 2; ++i) gc[h][i] = gn[h][i];
        if constexpr (ALIGN_EPI) { if (wr == 1) PG8_BAR; }
    }
    PG8_WAIT_V(0);
    if constexpr (!ALIGN_EPI) { if (wr == 0) PG8_BAR; }
    PG8_BAR;
#undef PG8_SA
#undef PG8_SB
#undef PG8_GL
#undef PG8_STAGE_A
#undef PG8_STAGE_B
#undef PG8_LDA
#undef PG8_LDB
#undef PG8_MMA
#undef PG8_WAIT_V
#undef PG8_WAIT_L
#undef PG8_BAR
#undef PG8_SCHED
}
}
namespace attn_body {
using bf16=__hip_bfloat16;
using bf16x8=__attribute__((ext_vector_type(8)))short;
using s16x4=__attribute__((ext_vector_type(4)))short;
using f32x16=__attribute__((ext_vector_type(16)))float;
using u32x4=__attribute__((ext_vector_type(4)))unsigned;
constexpr int BATCH=4,NHEAD=16,SEQ=8192,D=64,DM=NHEAD*D,OP=2048;
constexpr int NW=8,QBLK=32,QB=QBLK*NW,KVBLK=64,NQB=SEQ/QB;
constexpr int ATTN_PITCH=DM, ATTN_UNIT_ROWS=QB;
__device__ __forceinline__ int crow(int r,int hi){return (r&3)+8*(r>>2)+4*hi;}
#define SBAR() __builtin_amdgcn_sched_barrier(0)
__device__ __forceinline__ void cmask(f32x16&p0,f32x16&p1,int jb,int qrel,int hi){
  const float NEG=-INFINITY; int kb=64*jb+4*hi;
  #pragma unroll
  for(int r=0;r<16;++r){int kv=kb+(r&3)+8*(r>>2); if((kv>>6)>(qrel>>6))p0[r]=NEG; if(((kv+32)>>6)>(qrel>>6))p1[r]=NEG;}
}

constexpr int NSLOT=3, SLOTB=8192;
constexpr int LDS_K=0, LDS_V=NSLOT*SLOTB, LDS_WS=2*NSLOT*SLOTB, LDS_OST=LDS_WS+NW*64*4, LDS_BYTES=LDS_OST+NW*4096;
constexpr float C2=0.125f*1.4426950408889634f;
__device__ __forceinline__ void glds16(const void*gsrc,unsigned lds_dst){unsigned keep;
  asm volatile("s_mov_b32 %0, m0\n\ts_mov_b32 m0, %2\n\ts_nop 0\n\tglobal_load_lds_dwordx4 %1, off\n\ts_mov_b32 m0, %0":"=&s"(keep):"v"(gsrc),"s"(lds_dst):"memory");}
__device__ __forceinline__ float max3f(float a,float b,float c){float r;asm("v_max3_f32 %0, %1, %2, %3":"=v"(r):"v"(a),"v"(b),"v"(c));return r;}
__device__ __forceinline__ float max2f(float a,float b){float r;asm("v_max_f32_e32 %0, %1, %2":"=v"(r):"v"(a),"v"(b));return r;}
__device__ __forceinline__ float fadd_s(float a,float b){float r;asm("v_add_f32_e32 %0, %1, %2":"=v"(r):"v"(a),"v"(b));return r;}
__device__ __forceinline__ float fsub_s(float a,float b){float r;asm("v_sub_f32_e32 %0, %1, %2":"=v"(r):"v"(a),"v"(b));return r;}
typedef float f32x2_t __attribute__((ext_vector_type(2))); typedef __bf16 bf16x2_t __attribute__((ext_vector_type(2)));
__device__ __forceinline__ unsigned cvtpk_s(float lo,float hi){f32x2_t v={lo,hi};bf16x2_t b=__builtin_convertvector(v,bf16x2_t);return __builtin_bit_cast(unsigned,b);}
#define WAIT_BAR(N) asm volatile("s_waitcnt vmcnt(" #N ") lgkmcnt(0)\n\ts_barrier":::"memory")

__device__ __forceinline__ void qkt(f32x16&p0,f32x16&p1,const char*Kslot,const bf16x8*qr,const f32x16&negm,int r32,int hi){
  const char*kb=Kslot+hi*1024+r32*16;
  #pragma unroll
  for(int d0=0;d0<4;++d0){
    const bf16x8 b0=*reinterpret_cast<const bf16x8*>(kb+d0*2048);
    const bf16x8 b1=*reinterpret_cast<const bf16x8*>(kb+d0*2048+512);
    if(d0==0){p0=__builtin_amdgcn_mfma_f32_32x32x16_bf16(b0,qr[0],negm,0,0,0);p1=__builtin_amdgcn_mfma_f32_32x32x16_bf16(b1,qr[0],negm,0,0,0);}
    else{p0=__builtin_amdgcn_mfma_f32_32x32x16_bf16(b0,qr[d0],p0,0,0,0);p1=__builtin_amdgcn_mfma_f32_32x32x16_bf16(b1,qr[d0],p1,0,0,0);}}
}
__device__ __forceinline__ void qkt0(f32x16&p0,f32x16&p1,const char*Kslot,const bf16x8*qr,int r32,int hi){
  const char*kb=Kslot+hi*1024+r32*16; const f32x16 z=f32x16{};
  #pragma unroll
  for(int d0=0;d0<4;++d0){
    const bf16x8 b0=*reinterpret_cast<const bf16x8*>(kb+d0*2048);
    const bf16x8 b1=*reinterpret_cast<const bf16x8*>(kb+d0*2048+512);
    if(d0==0){p0=__builtin_amdgcn_mfma_f32_32x32x16_bf16(b0,qr[0],z,0,0,0);p1=__builtin_amdgcn_mfma_f32_32x32x16_bf16(b1,qr[0],z,0,0,0);}
    else{p0=__builtin_amdgcn_mfma_f32_32x32x16_bf16(b0,qr[d0],p0,0,0,0);p1=__builtin_amdgcn_mfma_f32_32x32x16_bf16(b1,qr[d0],p1,0,0,0);}}
}
typedef __attribute__((address_space(3))) const char* lds_cptr;
typedef short v4i16_t __attribute__((ext_vector_type(4)));
__device__ __forceinline__ void kload8(bf16x8*kf,lds_cptr kp){
  kf[0]=*(const __attribute__((address_space(3))) bf16x8*)(kp);      kf[1]=*(const __attribute__((address_space(3))) bf16x8*)(kp+512);
  kf[2]=*(const __attribute__((address_space(3))) bf16x8*)(kp+2048); kf[3]=*(const __attribute__((address_space(3))) bf16x8*)(kp+2560);
  kf[4]=*(const __attribute__((address_space(3))) bf16x8*)(kp+4096); kf[5]=*(const __attribute__((address_space(3))) bf16x8*)(kp+4608);
  kf[6]=*(const __attribute__((address_space(3))) bf16x8*)(kp+6144); kf[7]=*(const __attribute__((address_space(3))) bf16x8*)(kp+6656);
}
__device__ __forceinline__ void kload2(bf16x8*kf,lds_cptr kp,int j){ kf[2*j]=*(const __attribute__((address_space(3))) bf16x8*)(kp+j*2048); kf[2*j+1]=*(const __attribute__((address_space(3))) bf16x8*)(kp+j*2048+512); }
__device__ __forceinline__ s16x4 vtr(lds_cptr p){ return __builtin_bit_cast(s16x4,__builtin_amdgcn_ds_read_tr16_b64_v4i16((__attribute__((address_space(3))) v4i16_t*)p)); }
__device__ __forceinline__ float rowmax(const f32x16&p0,const f32x16&p1){
  float a=max3f(p0[0],p0[1],p1[0]),b=max3f(p0[2],p0[3],p1[1]);a=max3f(a,p1[2],p1[3]);
  #pragma unroll
  for(int r=4;r<16;r+=4){a=max3f(a,p0[r],p0[r+1]);b=max3f(b,p0[r+2],p0[r+3]);a=max3f(a,p1[r],p1[r+1]);b=max3f(b,p1[r+2],p1[r+3]);}
  const float m=max2f(a,b);
  auto rr=__builtin_amdgcn_permlane32_swap(__float_as_uint(m),__float_as_uint(m),false,false);
  return max2f(__uint_as_float(rr[0]),__uint_as_float(rr[1]));
}
__device__ __forceinline__ void pv(f32x16*o,int vb,bf16x8 pa0,bf16x8 pa1,bf16x8 pa2,bf16x8 pa3){
  #pragma unroll
  for(int d0=0;d0<2;++d0){s16x4 lo[4],hi[4];
    #pragma unroll
    for(int ks=0;ks<4;++ks){
      asm volatile("ds_read_b64_tr_b16 %0,%1 offset:%c2":"=&v"(lo[ks]):"v"(vb),"i"(d0*4096+ks*1024):"memory");
      asm volatile("ds_read_b64_tr_b16 %0,%1 offset:%c2":"=&v"(hi[ks]):"v"(vb),"i"(d0*4096+ks*1024+512):"memory");}
    asm volatile("s_waitcnt lgkmcnt(0)":::"memory");SBAR();
    #define PK(k) (bf16x8){lo[k][0],lo[k][1],lo[k][2],lo[k][3],hi[k][0],hi[k][1],hi[k][2],hi[k][3]}
    o[d0]=__builtin_amdgcn_mfma_f32_32x32x16_bf16(pa0,PK(0),o[d0],0,0,0);
    o[d0]=__builtin_amdgcn_mfma_f32_32x32x16_bf16(pa1,PK(1),o[d0],0,0,0);
    o[d0]=__builtin_amdgcn_mfma_f32_32x32x16_bf16(pa2,PK(2),o[d0],0,0,0);
    o[d0]=__builtin_amdgcn_mfma_f32_32x32x16_bf16(pa3,PK(3),o[d0],0,0,0);
    #undef PK
  }
}

#ifndef ATTN_STORE16
#define ATTN_STORE16(p,v) (*(u32x4*)(p)=(v))
#endif
template<int THRL> __device__ __forceinline__ void attn_unit(int b,int h,int hv,int ho,int qb,const bf16*Q,const bf16*__restrict__ K,const bf16*__restrict__ V,bf16*O,char*shm){
  const int tid=threadIdx.x,lane=tid&63,r32=lane&31,hi=lane>>5; const int wid=__builtin_amdgcn_readfirstlane(tid>>6);
  const long rowbase=(long)b*SEQ; const int q0=qb*QB;
  const bf16*Qw=Q+(rowbase+q0+wid*QBLK)*DM+h*D;
  const bf16*Kh=K+rowbase*DM+h*D,*Vh=V+rowbase*DM+hv*D;
  const unsigned lds0=(unsigned)(uintptr_t)shm;
  float*wsf=(float*)(shm+LDS_WS)+wid*64;
  const bf16*ksrc=Kh+(long)lane*DM+wid*8;
  const bf16*vsrc=Vh+(long)(16*(wid&3)+(lane>>2))*DM+(wid>>2)*32+(lane&3)*8;
  const unsigned kdst=lds0+LDS_K+wid*1024, vdst=lds0+LDS_V+wid*1024;
  #define DMA_K(t,slot) glds16(ksrc+(long)(t)*KVBLK*DM,(unsigned)__builtin_amdgcn_readfirstlane(kdst+(slot)))
  #define DMA_V(t,slot) glds16(vsrc+(long)(t)*KVBLK*DM,(unsigned)__builtin_amdgcn_readfirstlane(vdst+(slot)))
  const int vb0=(int)(lds0+LDS_V)+((lane>>4)&1)*32+(lane&3)*8+(4*hi+((lane&15)>>2))*64;
  const char*Kbase=shm+LDS_K; bf16x8 kf[8];
  const lds_cptr shm3=(lds_cptr)shm; const lds_cptr kp0=shm3+LDS_K+hi*1024+r32*16; const lds_cptr vp0=shm3+LDS_V+((lane>>4)&1)*32+(lane&3)*8+(4*hi+((lane&15)>>2))*64;
  const int NT=(q0+QB)/KVBLK;
  DMA_K(0,0);DMA_V(0,0);DMA_K(1,SLOTB);
  bf16x8 qr[4];
  #pragma unroll
  for(int d0=0;d0<4;++d0)qr[d0]=*reinterpret_cast<const bf16x8*>(&Qw[(long)r32*DM+d0*16+hi*8]);
  float mhat=0.f,l_reg=0.f;f32x16 o[2];o[0]=f32x16{};o[1]=f32x16{};f32x16 negm=f32x16{};asm volatile("":"+v"(negm));
  const int qrel=wid*QBLK+r32;
  #define CMASK(P0,P1,t) do{int jb_=(t)-(NT-4); if(jb_>=0)cmask(P0,P1,jb_,qrel,hi);}while(0)
  bool resc=false;
  #define START(P0,P1) do{ const float rm=rowmax(P0,P1); resc=false; \
    { const float dl=rm; mhat=fadd_s(mhat,dl); \
      _Pragma("unroll") for(int r=0;r<16;++r){P0[r]=fsub_s(P0[r],dl);P1[r]=fsub_s(P1[r],dl);} \
      _Pragma("unroll") for(int r=0;r<16;++r)negm[r]=-mhat; asm volatile("":"+v"(negm)); } \
    _Pragma("unroll") for(int r=0;r<16;++r)P0[r]=__builtin_amdgcn_exp2f(P0[r]); }while(0)
  #define RESC() do{ if(resc){ asm volatile("s_waitcnt lgkmcnt(0)":::"memory"); \
      _Pragma("unroll") for(int d_=0;d_<2;++d_) _Pragma("unroll") for(int r=0;r<16;++r)o[d_][r]*=wsf[crow(r,hi)]; } }while(0)
  f32x16 pA0,pA1,pB0,pB1;
  int sl_prev=0,sl_cur=0,sl_next=SLOTB;
  #define ROT() do{sl_prev=sl_cur;sl_cur=sl_next;sl_next=(sl_next==(NSLOT-1)*SLOTB)?0:sl_next+SLOTB;}while(0)
  DMA_K(2,2*SLOTB);
  WAIT_BAR(3);
  qkt(pA0,pA1,Kbase,qr,negm,r32,hi);asm volatile("s_nop 15\n\ts_nop 7":"+v"(pA0),"+v"(pA1));CMASK(pA0,pA1,0);
  START(pA0,pA1);
  _Pragma("unroll") for(int r=0;r<16;++r)pA1[r]=__builtin_amdgcn_exp2f(pA1[r]);
  WAIT_BAR(0);
  DMA_K(3,0);DMA_V(1,SLOTB);
  ROT();
  kload8(kf,kp0+sl_cur);
  WAIT_BAR(2);
  s16x4 vlo[8],vhi[8]; u32x4 pw0,pw1,pw2,pw3;
  #define PKW(P,B) cvtpk_s(P[B],P[B+1])
  #define PAF(k) __builtin_bit_cast(bf16x8,pw##k)
  #define VFR(i) (bf16x8){vlo[i][0],vlo[i][1],vlo[i][2],vlo[i][3],vhi[i][0],vhi[i][1],vhi[i][2],vhi[i][3]}
  #define PIN(x) asm volatile("":"+v"(x))
  #define MX3(a,b,c) __builtin_fmaxf(__builtin_fmaxf((a),(b)),(c))
  #define GAPA(MF,A0,A1,A2,A3,W0,W1,PW) do{ MF; sacc+=A0; sacc+=A1; sacc+=A2; sacc+=A3; PIN(sacc); W0; W1; PIN(PW); SBAR(); }while(0)
  #define EX(v) __builtin_amdgcn_exp2f(v)
  #define GAPB(MF,X,B) do{ MF; X[B]=EX(X[B]); X[B+1]=EX(X[B+1]); X[B+2]=EX(X[B+2]); X[B+3]=EX(X[B+3]); PIN(X); SBAR(); }while(0)
  #define VRD(i) do{ vlo[i]=vtr(vp_+(((i)>>2)*4096+((i)&3)*1024)); vhi[i]=vtr(vp_+(((i)>>2)*4096+((i)&3)*1024+512)); }while(0)
  #define KRD(G,j) do{ if(G){ kload2(kf,kp0+sl_next,j); SBAR(); } }while(0)
  #define STEP(C0,C1,P0,P1,t,GK,GV,GL) do{ SBAR(); \
    const lds_cptr vp_=vp0+sl_prev; \
    VRD(0); SBAR(); float sacc=(P0[0]+P0[1]); \
    GAPA(C0=__builtin_amdgcn_mfma_f32_32x32x16_bf16(kf[0],qr[0],negm,0,0,0), P0[2],P0[3],P0[4],P0[5],     pw0[0]=PKW(P0,0), pw0[1]=PKW(P0,2), pw0); \
    VRD(4); SBAR(); GAPA(C1=__builtin_amdgcn_mfma_f32_32x32x16_bf16(kf[1],qr[0],negm,0,0,0), P0[6],P0[7],P0[8],P0[9],     pw0[2]=PKW(P0,4), pw0[3]=PKW(P0,6), pw0); \
    VRD(1); SBAR(); GAPA(C0=__builtin_amdgcn_mfma_f32_32x32x16_bf16(kf[2],qr[1],C0,0,0,0),   P0[10],P0[11],P0[12],P0[13], pw1[0]=PKW(P0,8), pw1[1]=PKW(P0,10), pw1); \
    VRD(5); SBAR(); GAPA(C1=__builtin_amdgcn_mfma_f32_32x32x16_bf16(kf[3],qr[1],C1,0,0,0),   P0[14],P0[15],P1[0],P1[1],   pw1[2]=PKW(P0,12),pw1[3]=PKW(P0,14), pw1); \
    VRD(2); SBAR(); GAPA(C0=__builtin_amdgcn_mfma_f32_32x32x16_bf16(kf[4],qr[2],C0,0,0,0),   P1[2],P1[3],P1[4],P1[5],     pw2[0]=PKW(P1,0), pw2[1]=PKW(P1,2), pw2); \
    VRD(6); SBAR(); GAPA(C1=__builtin_amdgcn_mfma_f32_32x32x16_bf16(kf[5],qr[2],C1,0,0,0),   P1[6],P1[7],P1[8],P1[9],     pw2[2]=PKW(P1,4), pw2[3]=PKW(P1,6), pw2); \
    VRD(3); SBAR(); GAPA(C0=__builtin_amdgcn_mfma_f32_32x32x16_bf16(kf[6],qr[3],C0,0,0,0),   P1[10],P1[11],P1[12],P1[13], pw3[0]=PKW(P1,8), pw3[1]=PKW(P1,10), pw3); \
    VRD(7); SBAR(); GAPA(C1=__builtin_amdgcn_mfma_f32_32x32x16_bf16(kf[7],qr[3],C1,0,0,0),   P1[14],P1[15],0.f,0.f,       pw3[2]=PKW(P1,12),pw3[3]=PKW(P1,14), pw3); \
    l_reg+=sacc; \
    if(GK){DMA_K((t)+3,sl_cur);} if(GV){DMA_V((t)+1,sl_next);} \
    CMASK(C0,C1,t); \
    { float a=MX3(C0[0],C0[1],C1[0]),b=MX3(C0[2],C0[3],C1[1]); a=MX3(a,C1[2],C1[3]); \
      _Pragma("unroll") for(int r=4;r<16;r+=4){a=MX3(a,C0[r],C0[r+1]);b=MX3(b,C0[r+2],C0[r+3]);a=MX3(a,C1[r],C1[r+1]);b=MX3(b,C1[r+2],C1[r+3]);} \
      float rm=__builtin_fmaxf(a,b); { auto rr=__builtin_amdgcn_permlane32_swap(__float_as_uint(rm),__float_as_uint(rm),false,false); rm=__builtin_fmaxf(__uint_as_float(rr[0]),__uint_as_float(rr[1])); } \
      resc=false; \
      if(__builtin_expect(__any(rm>(float)THRL),0)){ const float dl=__builtin_fmaxf(rm,0.f); mhat+=dl; \
        _Pragma("unroll") for(int r=0;r<16;++r){C0[r]-=dl;C1[r]-=dl;} \
        _Pragma("unroll") for(int r=0;r<16;++r)negm[r]=-mhat; asm volatile("":"+v"(negm)); \
        const float f=__builtin_amdgcn_exp2f(-dl); l_reg*=f; if(hi==0)wsf[r32]=f; resc=true; } } \
    SBAR(); \
    GAPB(o[0]=__builtin_amdgcn_mfma_f32_32x32x16_bf16(PAF(0),VFR(0),o[0],0,0,0), C0,0); \
    GAPB(o[1]=__builtin_amdgcn_mfma_f32_32x32x16_bf16(PAF(0),VFR(4),o[1],0,0,0), C0,4); \
    KRD(GL,0); GAPB(o[0]=__builtin_amdgcn_mfma_f32_32x32x16_bf16(PAF(1),VFR(1),o[0],0,0,0), C0,8); \
    KRD(GL,1); GAPB(o[1]=__builtin_amdgcn_mfma_f32_32x32x16_bf16(PAF(1),VFR(5),o[1],0,0,0), C0,12); \
    KRD(GL,2); GAPB(o[0]=__builtin_amdgcn_mfma_f32_32x32x16_bf16(PAF(2),VFR(2),o[0],0,0,0), C1,0); \
    KRD(GL,3); GAPB(o[1]=__builtin_amdgcn_mfma_f32_32x32x16_bf16(PAF(2),VFR(6),o[1],0,0,0), C1,4); \
    GAPB(o[0]=__builtin_amdgcn_mfma_f32_32x32x16_bf16(PAF(3),VFR(3),o[0],0,0,0), C1,8); \
    GAPB(o[1]=__builtin_amdgcn_mfma_f32_32x32x16_bf16(PAF(3),VFR(7),o[1],0,0,0), C1,12); \
    }while(0)
  int t=1;
  #undef CMASK
  #define CMASK(P0,P1,t) do{}while(0)
  for(;t+5<NT;t+=2){
    STEP(pB0,pB1,pA0,pA1,t,true,true,true);     WAIT_BAR(2); RESC(); ROT();
    STEP(pA0,pA1,pB0,pB1,t+1,true,true,true);   WAIT_BAR(2); RESC(); ROT();
  }
  #undef CMASK
  #define CMASK(P0,P1,t) do{int jb_=(t)-(NT-4); if(jb_>=0)cmask(P0,P1,jb_,qrel,hi);}while(0)
  #define ENDW(tt) do{ if((tt)+3<NT){WAIT_BAR(2);} else if((tt)+2<NT){WAIT_BAR(1);} else {WAIT_BAR(0);} }while(0)
  for(;t+1<NT;t+=2){
    STEP(pB0,pB1,pA0,pA1,t,(t+3<NT),(t+1<NT),(t+1<NT));       ENDW(t);   RESC(); ROT();
    STEP(pA0,pA1,pB0,pB1,t+1,(t+4<NT),(t+2<NT),(t+2<NT));     ENDW(t+1); RESC(); ROT();
  }
  STEP(pB0,pB1,pA0,pA1,NT-1,false,false,false); RESC();
  { float sacc=pB0[0]+pB0[1]; _Pragma("unroll") for(int r=2;r<16;++r)sacc+=pB0[r]; _Pragma("unroll") for(int r=0;r<16;++r)sacc+=pB1[r]; l_reg+=sacc;
    pw0=(u32x4){PKW(pB0,0),PKW(pB0,2),PKW(pB0,4),PKW(pB0,6)};pw1=(u32x4){PKW(pB0,8),PKW(pB0,10),PKW(pB0,12),PKW(pB0,14)};pw2=(u32x4){PKW(pB1,0),PKW(pB1,2),PKW(pB1,4),PKW(pB1,6)};pw3=(u32x4){PKW(pB1,8),PKW(pB1,10),PKW(pB1,12),PKW(pB1,14)};
    SBAR(); pv(o,vb0+sl_cur,PAF(0),PAF(1),PAF(2),PAF(3)); }
  #undef PKW
  #undef PAF
  #undef VFR
  #undef PIN
  #undef MX3
  #undef GAPA
  #undef GAPB
  #undef EX
  #undef VRD
  #undef KRD
  #undef STEP
  #undef ENDW
  {auto rr=__builtin_amdgcn_permlane32_swap(__float_as_uint(l_reg),__float_as_uint(l_reg),false,false);l_reg=__uint_as_float(rr[0])+__uint_as_float(rr[1]);}
  if(hi==0)wsf[32+r32]=l_reg;asm volatile("s_waitcnt lgkmcnt(0)":::"memory");
  float rli[16];
  #pragma unroll
  for(int r=0;r<16;++r)rli[r]=__builtin_amdgcn_rcpf(wsf[32+crow(r,hi)]);
  bf16*Ow=O+(rowbase+q0+wid*QBLK)*OP+ho*D;
  { bf16*stg=(bf16*)(shm+LDS_OST)+wid*2048;
    #pragma unroll
    for(int r=0;r<16;++r){const int orow=crow(r,hi);
      #pragma unroll
      for(int d0=0;d0<2;++d0)stg[orow*64+d0*32+r32]=__float2bfloat16(o[d0][r]*rli[r]);}
    asm volatile("s_waitcnt lgkmcnt(0)":::"memory");
    #pragma unroll
    for(int i=0;i<4;++i){const int row=i*8+(lane>>3),ch=lane&7; const u32x4 v=*(const u32x4*)(stg+row*64+ch*8); ATTN_STORE16(Ow+(long)row*OP+ch*8,v);} }
  asm volatile("s_waitcnt lgkmcnt(0)\n\ts_barrier":::"memory");
  #undef DMA_K
  #undef DMA_V
  #undef CMASK
  #undef START
  #undef RESC
  #undef ROT
}
constexpr int ATTN_LDS_BYTES=LDS_BYTES;
struct AttnTensors { const bf16* Q; const bf16* K; const bf16* V; bf16* O; const float* qg=nullptr; const float* ropec=nullptr; const float* ropes=nullptr; };
struct AttnUnit { int b, hq, hv, ho, qb; };
struct StaticOrder {
  int vcu;
  __device__ __forceinline__ explicit StaticOrder(int grid,int block):vcu((block%8)*(grid/8)+block/8){}
  __device__ __forceinline__ bool next(int i,AttnUnit&u)const{ if(i>=16)return false; const int s=vcu&7, r=i>>2, ii=i&3; const int v=r*32+(vcu>>3);
    const int vhalf=v&1, c=(v>>1)&1, h=(v>>2)&7; u.b=v>>5; u.hq=h*2+c; u.hv=h*2+vhalf; u.ho=(h*2+c)*2+vhalf; u.qb=(ii==0)?s:(ii==1)?15-s:(ii==2)?16+s:31-s; return true; }
  __device__ __forceinline__ void a_ready(const AttnUnit&)const{}
  __device__ __forceinline__ void done(const AttnUnit&)const{}
};
template<class Sched,int THRL=8> __device__ __forceinline__ void attn_phase(char*lds,const AttnTensors&T,const Sched&S){
  AttnUnit u;
  for(int i=0;S.next(i,u);++i){ S.a_ready(u); attn_unit<THRL>(u.b,u.hq,u.hv,u.ho,u.qb,T.Q,T.K,T.V,T.O,lds); S.done(u); }
}

constexpr int L2_K=0, L2_V=3*8192, L2_WS=L2_V+3*16384, L2_OST=L2_WS+NW*64*4, L2_BYTES=L2_OST+NW*4096;
template<int THRL> __device__ __forceinline__ void attn2_unit(int b,int hq,int hv,int ho,int qb,const bf16*Q,const bf16*__restrict__ K,const bf16*__restrict__ V,bf16*O,char*shm){
  const int tid=threadIdx.x,lane=tid&63,r32=lane&31,hi=lane>>5; const int wid=__builtin_amdgcn_readfirstlane(tid>>6);
  const long rowbase=(long)b*SEQ; const int q0=qb*QB;
  const bf16*Qw=Q+(rowbase+q0+wid*QBLK)*DM+hq*D;
  const bf16*Kh=K+rowbase*DM+hq*D,*Vh=V+rowbase*DM+hv*D;
  const unsigned lds0=(unsigned)(uintptr_t)shm;
  float*wsf=(float*)(shm+L2_WS)+wid*64;
  const bf16*ksrc=Kh+(long)lane*DM+wid*8;
  const bf16*vsrc=Vh+(long)(16*(wid&3)+(lane>>2))*DM+(wid>>2)*32+(lane&3)*8;
  const unsigned kdst=lds0+L2_K+wid*1024, vdst=lds0+L2_V+wid*1024;
  #define DMA2_K(t,sl) glds16(ksrc+(long)(t)*KVBLK*DM,(unsigned)__builtin_amdgcn_readfirstlane(kdst+(sl)*8192))
  #define DMA2_V(t,sl) do{ glds16(vsrc+(long)(t)*KVBLK*DM,(unsigned)__builtin_amdgcn_readfirstlane(vdst+(sl)*16384)); glds16(vsrc+64+(long)(t)*KVBLK*DM,(unsigned)__builtin_amdgcn_readfirstlane(vdst+(sl)*16384+8192)); }while(0)
  const int vb0=(int)(lds0+L2_V)+((lane>>4)&1)*32+(lane&3)*8+(4*hi+((lane&15)>>2))*64;
  const int NT=(q0+QB)/KVBLK;
  bf16x8 qr[4];
  #pragma unroll
  for(int d0=0;d0<4;++d0)qr[d0]=*reinterpret_cast<const bf16x8*>(&Qw[(long)r32*DM+d0*16+hi*8]);
  asm volatile("":"+v"(qr[0]),"+v"(qr[1]),"+v"(qr[2]),"+v"(qr[3]));
  DMA2_K(0,0);DMA2_V(0,0);DMA2_K(1,1);DMA2_V(1,1);
  float mhat=0.f,l_reg=0.f;f32x16 o[4];o[0]=f32x16{};o[1]=f32x16{};o[2]=f32x16{};o[3]=f32x16{};f32x16 negm=f32x16{};asm volatile("":"+v"(negm));
  const int qrel=wid*QBLK+r32;
  int sl=0;
  for(int t=0;t<NT;++t){
    if(t+1<NT){ asm volatile("s_waitcnt vmcnt(3) lgkmcnt(0)\n\ts_barrier":::"memory"); } else { asm volatile("s_waitcnt vmcnt(0) lgkmcnt(0)\n\ts_barrier":::"memory"); }
    if(t+2<NT){ const int s2=(sl==0)?2:sl-1; DMA2_K(t+2,s2); DMA2_V(t+2,s2); }
    if(t-(NT-4)>(wid>>1)){ sl=(sl==2)?0:sl+1; continue; }
    f32x16 p0,p1;
    qkt(p0,p1,shm+L2_K+sl*8192,qr,negm,r32,hi); asm volatile("s_nop 15\n\ts_nop 7":"+v"(p0),"+v"(p1));
    const float rm=rowmax(p0,p1);
    bool resc=false;
    if(t==0){ const float dl=rm; mhat+=dl;
      #pragma unroll
      for(int r=0;r<16;++r){p0[r]-=dl;p1[r]-=dl;}
      #pragma unroll
      for(int r=0;r<16;++r)negm[r]=-mhat; asm volatile("":"+v"(negm)); }
    else if(__any(rm>(float)THRL)){ const float dl=__builtin_fmaxf(rm,0.f); mhat+=dl;
      #pragma unroll
      for(int r=0;r<16;++r){p0[r]-=dl;p1[r]-=dl;}
      #pragma unroll
      for(int r=0;r<16;++r)negm[r]=-mhat; asm volatile("":"+v"(negm));
      const float f=__builtin_amdgcn_exp2f(-dl); l_reg*=f; if(hi==0)wsf[r32]=f; resc=true; }
    float sacc=0.f;
    #pragma unroll
    for(int r=0;r<16;++r){p0[r]=__builtin_amdgcn_exp2f(p0[r]);p1[r]=__builtin_amdgcn_exp2f(p1[r]);sacc+=p0[r]+p1[r];}
    l_reg+=sacc;
    u32x4 pw0,pw1,pw2,pw3;
    pw0=(u32x4){cvtpk_s(p0[0],p0[1]),cvtpk_s(p0[2],p0[3]),cvtpk_s(p0[4],p0[5]),cvtpk_s(p0[6],p0[7])};
    pw1=(u32x4){cvtpk_s(p0[8],p0[9]),cvtpk_s(p0[10],p0[11]),cvtpk_s(p0[12],p0[13]),cvtpk_s(p0[14],p0[15])};
    pw2=(u32x4){cvtpk_s(p1[0],p1[1]),cvtpk_s(p1[2],p1[3]),cvtpk_s(p1[4],p1[5]),cvtpk_s(p1[6],p1[7])};
    pw3=(u32x4){cvtpk_s(p1[8],p1[9]),cvtpk_s(p1[10],p1[11]),cvtpk_s(p1[12],p1[13]),cvtpk_s(p1[14],p1[15])};
    if(resc){ asm volatile("s_waitcnt lgkmcnt(0)":::"memory");
      #pragma unroll
      for(int r=0;r<16;++r){ const float f=wsf[crow(r,hi)]; o[0][r]*=f;o[1][r]*=f;o[2][r]*=f;o[3][r]*=f; } }
    SBAR();
    pv(o,vb0+sl*16384,__builtin_bit_cast(bf16x8,pw0),__builtin_bit_cast(bf16x8,pw1),__builtin_bit_cast(bf16x8,pw2),__builtin_bit_cast(bf16x8,pw3));
    pv(o+2,vb0+sl*16384+8192,__builtin_bit_cast(bf16x8,pw0),__builtin_bit_cast(bf16x8,pw1),__builtin_bit_cast(bf16x8,pw2),__builtin_bit_cast(bf16x8,pw3));
    sl=(sl==2)?0:sl+1;
  }
  {auto rr=__builtin_amdgcn_permlane32_swap(__float_as_uint(l_reg),__float_as_uint(l_reg),false,false);l_reg=__uint_as_float(rr[0])+__uint_as_float(rr[1]);}
  if(hi==0)wsf[32+r32]=l_reg;asm volatile("s_waitcnt lgkmcnt(0)":::"memory");
  float rli[16];
  #pragma unroll
  for(int r=0;r<16;++r)rli[r]=__builtin_amdgcn_rcpf(wsf[32+crow(r,hi)]);
  bf16*stg=(bf16*)(shm+L2_OST)+wid*2048;
  #pragma unroll
  for(int hf=0;hf<2;++hf){
    bf16*Ow=O+(rowbase+q0+wid*QBLK)*OP+(ho+hf)*D;
    #pragma unroll
    for(int r=0;r<16;++r){const int orow=crow(r,hi);
      #pragma unroll
      for(int d0=0;d0<2;++d0)stg[orow*64+d0*32+r32]=__float2bfloat16(o[2*hf+d0][r]*rli[r]);}
    asm volatile("s_waitcnt lgkmcnt(0)":::"memory");
    #pragma unroll
    for(int i=0;i<4;++i){const int row=i*8+(lane>>3),ch=lane&7; const u32x4 v=*(const u32x4*)(stg+row*64+ch*8); ATTN_STORE16(Ow+(long)row*OP+ch*8,v);}
    asm volatile("s_waitcnt lgkmcnt(0)":::"memory");
  }
  asm volatile("s_waitcnt lgkmcnt(0)\n\ts_barrier":::"memory");
  #undef DMA2_K
  #undef DMA2_V
}
struct AttnUnit2 { int b, hq, hv, ho, qb; };
struct StaticOrder2 {
  int vcu;
  __device__ __forceinline__ explicit StaticOrder2(int grid,int block):vcu((block%8)*(grid/8)+block/8){}
  __device__ __forceinline__ bool next(int i,AttnUnit2&u)const{ if(i>=8)return false; const int s=vcu&7, r=i>>2, ii=i&3; const int v=r*32+(vcu>>3);
    const int c=v&1, h=(v>>1)&7; u.b=v>>4; u.hq=h*2+c; u.hv=h*2; u.ho=(h*2+c)*2; u.qb=(ii==0)?s:(ii==1)?15-s:(ii==2)?16+s:31-s; return true; }
};
template<class Sched,int THRL=8> __device__ __forceinline__ void attn2_phase(char*lds,const AttnTensors&T,const Sched&S){
  AttnUnit2 u;
  for(int i=0;S.next(i,u);++i){ attn2_unit<THRL>(u.b,u.hq,u.hv,u.ho,u.qb,T.Q,T.K,T.V,T.O,lds); }
}

constexpr int L3_K=0, L3_V=3*8192, L3_WS=L3_V+4*16384, L3_OST=L3_WS+NW*64*4, L3_BYTES=L3_OST+NW*4096;
template<int THRL> __device__ __forceinline__ void attn3_unit(int b,int hq,int hv,int ho,int qb,const bf16*Q,const bf16*__restrict__ K,const bf16*__restrict__ V,bf16*O,char*shm){
  const int tid=threadIdx.x,lane=tid&63,r32=lane&31,hi=lane>>5; const int wid=__builtin_amdgcn_readfirstlane(tid>>6);
  const long rowbase=(long)b*SEQ; const int q0=qb*QB;
  const bf16*Qw=Q+(rowbase+q0+wid*QBLK)*DM+hq*D;
  const bf16*Kh=K+rowbase*DM+hq*D,*Vh=V+rowbase*DM+hv*D;
  const unsigned lds0=(unsigned)(uintptr_t)shm;
  float*wsf=(float*)(shm+L3_WS)+wid*64;
  const bf16*ksrc=Kh+(long)lane*DM+wid*8;
  const bf16*vsrc=Vh+(long)(16*(wid&3)+(lane>>2))*DM+(wid>>2)*32+(lane&3)*8;
  const unsigned kdst=lds0+L3_K+wid*1024, vdst=lds0+L3_V+wid*1024;
  #define DMA3_K(t,sl) glds16(ksrc+(long)(t)*KVBLK*DM,(unsigned)__builtin_amdgcn_readfirstlane(kdst+(sl)*8192))
  #define DMA3_V(t,sl) do{ glds16(vsrc+(long)(t)*KVBLK*DM,(unsigned)__builtin_amdgcn_readfirstlane(vdst+(sl)*16384)); glds16(vsrc+64+(long)(t)*KVBLK*DM,(unsigned)__builtin_amdgcn_readfirstlane(vdst+(sl)*16384+8192)); }while(0)
  const int vb0=(int)(lds0+L3_V)+((lane>>4)&1)*32+(lane&3)*8+(4*hi+((lane&15)>>2))*64;
  const int NT=(q0+QB)/KVBLK;
  bf16x8 qr[4];
  #pragma unroll
  for(int d0=0;d0<4;++d0)qr[d0]=*reinterpret_cast<const bf16x8*>(&Qw[(long)r32*DM+d0*16+hi*8]);
  asm volatile("":"+v"(qr[0]),"+v"(qr[1]),"+v"(qr[2]),"+v"(qr[3]));
  DMA3_K(0,0);DMA3_V(0,0);DMA3_K(1,1);DMA3_V(1,1);
  float mhat=0.f,l_reg=0.f;f32x16 o[4];o[0]=f32x16{};o[1]=f32x16{};o[2]=f32x16{};o[3]=f32x16{};
  const int qrel=wid*QBLK+r32;
  f32x16 P0,P1;
  asm volatile("s_waitcnt vmcnt(5) lgkmcnt(0)\n\ts_barrier":::"memory");
  DMA3_K(2,2);DMA3_V(2,2);
  qkt0(P0,P1,shm+L3_K,qr,r32,hi); asm volatile("s_nop 15\n\ts_nop 7":"+v"(P0),"+v"(P1));
  { const int jb=0-(NT-4); if(jb>=0)cmask(P0,P1,jb,qrel,hi); }
  { const float dl=rowmax(P0,P1); mhat+=dl;
    #pragma unroll
    for(int r=0;r<16;++r){P0[r]=__builtin_amdgcn_exp2f(P0[r]-dl);P1[r]=__builtin_amdgcn_exp2f(P1[r]-dl);} }
  #define PACKP() do{ float sacc=0.f; _Pragma("unroll") for(int r=0;r<16;++r)sacc+=P0[r]+P1[r]; l_reg+=sacc; \
    pw0=(u32x4){cvtpk_s(P0[0],P0[1]),cvtpk_s(P0[2],P0[3]),cvtpk_s(P0[4],P0[5]),cvtpk_s(P0[6],P0[7])}; pw1=(u32x4){cvtpk_s(P0[8],P0[9]),cvtpk_s(P0[10],P0[11]),cvtpk_s(P0[12],P0[13]),cvtpk_s(P0[14],P0[15])}; \
    pw2=(u32x4){cvtpk_s(P1[0],P1[1]),cvtpk_s(P1[2],P1[3]),cvtpk_s(P1[4],P1[5]),cvtpk_s(P1[6],P1[7])}; pw3=(u32x4){cvtpk_s(P1[8],P1[9]),cvtpk_s(P1[10],P1[11]),cvtpk_s(P1[12],P1[13]),cvtpk_s(P1[14],P1[15])}; }while(0)
  #define BF8(x) __builtin_bit_cast(bf16x8,x)
  u32x4 pw0,pw1,pw2,pw3;
  for(int t=1;t<NT;++t){
    if(t+1<NT){ asm volatile("s_waitcnt vmcnt(5) lgkmcnt(0)\n\ts_barrier":::"memory"); } else { asm volatile("s_waitcnt vmcnt(2) lgkmcnt(0)\n\ts_barrier":::"memory"); }
    if(t+2<NT){ DMA3_K(t+2,(t+2)%3); DMA3_V(t+2,(t+2)&3); }
    f32x16 C0,C1;
    qkt0(C0,C1,shm+L3_K+(t%3)*8192,qr,r32,hi);
    PACKP();
    asm volatile("s_nop 15\n\ts_nop 7":"+v"(C0),"+v"(C1));
    { const int jb=t-(NT-4); if(jb>=0)cmask(C0,C1,jb,qrel,hi); }
    const float rm=rowmax(C0,C1)-mhat;
    bool resc=false;
    if(__any(rm>(float)THRL)){ const float dl=__builtin_fmaxf(rm,0.f); mhat+=dl;
      const float f=__builtin_amdgcn_exp2f(-dl); l_reg*=f; if(hi==0)wsf[r32]=f; resc=true; }
    #pragma unroll
    for(int r=0;r<16;++r){C0[r]-=mhat;C1[r]-=mhat;}
    SBAR();
    const int vs=vb0+((t-1)&3)*16384;
    pv(o,vs,BF8(pw0),BF8(pw1),BF8(pw2),BF8(pw3));
    #pragma unroll
    for(int r=0;r<16;++r)P0[r]=__builtin_amdgcn_exp2f(C0[r]);
    SBAR();
    pv(o+2,vs+8192,BF8(pw0),BF8(pw1),BF8(pw2),BF8(pw3));
    #pragma unroll
    for(int r=0;r<16;++r)P1[r]=__builtin_amdgcn_exp2f(C1[r]);
    if(resc){ asm volatile("s_waitcnt lgkmcnt(0)":::"memory");
      #pragma unroll
      for(int r=0;r<16;++r){ const float f=wsf[crow(r,hi)]; o[0][r]*=f;o[1][r]*=f;o[2][r]*=f;o[3][r]*=f; } }
  }
  PACKP();
  asm volatile("s_waitcnt vmcnt(0) lgkmcnt(0)\n\ts_barrier":::"memory");
  { const int vs=vb0+((NT-1)&3)*16384; SBAR(); pv(o,vs,BF8(pw0),BF8(pw1),BF8(pw2),BF8(pw3)); pv(o+2,vs+8192,BF8(pw0),BF8(pw1),BF8(pw2),BF8(pw3)); }
  #undef PACKP
  #undef BF8
  {auto rr=__builtin_amdgcn_permlane32_swap(__float_as_uint(l_reg),__float_as_uint(l_reg),false,false);l_reg=__uint_as_float(rr[0])+__uint_as_float(rr[1]);}
  if(hi==0)wsf[32+r32]=l_reg;asm volatile("s_waitcnt lgkmcnt(0)":::"memory");
  float rli[16];
  #pragma unroll
  for(int r=0;r<16;++r)rli[r]=__builtin_amdgcn_rcpf(wsf[32+crow(r,hi)]);
  bf16*stg=(bf16*)(shm+L3_OST)+wid*2048;
  #pragma unroll
  for(int hf=0;hf<2;++hf){
    bf16*Ow=O+(rowbase+q0+wid*QBLK)*OP+(ho+hf)*D;
    #pragma unroll
    for(int r=0;r<16;++r){const int orow=crow(r,hi);
      #pragma unroll
      for(int d0=0;d0<2;++d0)stg[orow*64+d0*32+r32]=__float2bfloat16(o[2*hf+d0][r]*rli[r]);}
    asm volatile("s_waitcnt lgkmcnt(0)":::"memory");
    #pragma unroll
    for(int i=0;i<4;++i){const int row=i*8+(lane>>3),ch=lane&7; const u32x4 v=*(const u32x4*)(stg+row*64+ch*8); ATTN_STORE16(Ow+(long)row*OP+ch*8,v);}
    asm volatile("s_waitcnt lgkmcnt(0)":::"memory");
  }
  asm volatile("s_waitcnt lgkmcnt(0)\n\ts_barrier":::"memory");
  #undef DMA3_K
  #undef DMA3_V
}
template<class Sched,int THRL=8> __device__ __forceinline__ void attn3_phase(char*lds,const AttnTensors&T,const Sched&S){
  AttnUnit2 u;
  for(int i=0;S.next(i,u);++i){ attn3_unit<THRL>(u.b,u.hq,u.hv,u.ho,u.qb,T.Q,T.K,T.V,T.O,lds); }
}

#ifndef ATTN4_GRP
#define ATTN4_GRP (wid>>2)
#endif
constexpr int L4_K=0, L4_V=4*8192, L4_WS=L4_V+4*16384, L4_OST=L4_WS+NW*64*4, L4_BYTES=L4_OST+NW*4096;
#define WAITBARN(n) do{ const int n_=(n); if(n_==0){asm volatile("s_waitcnt vmcnt(0) lgkmcnt(0)\n\ts_barrier":::"memory");} else if(n_==2){asm volatile("s_waitcnt vmcnt(2) lgkmcnt(0)\n\ts_barrier":::"memory");} \
  else if(n_==3){asm volatile("s_waitcnt vmcnt(3) lgkmcnt(0)\n\ts_barrier":::"memory");} else if(n_==5){asm volatile("s_waitcnt vmcnt(5) lgkmcnt(0)\n\ts_barrier":::"memory");} else {asm volatile("s_waitcnt vmcnt(6) lgkmcnt(0)\n\ts_barrier":::"memory");} }while(0)
template<int THRL> __device__ __forceinline__ void attn4_unit(int b,int hq,int hv,int ho,int qb,const bf16*Q,const bf16*__restrict__ K,const bf16*__restrict__ V,bf16*O,char*shm){
  const int tid=threadIdx.x,lane=tid&63,r32=lane&31,hi=lane>>5; const int wid=__builtin_amdgcn_readfirstlane(tid>>6); const int grp=(ATTN4_GRP);
  const long rowbase=(long)b*SEQ; const int q0=qb*QB;
  const bf16*Qw=Q+(rowbase+q0+wid*QBLK)*DM+hq*D;
  const bf16*Kh=K+rowbase*DM+hq*D,*Vh=V+rowbase*DM+hv*D;
  const unsigned lds0=(unsigned)(uintptr_t)shm;
  float*wsf=(float*)(shm+L4_WS)+wid*64;
  const bf16*ksrc=Kh+(long)lane*DM+wid*8;
  const bf16*vsrc=Vh+(long)(16*(wid&3)+(lane>>2))*DM+(wid>>2)*32+(lane&3)*8;
  const unsigned kdst=lds0+L4_K+wid*1024, vdst=lds0+L4_V+wid*1024;
  #define DMA4_K(t,sl) glds16(ksrc+(long)(t)*KVBLK*DM,(unsigned)__builtin_amdgcn_readfirstlane(kdst+(sl)*8192))
  #define DMA4_V(t,sl) do{ glds16(vsrc+(long)(t)*KVBLK*DM,(unsigned)__builtin_amdgcn_readfirstlane(vdst+(sl)*16384)); glds16(vsrc+64+(long)(t)*KVBLK*DM,(unsigned)__builtin_amdgcn_readfirstlane(vdst+(sl)*16384+8192)); }while(0)
  const int vb0=(int)(lds0+L4_V)+((lane>>4)&1)*32+(lane&3)*8+(4*hi+((lane&15)>>2))*64;
  const int NT=(q0+QB)/KVBLK;
  bf16x8 qr[4];
  #pragma unroll
  for(int d0=0;d0<4;++d0)qr[d0]=*reinterpret_cast<const bf16x8*>(&Qw[(long)r32*DM+d0*16+hi*8]);
  asm volatile("":"+v"(qr[0]),"+v"(qr[1]),"+v"(qr[2]),"+v"(qr[3]));
  DMA4_K(0,0);DMA4_V(0,0);DMA4_K(1,1);DMA4_V(1,1);
  float mhat=0.f,l_reg=0.f;f32x16 o[4];o[0]=f32x16{};o[1]=f32x16{};o[2]=f32x16{};o[3]=f32x16{};f32x16 negm=f32x16{};asm volatile("":"+v"(negm));
  if(grp){ WAITBARN(5); }
  for(int t=0;t<NT;++t){
    const int sl=t&3;
    if(grp==0){ WAITBARN(t+1<NT?5:2); } else { WAITBARN(t+1<NT?3:0); }
    if(t+2<NT){ DMA4_K(t+2,(t+2)&3); DMA4_V(t+2,(t+2)&3); }
    const bool live=!(t-(NT-4)>(wid>>1));
    u32x4 pw0,pw1,pw2,pw3; bool resc=false;
    if(live){
      f32x16 p0,p1;
      qkt(p0,p1,shm+L4_K+sl*8192,qr,negm,r32,hi); asm volatile("s_nop 15\n\ts_nop 7":"+v"(p0),"+v"(p1));
      const float rm=rowmax(p0,p1);
      if(t==0){ const float dl=rm; mhat+=dl;
        #pragma unroll
        for(int r=0;r<16;++r){p0[r]-=dl;p1[r]-=dl;}
        #pragma unroll
        for(int r=0;r<16;++r)negm[r]=-mhat; asm volatile("":"+v"(negm)); }
      else if(__any(rm>(float)THRL)){ const float dl=__builtin_fmaxf(rm,0.f); mhat+=dl;
        #pragma unroll
        for(int r=0;r<16;++r){p0[r]-=dl;p1[r]-=dl;}
        #pragma unroll
        for(int r=0;r<16;++r)negm[r]=-mhat; asm volatile("":"+v"(negm));
        const float f=__builtin_amdgcn_exp2f(-dl); l_reg*=f; if(hi==0)wsf[r32]=f; resc=true; }
      float sacc=0.f;
      #pragma unroll
      for(int r=0;r<16;++r){p0[r]=__builtin_amdgcn_exp2f(p0[r]);p1[r]=__builtin_amdgcn_exp2f(p1[r]);sacc+=p0[r]+p1[r];}
      l_reg+=sacc;
      pw0=(u32x4){cvtpk_s(p0[0],p0[1]),cvtpk_s(p0[2],p0[3]),cvtpk_s(p0[4],p0[5]),cvtpk_s(p0[6],p0[7])};
      pw1=(u32x4){cvtpk_s(p0[8],p0[9]),cvtpk_s(p0[10],p0[11]),cvtpk_s(p0[12],p0[13]),cvtpk_s(p0[14],p0[15])};
      pw2=(u32x4){cvtpk_s(p1[0],p1[1]),cvtpk_s(p1[2],p1[3]),cvtpk_s(p1[4],p1[5]),cvtpk_s(p1[6],p1[7])};
      pw3=(u32x4){cvtpk_s(p1[8],p1[9]),cvtpk_s(p1[10],p1[11]),cvtpk_s(p1[12],p1[13]),cvtpk_s(p1[14],p1[15])};
      if(resc){ asm volatile("s_waitcnt lgkmcnt(0)":::"memory");
        #pragma unroll
        for(int r=0;r<16;++r){ const float f=wsf[crow(r,hi)]; o[0][r]*=f;o[1][r]*=f;o[2][r]*=f;o[3][r]*=f; } }
    }
    if(grp==0){ WAITBARN(t+2<NT?6:(t+1<NT?3:0)); } else { WAITBARN(t+2<NT?5:(t+1<NT?2:0)); }
    if(live){
      SBAR();
      pv(o,vb0+sl*16384,__builtin_bit_cast(bf16x8,pw0),__builtin_bit_cast(bf16x8,pw1),__builtin_bit_cast(bf16x8,pw2),__builtin_bit_cast(bf16x8,pw3));
      pv(o+2,vb0+sl*16384+8192,__builtin_bit_cast(bf16x8,pw0),__builtin_bit_cast(bf16x8,pw1),__builtin_bit_cast(bf16x8,pw2),__builtin_bit_cast(bf16x8,pw3));
    }
  }
  if(grp==0){ asm volatile("s_waitcnt lgkmcnt(0)\n\ts_barrier":::"memory"); }
  {auto rr=__builtin_amdgcn_permlane32_swap(__float_as_uint(l_reg),__float_as_uint(l_reg),false,false);l_reg=__uint_as_float(rr[0])+__uint_as_float(rr[1]);}
  if(hi==0)wsf[32+r32]=l_reg;asm volatile("s_waitcnt lgkmcnt(0)":::"memory");
  float rli[16];
  #pragma unroll
  for(int r=0;r<16;++r)rli[r]=__builtin_amdgcn_rcpf(wsf[32+crow(r,hi)]);
  bf16*stg=(bf16*)(shm+L4_OST)+wid*2048;
  #pragma unroll
  for(int hf=0;hf<2;++hf){
    bf16*Ow=O+(rowbase+q0+wid*QBLK)*OP+(ho+hf)*D;
    #pragma unroll
    for(int r=0;r<16;++r){const int orow=crow(r,hi);
      #pragma unroll
      for(int d0=0;d0<2;++d0)stg[orow*64+d0*32+r32]=__float2bfloat16(o[2*hf+d0][r]*rli[r]);}
    asm volatile("s_waitcnt lgkmcnt(0)":::"memory");
    #pragma unroll
    for(int i=0;i<4;++i){const int row=i*8+(lane>>3),ch=lane&7; const u32x4 v=*(const u32x4*)(stg+row*64+ch*8); ATTN_STORE16(Ow+(long)row*OP+ch*8,v);}
    asm volatile("s_waitcnt lgkmcnt(0)":::"memory");
  }
  asm volatile("s_waitcnt lgkmcnt(0)\n\ts_barrier":::"memory");
  #undef DMA4_K
  #undef DMA4_V
}
template<class Sched,int THRL=8> __device__ __forceinline__ void attn4_phase(char*lds,const AttnTensors&T,const Sched&S){
  AttnUnit2 u;
  for(int i=0;S.next(i,u);++i){ attn4_unit<THRL>(u.b,u.hq,u.hv,u.ho,u.qb,T.Q,T.K,T.V,T.O,lds); }
}
template<int THRL> __device__ __forceinline__ void attn5_unit(int b,int h,int hv,int ho,int qb,const bf16*Q,const bf16*__restrict__ K,const bf16*__restrict__ V,bf16*O,char*shm,const float*qg,const float*ropec,const float*ropes){
  const int tid=threadIdx.x,lane=tid&63,r32=lane&31,hi=lane>>5; const int wid=__builtin_amdgcn_readfirstlane(tid>>6);
  const long rowbase=(long)b*SEQ; const int q0=qb*QB;
  const bf16*Qw=Q+(rowbase+q0+wid*QBLK)*DM+h*D;
  const bf16*Kh=K+rowbase*DM+h*D,*Vh=V+rowbase*DM+hv*D;
  const unsigned lds0=(unsigned)(uintptr_t)shm;
  float*wsf=(float*)(shm+L2_WS)+wid*64;
  const bf16*ksrc=Kh+(long)lane*DM+wid*8;
  const bf16*vsrc=Vh+(long)(16*(wid&3)+(lane>>2))*DM+(wid>>2)*32+(lane&3)*8;
  const unsigned kdst=lds0+L2_K+wid*1024, vdst=lds0+L2_V+wid*1024;
  #define DMA_K(t,slot) glds16(ksrc+(long)(t)*KVBLK*DM,(unsigned)__builtin_amdgcn_readfirstlane(kdst+(slot)))
  #define DMA_V(t,slot) do{ glds16(vsrc+(long)(t)*KVBLK*DM,(unsigned)__builtin_amdgcn_readfirstlane(vdst+2*(slot))); glds16(vsrc+64+(long)(t)*KVBLK*DM,(unsigned)__builtin_amdgcn_readfirstlane(vdst+2*(slot)+8192)); }while(0)
  const int vb0=(int)(lds0+L2_V)+((lane>>4)&1)*32+(lane&3)*8+(4*hi+((lane&15)>>2))*64;
  const char*Kbase=shm+L2_K; bf16x8 kf[8];
  const lds_cptr shm3=(lds_cptr)shm; const lds_cptr kp0=shm3+L2_K+hi*1024+r32*16; const lds_cptr vp0=shm3+L2_V+((lane>>4)&1)*32+(lane&3)*8+(4*hi+((lane&15)>>2))*64;
  const int NT=(q0+QB)/KVBLK;
  DMA_K(0,0);DMA_V(0,0);DMA_K(1,SLOTB);
  bf16x8 qr[4];
  #pragma unroll
  for(int d0=0;d0<4;++d0)qr[d0]=*reinterpret_cast<const bf16x8*>(&Qw[(long)r32*DM+d0*16+hi*8]);
  if(qg){
    float x[4][8]; float ssq=0.f;
    #pragma unroll
    for(int d0=0;d0<4;++d0){
      #pragma unroll
      for(int e=0;e<8;++e){ x[d0][e]=__uint_as_float(((unsigned)(unsigned short)qr[d0][e])<<16); ssq+=x[d0][e]*x[d0][e]; } }
    ssq+=__shfl_xor(ssq,32);
    const float rstd=C2/sqrtf(ssq*(1.f/64.f)+1e-6f);
    const int pos=q0+wid*QBLK+r32;
    #pragma unroll
    for(int d0=0;d0<2;++d0){ const int i0=16*d0+8*hi; u32x4 w1,w2; float o1[8],o2[8];
      #pragma unroll
      for(int e=0;e<8;++e){ const float cs=ropec[(long)pos*32+i0+e],sn=ropes[(long)pos*32+i0+e]; const float a_=x[d0][e]*rstd*qg[i0+e],b_=x[d0+2][e]*rstd*qg[32+i0+e]; o1[e]=a_*cs-b_*sn; o2[e]=b_*cs+a_*sn; }
      w1=(u32x4){cvtpk_s(o1[0],o1[1]),cvtpk_s(o1[2],o1[3]),cvtpk_s(o1[4],o1[5]),cvtpk_s(o1[6],o1[7])}; w2=(u32x4){cvtpk_s(o2[0],o2[1]),cvtpk_s(o2[2],o2[3]),cvtpk_s(o2[4],o2[5]),cvtpk_s(o2[6],o2[7])};
      qr[d0]=__builtin_bit_cast(bf16x8,w1); qr[d0+2]=__builtin_bit_cast(bf16x8,w2); }
  }
  float mhat=0.f,l_reg=0.f;f32x16 o[4];o[0]=f32x16{};o[1]=f32x16{};o[2]=f32x16{};o[3]=f32x16{};f32x16 negm=f32x16{};asm volatile("":"+v"(negm));
  const int qrel=wid*QBLK+r32;
  #define CMASK(P0,P1,t) do{int jb_=(t)-(NT-4); if(jb_>=0)cmask(P0,P1,jb_,qrel,hi);}while(0)
  bool resc=false;
  #define START(P0,P1) do{ const float rm=rowmax(P0,P1); resc=false; \
    { const float dl=rm; mhat=fadd_s(mhat,dl); \
      _Pragma("unroll") for(int r=0;r<16;++r){P0[r]=fsub_s(P0[r],dl);P1[r]=fsub_s(P1[r],dl);} \
      _Pragma("unroll") for(int r=0;r<16;++r)negm[r]=-mhat; asm volatile("":"+v"(negm)); } \
    _Pragma("unroll") for(int r=0;r<16;++r)P0[r]=__builtin_amdgcn_exp2f(P0[r]); }while(0)
  #define RESC() do{ if(resc){ asm volatile("s_waitcnt lgkmcnt(0)":::"memory"); \
      _Pragma("unroll") for(int r=0;r<16;++r){ const float f_=wsf[crow(r,hi)]; o[0][r]*=f_;o[1][r]*=f_;o[2][r]*=f_;o[3][r]*=f_; } } }while(0)
  f32x16 pA0,pA1,pB0,pB1;
  int sl_prev=0,sl_cur=0,sl_next=SLOTB;
  #define ROT() do{sl_prev=sl_cur;sl_cur=sl_next;sl_next=(sl_next==(NSLOT-1)*SLOTB)?0:sl_next+SLOTB;}while(0)
  DMA_K(2,2*SLOTB);
  WAIT_BAR(4);
  qkt(pA0,pA1,Kbase,qr,negm,r32,hi);asm volatile("s_nop 15\n\ts_nop 7":"+v"(pA0),"+v"(pA1));CMASK(pA0,pA1,0);
  START(pA0,pA1);
  _Pragma("unroll") for(int r=0;r<16;++r)pA1[r]=__builtin_amdgcn_exp2f(pA1[r]);
  WAIT_BAR(0);
  DMA_K(3,0);DMA_V(1,SLOTB);
  ROT();
  kload8(kf,kp0+sl_cur);
  WAIT_BAR(3);
  s16x4 vlo[4],vhi[4]; u32x4 pw0,pw1,pw2,pw3;
  #define PKW(P,B) cvtpk_s(P[B],P[B+1])
  #define PAF(k) __builtin_bit_cast(bf16x8,pw##k)
  #define VFR(i) (bf16x8){vlo[i][0],vlo[i][1],vlo[i][2],vlo[i][3],vhi[i][0],vhi[i][1],vhi[i][2],vhi[i][3]}
  #define PIN(x) asm volatile("":"+v"(x))
  #define MX3(a,b,c) __builtin_fmaxf(__builtin_fmaxf((a),(b)),(c))
  #define GAPA(MF,A0,A1,A2,A3,W0,W1,PW) do{ MF; sacc+=A0; sacc+=A1; sacc+=A2; sacc+=A3; PIN(sacc); W0; W1; PIN(PW); SBAR(); }while(0)
  #define EX(v) __builtin_amdgcn_exp2f(v)
  #define GAPB(MF,X,B) do{ MF; X[B]=EX(X[B]); X[B+1]=EX(X[B+1]); PIN(X); SBAR(); }while(0)
  #define VOFF(j) ((((j)&3)>>1)*8192+((j)&1)*4096+((j)>>2)*1024)
  #define VRD(j) do{ vlo[(j)&3]=vtr(vp_+VOFF(j)); vhi[(j)&3]=vtr(vp_+(VOFF(j)+512)); }while(0)
  #define PVM(j,ks) o[(j)&3]=__builtin_amdgcn_mfma_f32_32x32x16_bf16(PAF(ks),VFR((j)&3),o[(j)&3],0,0,0)
  #define KRD(G,j) do{ if(G){ kload2(kf,kp0+sl_next,j); SBAR(); } }while(0)
  #define STEP(C0,C1,P0,P1,t,GK,GV,GL) do{ SBAR(); \
    const lds_cptr vp_=vp0+2*sl_prev; \
    float sacc=(P0[0]+P0[1]); \
    GAPA(C0=__builtin_amdgcn_mfma_f32_32x32x16_bf16(kf[0],qr[0],negm,0,0,0), P0[2],P0[3],P0[4],P0[5],     pw0[0]=PKW(P0,0), pw0[1]=PKW(P0,2), pw0); \
    GAPA(C1=__builtin_amdgcn_mfma_f32_32x32x16_bf16(kf[1],qr[0],negm,0,0,0), P0[6],P0[7],P0[8],P0[9],     pw0[2]=PKW(P0,4), pw0[3]=PKW(P0,6), pw0); \
    GAPA(C0=__builtin_amdgcn_mfma_f32_32x32x16_bf16(kf[2],qr[1],C0,0,0,0),   P0[10],P0[11],P0[12],P0[13], pw1[0]=PKW(P0,8), pw1[1]=PKW(P0,10), pw1); \
    GAPA(C1=__builtin_amdgcn_mfma_f32_32x32x16_bf16(kf[3],qr[1],C1,0,0,0),   P0[14],P0[15],P1[0],P1[1],   pw1[2]=PKW(P0,12),pw1[3]=PKW(P0,14), pw1); \
    GAPA(C0=__builtin_amdgcn_mfma_f32_32x32x16_bf16(kf[4],qr[2],C0,0,0,0),   P1[2],P1[3],P1[4],P1[5],     pw2[0]=PKW(P1,0), pw2[1]=PKW(P1,2), pw2); \
    VRD(0); SBAR(); GAPA(C1=__builtin_amdgcn_mfma_f32_32x32x16_bf16(kf[5],qr[2],C1,0,0,0),   P1[6],P1[7],P1[8],P1[9],     pw2[2]=PKW(P1,4), pw2[3]=PKW(P1,6), pw2); \
    VRD(1); SBAR(); GAPA(C0=__builtin_amdgcn_mfma_f32_32x32x16_bf16(kf[6],qr[3],C0,0,0,0),   P1[10],P1[11],P1[12],P1[13], pw3[0]=PKW(P1,8), pw3[1]=PKW(P1,10), pw3); \
    VRD(2); SBAR(); GAPA(C1=__builtin_amdgcn_mfma_f32_32x32x16_bf16(kf[7],qr[3],C1,0,0,0),   P1[14],P1[15],0.f,0.f,       pw3[2]=PKW(P1,12),pw3[3]=PKW(P1,14), pw3); \
    l_reg+=sacc; \
    if(GK){DMA_K((t)+3,sl_cur);} if(GV){DMA_V((t)+1,sl_next);} \
    CMASK(C0,C1,t); \
    { float a=MX3(C0[0],C0[1],C1[0]),b=MX3(C0[2],C0[3],C1[1]); a=MX3(a,C1[2],C1[3]); \
      _Pragma("unroll") for(int r=4;r<16;r+=4){a=MX3(a,C0[r],C0[r+1]);b=MX3(b,C0[r+2],C0[r+3]);a=MX3(a,C1[r],C1[r+1]);b=MX3(b,C1[r+2],C1[r+3]);} \
      float rm=__builtin_fmaxf(a,b); { auto rr=__builtin_amdgcn_permlane32_swap(__float_as_uint(rm),__float_as_uint(rm),false,false); rm=__builtin_fmaxf(__uint_as_float(rr[0]),__uint_as_float(rr[1])); } \
      resc=false; \
      if(__builtin_expect(__any(rm>(float)THRL),0)){ const float dl=__builtin_fmaxf(rm,0.f); mhat+=dl; \
        _Pragma("unroll") for(int r=0;r<16;++r){C0[r]-=dl;C1[r]-=dl;} \
        _Pragma("unroll") for(int r=0;r<16;++r)negm[r]=-mhat; asm volatile("":"+v"(negm)); \
        const float f=__builtin_amdgcn_exp2f(-dl); l_reg*=f; if(hi==0)wsf[r32]=f; resc=true; } } \
    SBAR(); \
    VRD(3); SBAR(); GAPB(PVM(0,0), C0,0); \
    VRD(4); SBAR(); GAPB(PVM(1,0), C0,2); \
    VRD(5); SBAR(); GAPB(PVM(2,0), C0,4); \
    VRD(6); SBAR(); GAPB(PVM(3,0), C0,6); \
    VRD(7); SBAR(); GAPB(PVM(4,1), C0,8); \
    VRD(8); SBAR(); KRD(GL,0); GAPB(PVM(5,1), C0,10); \
    VRD(9); SBAR(); GAPB(PVM(6,1), C0,12); \
    VRD(10); SBAR(); KRD(GL,1); GAPB(PVM(7,1), C0,14); \
    VRD(11); SBAR(); GAPB(PVM(8,2), C1,0); \
    VRD(12); SBAR(); KRD(GL,2); GAPB(PVM(9,2), C1,2); \
    VRD(13); SBAR(); GAPB(PVM(10,2), C1,4); \
    VRD(14); SBAR(); KRD(GL,3); GAPB(PVM(11,2), C1,6); \
    VRD(15); SBAR(); GAPB(PVM(12,3), C1,8); \
    GAPB(PVM(13,3), C1,10); \
    GAPB(PVM(14,3), C1,12); \
    GAPB(PVM(15,3), C1,14); \
    }while(0)
  int t=1;
  #undef CMASK
  #define CMASK(P0,P1,t) do{}while(0)
  for(;t+5<NT;t+=2){
    STEP(pB0,pB1,pA0,pA1,t,true,true,true);     WAIT_BAR(3); RESC(); ROT();
    STEP(pA0,pA1,pB0,pB1,t+1,true,true,true);   WAIT_BAR(3); RESC(); ROT();
  }
  #undef CMASK
  #define CMASK(P0,P1,t) do{int jb_=(t)-(NT-4); if(jb_>=0)cmask(P0,P1,jb_,qrel,hi);}while(0)
  #define ENDW(tt) do{ if((tt)+3<NT){WAIT_BAR(3);} else if((tt)+2<NT){WAIT_BAR(2);} else {WAIT_BAR(0);} }while(0)
  for(;t+1<NT;t+=2){
    STEP(pB0,pB1,pA0,pA1,t,(t+3<NT),(t+1<NT),(t+1<NT));       ENDW(t);   RESC(); ROT();
    STEP(pA0,pA1,pB0,pB1,t+1,(t+4<NT),(t+2<NT),(t+2<NT));     ENDW(t+1); RESC(); ROT();
  }
  STEP(pB0,pB1,pA0,pA1,NT-1,false,false,false); RESC();
  { float sacc=pB0[0]+pB0[1]; _Pragma("unroll") for(int r=2;r<16;++r)sacc+=pB0[r]; _Pragma("unroll") for(int r=0;r<16;++r)sacc+=pB1[r]; l_reg+=sacc;
    pw0=(u32x4){PKW(pB0,0),PKW(pB0,2),PKW(pB0,4),PKW(pB0,6)};pw1=(u32x4){PKW(pB0,8),PKW(pB0,10),PKW(pB0,12),PKW(pB0,14)};pw2=(u32x4){PKW(pB1,0),PKW(pB1,2),PKW(pB1,4),PKW(pB1,6)};pw3=(u32x4){PKW(pB1,8),PKW(pB1,10),PKW(pB1,12),PKW(pB1,14)};
    SBAR(); pv(o,vb0+2*sl_cur,PAF(0),PAF(1),PAF(2),PAF(3)); pv(o+2,vb0+2*sl_cur+8192,PAF(0),PAF(1),PAF(2),PAF(3)); }
  #undef PKW
  #undef PAF
  #undef VFR
  #undef PIN
  #undef MX3
  #undef GAPA
  #undef GAPB
  #undef EX
  #undef VRD
  #undef VOFF
  #undef PVM
  #undef KRD
  #undef STEP
  #undef ENDW
  {auto rr=__builtin_amdgcn_permlane32_swap(__float_as_uint(l_reg),__float_as_uint(l_reg),false,false);l_reg=__uint_as_float(rr[0])+__uint_as_float(rr[1]);}
  if(hi==0)wsf[32+r32]=l_reg;asm volatile("s_waitcnt lgkmcnt(0)":::"memory");
  float rli[16];
  #pragma unroll
  for(int r=0;r<16;++r)rli[r]=__builtin_amdgcn_rcpf(wsf[32+crow(r,hi)]);
  bf16*stg=(bf16*)(shm+L2_OST)+wid*2048;
  #pragma unroll
  for(int hf=0;hf<2;++hf){
    bf16*Ow=O+(rowbase+q0+wid*QBLK)*OP+(ho+hf)*D;
    #pragma unroll
    for(int r=0;r<16;++r){const int orow=crow(r,hi);
      #pragma unroll
      for(int d0=0;d0<2;++d0)stg[orow*64+d0*32+r32]=__float2bfloat16(o[2*hf+d0][r]*rli[r]);}
    asm volatile("s_waitcnt lgkmcnt(0)":::"memory");
    #pragma unroll
    for(int i=0;i<4;++i){const int row=i*8+(lane>>3),ch=lane&7; const u32x4 v=*(const u32x4*)(stg+row*64+ch*8); ATTN_STORE16(Ow+(long)row*OP+ch*8,v);}
    asm volatile("s_waitcnt lgkmcnt(0)":::"memory");
  }
  asm volatile("s_waitcnt lgkmcnt(0)\n\ts_barrier":::"memory");
  #undef DMA_K
  #undef DMA_V
  #undef CMASK
  #undef START
  #undef RESC
  #undef ROT
}
template<class Sched,int THRL=8> __device__ __forceinline__ void attn5_phase(char*lds,const AttnTensors&T,const Sched&S){
  AttnUnit2 u;
  for(int i=0;S.next(i,u);++i){ attn5_unit<THRL>(u.b,u.hq,u.hv,u.ho,u.qb,T.Q,T.K,T.V,T.O,lds,T.qg,T.ropec,T.ropes); }
}
#undef SBAR
#undef WAIT_BAR
}

#define GAS __attribute__((address_space(1)))
#define LAS __attribute__((address_space(3)))
typedef unsigned short bfu;
typedef unsigned v4u __attribute__((ext_vector_type(4)));
typedef unsigned v2u __attribute__((ext_vector_type(2)));
typedef float f32x4 __attribute__((ext_vector_type(4)));
using pg8::Unit; using pg8::UP; using pg8::st8; using pg8::cvt_pk_bf16;

constexpr int NB = 4, SEQ = 8192, DM = 1024, T = NB * SEQ;
constexpr int NWAVES = 8, NTHR = 512;
constexpr float NORM_EPS = 1e-6f;
constexpr float LAMBDA_INIT = 0.2f;
constexpr int NSLOT_MAX = 131072 + 32 * 256;

constexpr size_t MiB = 1u << 20;
constexpr size_t WS_CTL = 0, CTL_ZERO_BYTES = 4 * MiB;
constexpr int CW_TMO = 0, CW_BAR = 4096;
constexpr size_t WS_DEN = 1 * MiB, WS_CAROWP = 2 * MiB;
constexpr size_t WS_DENP = 16 * MiB;
constexpr size_t WS_CASQP = 16 * MiB;
constexpr size_t WS_SMALL = 4 * MiB;
constexpr size_t SM_IPRE = WS_SMALL, SM_FPRE = SM_IPRE + 512 * 1024, SM_AA = SM_FPRE + 512 * 1024, SM_GG = SM_AA + 512 * 1024, SM_MM = SM_GG + 512 * 1024,
                 SM_QN = SM_MM + 512 * 1024, SM_DN = SM_QN + 512 * 1024, SM_UQK = SM_DN + 512 * 1024, SM_UV = SM_UQK + 64 * 1024, SM_LAM = SM_UV + 64 * 1024, SM_INVF = SM_LAM + 1024,
                 SM_ROPEC = WS_SMALL + 4 * MiB, SM_ROPES = WS_SMALL + 5 * MiB, SM_MEMN = WS_SMALL + 6 * MiB, SM_KCA = WS_SMALL + 8 * MiB, SM_VCAT = WS_SMALL + 10 * MiB,
                 SM_TOPI = WS_SMALL + 12 * MiB, SM_TOPW = SM_TOPI + 512 * 1024, SM_SLOTOF = SM_TOPW + 512 * 1024, SM_WGCNT = SM_SLOTOF + 512 * 1024, SM_META = SM_WGCNT + 64 * 1024,
                 SM_TOK = WS_SMALL + 14 * MiB, SM_WSRT = SM_TOK + 768 * 1024;
constexpr size_t WS_WINT = 20 * MiB, WS_CAKVT = 42 * MiB, WS_WBDAT = 46 * MiB, WS_WBMLT = 48 * MiB, WS_WBCAT = 52 * MiB, WS_WOUTT = 54 * MiB;
constexpr size_t WS_XN = 56 * MiB;
constexpr int LDT = SEQ + 64;
constexpr size_t WS_R3 = 120 * MiB, WS_R1 = 248 * MiB, WS_R2 = 376 * MiB, WS_R4 = 504 * MiB, WS_R5 = 633 * MiB, WS_R6 = 762 * MiB, WS_R7 = 890 * MiB, WS_END = 1018 * MiB;
static_assert((size_t)16 * 512 * LDT * 2 <= 129 * MiB, "padded transposed tensors fit their regions");
constexpr size_t WS_KNAT = WS_R3, WS_HH = WS_R3, WS_MLX = WS_R1, WS_QNAT = WS_R2, WS_KT = WS_R4, WS_VT = WS_R5, WS_C = WS_R6, WS_S = WS_R7;
constexpr size_t WS_O = WS_R1, WS_DAQ = 376 * MiB, WS_DAK = 440 * MiB, WS_DAV = 504 * MiB, WS_CAQ = 568 * MiB, WS_GATE = 632 * MiB, WS_WDT = 824 * MiB, WS_WGUT = 888 * MiB;
constexpr size_t WS_MIXBF = 440 * MiB, WS_A2 = 120 * MiB, WS_Y = 392 * MiB;
constexpr size_t WS_XN8 = 856 * MiB, WS_WG8 = 984 * MiB;
static_assert(SM_WSRT + NSLOT_MAX * 4 <= WS_WINT && SM_TOK + NSLOT_MAX * 4 <= SM_WSRT, "small map");

constexpr int SCR_BYTES = 135168;
constexpr int LDSCTL_OFF = SCR_BYTES, MISC_OFF = LDSCTL_OFF + 320, BIAS_OFF = 147456, LDS_BYTES = 159744;

#define RLX_AGENT __ATOMIC_RELAXED, __HIP_MEMORY_SCOPE_AGENT
#define LDS_WAIT() asm volatile("s_waitcnt lgkmcnt(0)" ::: "memory")
#define VM_WAIT() asm volatile("s_waitcnt vmcnt(0)" ::: "memory")
__device__ __forceinline__ unsigned f2bf(float f) { unsigned u = __builtin_bit_cast(unsigned, f); return (u + 0x7fffu + ((u >> 16) & 1u)) >> 16; }
__device__ __forceinline__ unsigned pk2(float lo, float hi) { return cvt_pk_bf16(lo, hi); }
__device__ __forceinline__ float bflo(unsigned w) { return __builtin_bit_cast(float, w << 16); }
__device__ __forceinline__ float bfhi(unsigned w) { return __builtin_bit_cast(float, w & 0xffff0000u); }
__device__ __forceinline__ float fexp(float x) { return __builtin_amdgcn_exp2f(x * 1.4426950408889634f); }
__device__ __forceinline__ float frcp(float x) { return __builtin_amdgcn_rcpf(x); }
__device__ __forceinline__ float fsigmoid(float x) { return frcp(1.f + fexp(-x)); }
__device__ __forceinline__ float fsilu(float x) { return x * fsigmoid(x); }
__device__ __forceinline__ float wave_sum(float v) {
#pragma unroll
    for (int o = 1; o < 64; o <<= 1) v += __shfl_xor(v, o);
    return v;
}
__device__ __forceinline__ float wave_max(float v) {
#pragma unroll
    for (int o = 1; o < 64; o <<= 1) v = fmaxf(v, __shfl_xor(v, o));
    return v;
}

#ifndef FAST_BAR
#define FAST_BAR 1
#endif
#define XB_TMO      128
#define XB_XCNT(j)  (256  + 64 * (j))
#define XB_XSUB(j)  (1280 + 64 * (j))
#define XB_XGEN(j)  (2304 + 64 * (j))
#define XB_TOP      3328
#define XB_TOPGEN   3392
#define XCD_BAR_WORDS 3456
#define XB_SPIN_CAP (1u << 18)
__device__ __forceinline__ unsigned xb_ld(unsigned* p)              { return __hip_atomic_load(p, __ATOMIC_RELAXED, __HIP_MEMORY_SCOPE_AGENT); }
__device__ __forceinline__ unsigned xb_add(unsigned* p, unsigned v) { return __hip_atomic_fetch_add(p, v, __ATOMIC_RELAXED, __HIP_MEMORY_SCOPE_AGENT); }
__device__ __forceinline__ unsigned xb_xcc_id() { return (unsigned)__builtin_amdgcn_s_getreg((3 << 11) | 20) & 0xFu; }
#define XB_SPIN(cond, bar) do { unsigned _sp = 0; while (cond) { __builtin_amdgcn_s_sleep(1); \
    if ((++_sp & 255u) == 0u) { if (xb_ld(&(bar)[XB_TMO])) break; if (_sp > XB_SPIN_CAP) { atomicAdd(&(bar)[XB_TMO], 1u); break; } } } } while (0)
struct XcdBarrier { unsigned* bar; unsigned x; volatile LAS unsigned* st; };
__device__ __forceinline__ XcdBarrier xcd_barrier_post(unsigned* bar, volatile LAS unsigned* st) {
    XcdBarrier b; b.bar = bar; b.x = xb_xcc_id(); b.st = st;
    if (threadIdx.x == 0) (void)xb_add(&bar[XB_XCNT(b.x)], 1u);
    return b;
}
__device__ __forceinline__ void xcd_barrier_complete(unsigned* bar, unsigned x, unsigned& nloc, unsigned& nx) {
    const unsigned G = gridDim.x * gridDim.y * gridDim.z;
    unsigned sum, cnt, mine, sp = 0u;
    for (;;) {
        sum = 0u; cnt = 0u; mine = 0u;
#pragma unroll
        for (unsigned j = 0; j < 16; ++j) { const unsigned c = xb_ld(&bar[XB_XCNT(j)]); sum += c; cnt += (c > 0u) ? 1u : 0u; mine = (j == x) ? c : mine; }
        if (sum == G) break;
        __builtin_amdgcn_s_sleep(1);
        if ((++sp & 255u) == 0u) { if (xb_ld(&bar[XB_TMO])) break; if (sp > XB_SPIN_CAP) { atomicAdd(&bar[XB_TMO], 1u); break; } }
    }
    nloc = mine > 0u ? mine : 1u; nx = cnt > 0u ? cnt : 1u;
}
__device__ __forceinline__ void xcd_barrier(const XcdBarrier& b) {
    asm volatile("s_waitcnt vmcnt(0)" ::: "memory");
    __syncthreads();
    if (threadIdx.x == 0) {
        unsigned* bar = b.bar;
        __builtin_amdgcn_s_waitcnt(0);
        unsigned nloc = b.st[0], nx = b.st[1];
        if (nloc == 0u) { xcd_barrier_complete(bar, b.x, nloc, nx); b.st[0] = nloc; b.st[1] = nx; }
        const unsigned old = xb_add(&bar[XB_XSUB(b.x)], 1u);
        const unsigned gen = old / nloc;
        if (old + 1u == (gen + 1u) * nloc) {
            __builtin_amdgcn_fence(__ATOMIC_RELEASE, "agent");
            asm volatile("s_waitcnt vmcnt(0)" ::: "memory");
            const unsigned og = xb_add(&bar[XB_TOP], 1u);
            const unsigned tg = og / nx;
#if FAST_BAR
            if (og + 1u == (tg + 1u) * nx) { _Pragma("clang loop unroll(disable)") for (unsigned j = 0; j < 16u; ++j) (void)__hip_atomic_fetch_add(&bar[XB_XGEN(j)], 1u, __ATOMIC_RELAXED, __HIP_MEMORY_SCOPE_AGENT); }
            else XB_SPIN(xb_ld(&bar[XB_XGEN(b.x)]) == gen, bar);
            __builtin_amdgcn_fence(__ATOMIC_ACQUIRE, "agent");
#else
            if (og + 1u == (tg + 1u) * nx) xb_add(&bar[XB_TOPGEN], 1u);
            else XB_SPIN(xb_ld(&bar[XB_TOPGEN]) == tg, bar);
            __builtin_amdgcn_fence(__ATOMIC_ACQUIRE, "agent");
            xb_add(&bar[XB_XGEN(b.x)], 1u);
            asm volatile("s_waitcnt vmcnt(0)" ::: "memory");
#endif
        } else {
            XB_SPIN(xb_ld(&bar[XB_XGEN(b.x)]) == gen, bar);
            __builtin_amdgcn_fence(__ATOMIC_ACQUIRE, "agent");
            asm volatile("s_waitcnt vmcnt(0)" ::: "memory");
        }
    }
    __syncthreads();
}

struct Args { const float* in[36]; float* out; unsigned char* ws; };
enum { I_X = 0, I_MEM, I_ATTN_G, I_WIN, I_BGATE, I_DAQG, I_DAKG, I_LQ1, I_LK1, I_LQ2, I_LK2, I_SUBG, I_CONVW, I_CONVB, I_WQ, I_WK, I_WV, I_WIF, I_BIF, I_MLNG, I_SKIP,
       I_MEMG, I_CAWKV, I_CAQG, I_CAKG, I_WBDA, I_WBML, I_WBCA, I_WOUT, I_FFNG, I_RW, I_RB, I_WGU, I_BGU, I_WD, I_BD };

struct Frame {
    LAS unsigned char* lds; int tid, lane, wave, bid, G;
    const Args* a; unsigned char* ws;
};
#define WSP(type, off) ((type*)(F.ws + (off)))

__device__ __forceinline__ void transpose64(const float* W, int N, int K, int k0, int n0, bfu* dst, int drow0, LAS float* scr, int lane, int drow1 = -1) {
    f32x4 v[16];
#pragma unroll
    for (int i = 0; i < 16; ++i) v[i] = *(const GAS f32x4*)(W + (size_t)(k0 + 4 * i + (lane >> 4)) * N + n0 + 4 * (lane & 15));
#pragma unroll
    for (int i = 0; i < 16; ++i) { LAS float* d = scr + (4 * i + (lane >> 4)) * 65 + 4 * (lane & 15); d[0] = v[i].x; d[1] = v[i].y; d[2] = v[i].z; d[3] = v[i].w; }
    LDS_WAIT(); asm volatile("" ::: "memory");
    const int c = lane & 7;
#pragma unroll
    for (int j = 0; j < 8; ++j) { const int n = (lane >> 3) + 8 * j; const LAS float* sp = scr + (8 * c) * 65 + n;
        v4u o; o.x = pk2(sp[0 * 65], sp[1 * 65]); o.y = pk2(sp[2 * 65], sp[3 * 65]); o.z = pk2(sp[4 * 65], sp[5 * 65]); o.w = pk2(sp[6 * 65], sp[7 * 65]);
        const int orow = (drow1 >= 0 && n >= 32) ? drow1 + n - 32 : drow0 + n;
        *(GAS v4u*)(dst + (size_t)orow * K + k0 + 8 * c) = o; }
    LDS_WAIT(); asm volatile("" ::: "memory");
}
__device__ __forceinline__ float clamp448(float x) { return fminf(fmaxf(x, -448.f), 448.f); }
__device__ __forceinline__ unsigned pk4fp8(float a, float b, float c, float d) { int w = __builtin_amdgcn_cvt_pk_fp8_f32(clamp448(a), clamp448(b), 0, false); w = __builtin_amdgcn_cvt_pk_fp8_f32(clamp448(c), clamp448(d), w, true); return (unsigned)w; }
#ifndef MIXQ
#define MIXQ 0
#endif
__device__ __forceinline__ float rt8(float x) { const int w = __builtin_amdgcn_cvt_pk_fp8_f32(clamp448(16.f * x), 0.f, 0, false); return __builtin_amdgcn_cvt_f32_fp8(w, 0) * (1.f / 16.f); }
__device__ __forceinline__ void transpose64_fp8(const float* W, int N, int K, int k0, int n0, unsigned char* dst, int drow0, LAS float* scr, int lane) {
    f32x4 v[16];
#pragma unroll
    for (int i = 0; i < 16; ++i) v[i] = *(const GAS f32x4*)(W + (size_t)(k0 + 4 * i + (lane >> 4)) * N + n0 + 4 * (lane & 15));
#pragma unroll
    for (int i = 0; i < 16; ++i) { LAS float* d = scr + (4 * i + (lane >> 4)) * 65 + 4 * (lane & 15); d[0] = v[i].x; d[1] = v[i].y; d[2] = v[i].z; d[3] = v[i].w; }
    LDS_WAIT(); asm volatile("" ::: "memory");
    const int c = lane & 7;
#pragma unroll
    for (int j = 0; j < 8; ++j) { const int n = (lane >> 3) + 8 * j; const LAS float* sp = scr + (8 * c) * 65 + n;
        v2u o; o.x = pk4fp8(64.f * sp[0 * 65], 64.f * sp[1 * 65], 64.f * sp[2 * 65], 64.f * sp[3 * 65]); o.y = pk4fp8(64.f * sp[4 * 65], 64.f * sp[5 * 65], 64.f * sp[6 * 65], 64.f * sp[7 * 65]);
        *(GAS v2u*)(dst + (size_t)(drow0 + n) * K + k0 + 8 * c) = o; }
    LDS_WAIT(); asm volatile("" ::: "memory");
}
__device__ __forceinline__ void transpose_plain(const float* W, int K, int N, bfu* WT, int item, LAS float* scr, int lane) {
    const int nblk = N / 64, kb = item / nblk, nb = item % nblk;
    transpose64(W, N, K, 64 * kb, 64 * nb, WT, 64 * nb, scr, lane);
}
__device__ __forceinline__ void rms_rows2_to_bf16(const float* xrow, const float* g, bfu* orow, int lane) {
    const GAS f32x4* gr = (const GAS f32x4*)g + lane;
    f32x4 v[2][4]; float s[2] = {0.f, 0.f};
#pragma unroll
    for (int r = 0; r < 2; ++r)
#pragma unroll
        for (int j = 0; j < 4; ++j) v[r][j] = ((const GAS f32x4*)(xrow + (size_t)r * 1024) + lane)[64 * j];
#pragma unroll
    for (int r = 0; r < 2; ++r)
#pragma unroll
        for (int j = 0; j < 4; ++j) s[r] += (v[r][j].x * v[r][j].x + v[r][j].y * v[r][j].y) + (v[r][j].z * v[r][j].z + v[r][j].w * v[r][j].w);
#pragma unroll
    for (int o = 1; o < 64; o <<= 1) { s[0] += __shfl_xor(s[0], o); s[1] += __shfl_xor(s[1], o); }
#pragma unroll
    for (int r = 0; r < 2; ++r) { const float rstd = 1.f / sqrtf(s[r] * (1.f / 1024.f) + NORM_EPS); GAS v2u* o8 = (GAS v2u*)(orow + (size_t)r * 1024) + lane;
#pragma unroll
        for (int j = 0; j < 4; ++j) { const f32x4 gg = gr[64 * j]; v2u w; w.x = pk2(v[r][j].x * rstd * gg.x, v[r][j].y * rstd * gg.y); w.y = pk2(v[r][j].z * rstd * gg.z, v[r][j].w * rstd * gg.w); o8[64 * j] = w; } }
}

#ifndef SKIP_GATE_WT
#define SKIP_GATE_WT 1
#endif
__device__ __forceinline__ void p0_prologue(Frame& F) {
    const Args& A = *F.a;
    LAS float* scr = (LAS float*)(F.lds + F.wave * 16640);
    const int gw = F.bid * NWAVES + F.wave, NGW = F.G * NWAVES;
    constexpr int I0 = 16 * 176, I1 = 16 * 32, I2 = 16 * 16, I3 = 32 * 16, I4 = 16 * 16, I5 = 16 * 16;
    constexpr int NITEMS = I0 + I1 + I2 + I3 + I4 + I5;
    for (int it = gw; it < NITEMS; it += NGW) {
        int r = it;
        if (SKIP_GATE_WT && r < I0 && (r % 176) >= 128) continue;
        if (r < I0) {
            if constexpr (KNORM_FOLD) { const int kb = r / 176, nb = r % 176;
                if (nb >= 16 && nb < 32) { const int tb = (64 * nb) & ~255, hh = nb & 3;
                    transpose64(A.in[I_WIN], 11264, 1024, 64 * kb, 64 * nb, WSP(bfu, WS_WINT), tb + 32 * hh, scr, F.lane, tb + 128 + 32 * hh); continue; } }
            transpose_plain(A.in[I_WIN], 1024, 11264, WSP(bfu, WS_WINT), r, scr, F.lane); continue; } r -= I0;
        if (r < I1) { transpose_plain(A.in[I_CAWKV], 1024, 2048, WSP(bfu, WS_CAKVT), r, scr, F.lane); continue; } r -= I1;
        if (r < I2) { transpose_plain(A.in[I_WBDA], 1024, 1024, WSP(bfu, WS_WBDAT), r, scr, F.lane); continue; } r -= I2;
        if (r < I3) { transpose_plain(A.in[I_WBML], 2048, 1024, WSP(bfu, WS_WBMLT), r, scr, F.lane); continue; } r -= I3;
        if (r < I4) { transpose_plain(A.in[I_WBCA], 1024, 1024, WSP(bfu, WS_WBCAT), r, scr, F.lane); continue; } r -= I4;
        transpose_plain(A.in[I_WOUT], 1024, 1024, WSP(bfu, WS_WOUTT), r, scr, F.lane);
    }
    for (int m = 2 * gw; m < T; m += 2 * NGW) rms_rows2_to_bf16(A.in[I_X] + (size_t)m * DM, A.in[I_ATTN_G], WSP(bfu, WS_XN) + (size_t)m * DM, F.lane);
    for (int m = 2 * gw; m < NB * 256; m += 2 * NGW) rms_rows2_to_bf16(A.in[I_MEM] + (size_t)m * DM, A.in[I_MEMG], WSP(bfu, SM_MEMN) + (size_t)m * DM, F.lane);
    const int gt = F.bid * NTHR + F.tid, NGT = F.G * NTHR;
    for (int idx = gt; idx < 2048 * 8; idx += NGT) {
        const int c = idx >> 3, g = idx & 7, blk = c >> 2, i = c & 3; const float* wif = A.in[I_WIF];
        float uq = 0.f, uv = 0.f;
#pragma unroll
        for (int o = 0; o < 4; ++o) {
            uq += A.in[I_WQ][blk * 16 + i * 4 + o] * wif[(size_t)(blk * 4 + o) * 8 + g] + A.in[I_WK][blk * 16 + i * 4 + o] * wif[(size_t)(2048 + blk * 4 + o) * 8 + g];
            uv += A.in[I_WV][blk * 16 + i * 4 + o] * wif[(size_t)(4096 + blk * 4 + o) * 8 + g]; }
        WSP(float, SM_UQK)[idx] = uq; WSP(float, SM_UV)[idx] = uv;
    }
    for (int idx = gt; idx < SEQ * 32; idx += NGT) {
        const int t = idx >> 5, i = idx & 31;
        double pw = 1.0; for (int q = 0; q < i; ++q) pw *= 0.7498942093324559;
        const float inv = (float)pw;
        const float ang = (float)t * inv;
        const float n = rintf(ang * 0.15915494309189535f);
        float r = fmaf(n, -6.28125f, ang); r = fmaf(n, -1.9353071795864769e-3f, r);
        const float rev = r * 0.15915494309189535f;
        WSP(float, SM_ROPEC)[idx] = __builtin_amdgcn_cosf(rev); WSP(float, SM_ROPES)[idx] = __builtin_amdgcn_sinf(rev);
        if (t == 0) WSP(float, SM_INVF)[i] = inv;
    }
    if (gt == 0) {
        float s1 = 0.f, s2 = 0.f;
        for (int i = 0; i < 64; ++i) { s1 += A.in[I_LQ1][i] * A.in[I_LK1][i]; s2 += A.in[I_LQ2][i] * A.in[I_LK2][i]; }
        WSP(float, SM_LAM)[0] = fexp(s1) - fexp(s2) + LAMBDA_INIT;
    }
}

__device__ __forceinline__ void ld4bf(const bfu* p, float (&v)[4]) { const v2u w = *(const GAS v2u*)p; v[0] = bflo(w.x); v[1] = bfhi(w.x); v[2] = bflo(w.y); v[3] = bfhi(w.y); }
__device__ __forceinline__ void ld8bf(const bfu* p, float (&v)[8]) { const v4u w = *(const GAS v4u*)p; v[0] = bflo(w.x); v[1] = bfhi(w.x); v[2] = bflo(w.y); v[3] = bfhi(w.y); v[4] = bflo(w.z); v[5] = bfhi(w.z); v[6] = bflo(w.w); v[7] = bfhi(w.w); }
__device__ __forceinline__ void unpk8(const v4u w, float (&v)[8]) { v[0] = bflo(w.x); v[1] = bfhi(w.x); v[2] = bflo(w.y); v[3] = bfhi(w.y); v[4] = bflo(w.z); v[5] = bfhi(w.z); v[6] = bflo(w.w); v[7] = bfhi(w.w); }
__device__ __forceinline__ v4u pk8(const float (&v)[8]) { v4u o; o.x = pk2(v[0], v[1]); o.y = pk2(v[2], v[3]); o.z = pk2(v[4], v[5]); o.w = pk2(v[6], v[7]); return o; }

#define TRSTEP(arr, N, BIT, lane_) _Pragma("unroll") for (int e_ = 0; e_ < (N); ++e_) { const bool up_ = ((lane_) >> (BIT)) & 1; const float keep_ = up_ ? arr[(N) + e_] : arr[e_], send_ = up_ ? arr[e_] : arr[(N) + e_]; arr[e_] = keep_ + __shfl_xor(send_, 1 << (BIT)); }
__device__ __forceinline__ void p2_gates(Frame& F) {
    const Args& A = *F.a; const bfu* MLX = WSP(bfu, WS_MLX);
    const int c0 = 4 * F.tid;
    float cw[4][4], cb[4], uq[4][8], uv[4][8];
#pragma unroll
    for (int j = 0; j < 4; ++j)
#pragma unroll
        for (int i = 0; i < 4; ++i) cw[j][i] = A.in[I_CONVW][j * 2048 + c0 + i];
#pragma unroll
    for (int i = 0; i < 4; ++i) { cb[i] = A.in[I_CONVB][c0 + i];
#pragma unroll
        for (int g = 0; g < 8; ++g) { uq[i][g] = WSP(float, SM_UQK)[(c0 + i) * 8 + g]; uv[i][g] = WSP(float, SM_UV)[(c0 + i) * 8 + g]; } }
    LAS float* red = (LAS float*)F.lds;
    for (int tile = F.bid; tile < T / 128; tile += F.G) {
        const int m0 = tile * 128;
        float xw[3][4];
#pragma unroll
        for (int j = 0; j < 3; ++j) { if ((m0 & (SEQ - 1)) == 0) { xw[j][0] = xw[j][1] = xw[j][2] = xw[j][3] = 0.f; } else ld4bf(MLX + (size_t)(m0 - 3 + j) * 2048 + c0, xw[j]); }
        for (int t8 = 0; t8 < 16; ++t8) {
            v2u raw[8];
#pragma unroll
            for (int tt = 0; tt < 8; ++tt) raw[tt] = *(const GAS v2u*)(MLX + (size_t)(m0 + t8 * 8 + tt) * 2048 + c0);
            float pg[64];
#pragma unroll
            for (int tt = 0; tt < 8; ++tt) {
                const float xm[4] = {bflo(raw[tt].x), bfhi(raw[tt].x), bflo(raw[tt].y), bfhi(raw[tt].y)};
#pragma unroll
                for (int g = 0; g < 8; ++g) pg[tt * 8 + g] = 0.f;
#pragma unroll
                for (int i = 0; i < 4; ++i) {
                    const float y = cb[i] + cw[0][i] * xw[0][i] + cw[1][i] * xw[1][i] + cw[2][i] * xw[2][i] + cw[3][i] * xm[i];
                    const float xc = fsilu(y);
#pragma unroll
                    for (int g = 0; g < 8; ++g) pg[tt * 8 + g] += xc * uq[i][g] + xm[i] * uv[i][g];
                    xw[0][i] = xw[1][i]; xw[1][i] = xw[2][i]; xw[2][i] = xm[i];
                }
            }
            TRSTEP(pg, 32, 5, F.lane) TRSTEP(pg, 16, 4, F.lane) TRSTEP(pg, 8, 3, F.lane) TRSTEP(pg, 4, 2, F.lane) TRSTEP(pg, 2, 1, F.lane) TRSTEP(pg, 1, 0, F.lane)
            red[((t8 * 8 + (F.lane >> 3)) * 8 + F.wave) * 8 + (F.lane & 7)] = pg[0];
        }
        __syncthreads();
        for (int idx = F.tid; idx < 1024; idx += NTHR) {
            const int t = idx >> 3, g = idx & 7; float s = A.in[I_BIF][g];
#pragma unroll
            for (int w = 0; w < 8; ++w) s += red[(t * 8 + w) * 8 + g];
            const int m = m0 + t, b = m >> 13, ts = m & (SEQ - 1);
            if (g < 4) WSP(float, SM_IPRE)[((b * 4 + g) << 13) + ts] = s; else WSP(float, SM_FPRE)[((b * 4 + g - 4) << 13) + ts] = s;
        }
        __syncthreads();
    }
}

__device__ __forceinline__ void p3_scan(Frame& F) {
    LAS float* wt = (LAS float*)F.lds;
    for (int bh = F.bid; bh < 16; bh += F.G) {
        const int base = bh * SEQ + 16 * F.tid;
        float fv[16], iv[16];
#pragma unroll
        for (int q = 0; q < 4; ++q) { const f32x4 a = *(const GAS f32x4*)(WSP(float, SM_FPRE) + base + 4 * q); fv[4 * q] = a.x; fv[4 * q + 1] = a.y; fv[4 * q + 2] = a.z; fv[4 * q + 3] = a.w;
            const f32x4 c = *(const GAS f32x4*)(WSP(float, SM_IPRE) + base + 4 * q); iv[4 * q] = c.x; iv[4 * q + 1] = c.y; iv[4 * q + 2] = c.z; iv[4 * q + 3] = c.w; }
        float run = 0.f;
#pragma unroll
        for (int k = 0; k < 16; ++k) { const float x = fv[k]; const float ls = fminf(x, 0.f) - __logf(1.f + fexp(-fabsf(x))); run += ls; fv[k] = run; }
        float incl = run;
#pragma unroll
        for (int o = 1; o < 64; o <<= 1) { const float v = __shfl_up(incl, o); if (F.lane >= o) incl += v; }
        if (F.lane == 63) wt[F.wave] = incl;
        __syncthreads();
        float off = incl - run;
        for (int w = 0; w < F.wave; ++w) off += wt[w];
        float rm = -INFINITY;
#pragma unroll
        for (int k = 0; k < 16; ++k) { fv[k] += off; iv[k] -= fv[k]; rm = fmaxf(rm, iv[k]); }
        float im = rm;
#pragma unroll
        for (int o = 1; o < 64; o <<= 1) { const float v = __shfl_up(im, o); if (F.lane >= o) im = fmaxf(im, v); }
        if (F.lane == 63) wt[8 + F.wave] = im;
        __syncthreads();
        float pm = __shfl_up(im, 1); if (F.lane == 0) pm = -INFINITY;
        for (int w = 0; w < F.wave; ++w) pm = fmaxf(pm, wt[8 + w]);
        float gg[16], mm[16]; float cm = pm;
#pragma unroll
        for (int k = 0; k < 16; ++k) { cm = fmaxf(cm, iv[k]); gg[k] = cm; mm[k] = fv[k] + cm; }
#pragma unroll
        for (int q = 0; q < 4; ++q) {
            *(GAS f32x4*)(WSP(float, SM_AA) + base + 4 * q) = (f32x4){iv[4 * q], iv[4 * q + 1], iv[4 * q + 2], iv[4 * q + 3]};
            *(GAS f32x4*)(WSP(float, SM_GG) + base + 4 * q) = (f32x4){gg[4 * q], gg[4 * q + 1], gg[4 * q + 2], gg[4 * q + 3]};
            *(GAS f32x4*)(WSP(float, SM_MM) + base + 4 * q) = (f32x4){mm[4 * q], mm[4 * q + 1], mm[4 * q + 2], mm[4 * q + 3]}; }
        __syncthreads();
    }
}

__device__ __forceinline__ void p4_materialise(Frame& F) {
    const Args& A = *F.a; const bfu* MLX = WSP(bfu, WS_MLX);
    bfu* QN_ = WSP(bfu, WS_QNAT); bfu* KN_ = WSP(bfu, WS_KNAT); bfu* KT = WSP(bfu, WS_KT); bfu* VT = WSP(bfu, WS_VT);
    LAS unsigned char* kt_l = F.lds;
    LAS unsigned char* vt_l = F.lds + 64 * 1040;
    LAS float* red = (LAS float*)(F.lds + 2 * 64 * 1040);
    const int bl = F.tid & 15, seg = F.tid >> 4;
    for (int unit = F.bid; unit < 2048; unit += F.G) {
        const int b = unit >> 9, j = (unit >> 5) & 15, cg = unit & 31, h = cg >> 3, bh = b * 4 + h;
        const int c0 = cg * 64 + 4 * bl, d00 = (cg & 7) * 64, blk = c0 >> 2;
        float cw[4][4], cb[4], wq[4][4], wk[4][4], wv[4][4];
#pragma unroll
        for (int jj = 0; jj < 4; ++jj)
#pragma unroll
            for (int i = 0; i < 4; ++i) { cw[jj][i] = A.in[I_CONVW][jj * 2048 + c0 + i]; wq[jj][i] = A.in[I_WQ][blk * 16 + jj * 4 + i]; wk[jj][i] = A.in[I_WK][blk * 16 + jj * 4 + i] * 0.044194173824159216f; wv[jj][i] = A.in[I_WV][blk * 16 + jj * 4 + i]; }
#pragma unroll
        for (int i = 0; i < 4; ++i) cb[i] = A.in[I_CONVB][c0 + i];
        const float Gend = WSP(float, SM_GG)[bh * SEQ + 512 * j + 511];
        const int tl0 = 16 * seg, ts0 = 512 * j + tl0; const size_t mrow0 = (size_t)b * SEQ + ts0;
        v2u raw[19];
#pragma unroll
        for (int q = 0; q < 19; ++q) { if (q < 3 && ts0 == 0) raw[q] = (v2u){0u, 0u}; else raw[q] = *(const GAS v2u*)(MLX + (mrow0 - 3 + q) * 2048 + c0); }
        float aw[16];
#pragma unroll
        for (int q = 0; q < 4; ++q) { const f32x4 a = *(const GAS f32x4*)(WSP(float, SM_AA) + bh * SEQ + ts0 + 4 * q); aw[4 * q] = a.x; aw[4 * q + 1] = a.y; aw[4 * q + 2] = a.z; aw[4 * q + 3] = a.w; }
        float dn[4] = {0.f, 0.f, 0.f, 0.f};
#pragma unroll
        for (int t8 = 0; t8 < 2; ++t8) {
            float kT[4][8], vT[4][8];
#pragma unroll
            for (int tt = 0; tt < 8; ++tt) {
                const int tq = t8 * 8 + tt; const size_t m = mrow0 + tq;
                float xc[4], xm[4] = {bflo(raw[tq + 3].x), bfhi(raw[tq + 3].x), bflo(raw[tq + 3].y), bfhi(raw[tq + 3].y)};
#pragma unroll
                for (int i = 0; i < 4; ++i) {
                    const float x0 = (i & 1) ? bfhi(i < 2 ? raw[tq].x : raw[tq].y) : bflo(i < 2 ? raw[tq].x : raw[tq].y);
                    const float x1 = (i & 1) ? bfhi(i < 2 ? raw[tq + 1].x : raw[tq + 1].y) : bflo(i < 2 ? raw[tq + 1].x : raw[tq + 1].y);
                    const float x2 = (i & 1) ? bfhi(i < 2 ? raw[tq + 2].x : raw[tq + 2].y) : bflo(i < 2 ? raw[tq + 2].x : raw[tq + 2].y);
                    const float y = cb[i] + cw[0][i] * x0 + cw[1][i] * x1 + cw[2][i] * x2 + cw[3][i] * xm[i]; xc[i] = fsilu(y); }
                const float w = fexp(aw[tq] - Gend);
                float q[4], k[4];
#pragma unroll
                for (int o = 0; o < 4; ++o) {
                    q[o] = xc[0] * wq[0][o] + xc[1] * wq[1][o] + xc[2] * wq[2][o] + xc[3] * wq[3][o];
                    k[o] = xc[0] * wk[0][o] + xc[1] * wk[1][o] + xc[2] * wk[2][o] + xc[3] * wk[3][o];
                    vT[o][tt] = xm[0] * wv[0][o] + xm[1] * wv[1][o] + xm[2] * wv[2][o] + xm[3] * wv[3][o];
                    kT[o][tt] = w * k[o]; dn[o] += w * k[o]; }
                v2u qo, ko; qo.x = pk2(q[0], q[1]); qo.y = pk2(q[2], q[3]); ko.x = pk2(k[0], k[1]); ko.y = pk2(k[2], k[3]);
                *(GAS v2u*)(QN_ + m * 2048 + c0) = qo; *(GAS v2u*)(KN_ + m * 2048 + c0) = ko;
            }
#pragma unroll
            for (int o = 0; o < 4; ++o) { const int lo = (4 * bl + o) * 1040 + (tl0 + t8 * 8) * 2;
                *(LAS v4u*)(kt_l + lo) = pk8(kT[o]); *(LAS v4u*)(vt_l + lo) = pk8(vT[o]); }
        }
#pragma unroll
        for (int o = 0; o < 4; ++o) { dn[o] += __shfl_xor(dn[o], 16); dn[o] += __shfl_xor(dn[o], 32); if (F.lane < 16) red[F.wave * 64 + 4 * bl + o] = dn[o]; }
        __syncthreads();
#pragma unroll
        for (int r = 0; r < 8; ++r) { const int ch = F.wave * 8 + r; const size_t off = ((size_t)(bh * 512 + d00 + ch)) * LDT + 512 * j + 8 * F.lane;
            *(GAS v4u*)(KT + off) = *(const LAS v4u*)(kt_l + ch * 1040 + 16 * F.lane); *(GAS v4u*)(VT + off) = *(const LAS v4u*)(vt_l + ch * 1040 + 16 * F.lane); }
        if (F.tid < 64) { float sum = 0.f;
#pragma unroll
            for (int w = 0; w < 8; ++w) sum += red[w * 64 + F.tid];
            WSP(float, SM_DN)[(bh * 16 + j) * 512 + d00 + F.tid] = sum; }
        __syncthreads();
    }
}

__device__ __forceinline__ void p6_scan_qn(Frame& F) {
    bfu* C = WSP(bfu, WS_C); const float* GG = WSP(float, SM_GG);
    const int gt = F.bid * NTHR + F.tid, NGT = F.G * NTHR;
    for (int g = gt; g < 16 * 32768; g += NGT) {
        const int bh = g >> 15; const size_t off = (size_t)(g & 32767) * 8;
        v4u tmp[15];
#pragma unroll
        for (int j = 0; j < 15; ++j) tmp[j] = *(const GAS v4u*)(C + ((size_t)(bh * 16 + j) << 18) + off);
        float cur[8];
#pragma unroll
        for (int e = 0; e < 8; ++e) cur[e] = 0.f;
#pragma unroll
        for (int j = 0; j < 16; ++j) {
            *(GAS v4u*)(C + ((size_t)(bh * 16 + j) << 18) + off) = pk8(cur);
            if (j < 15) {
                const float dec = (j == 0) ? 0.f : fexp(GG[bh * SEQ + 512 * j - 1] - GG[bh * SEQ + 512 * j + 511]);
                const v4u w = tmp[j];
                cur[0] = dec * cur[0] + bflo(w.x); cur[1] = dec * cur[1] + bfhi(w.x); cur[2] = dec * cur[2] + bflo(w.y); cur[3] = dec * cur[3] + bfhi(w.y);
                cur[4] = dec * cur[4] + bflo(w.z); cur[5] = dec * cur[5] + bfhi(w.z); cur[6] = dec * cur[6] + bflo(w.w); cur[7] = dec * cur[7] + bfhi(w.w);
            }
        }
    }
    LAS float* nj = (LAS float*)F.lds;
    const bfu* QN_ = WSP(bfu, WS_QNAT);
    for (int item = F.bid; item < 256; item += F.G) {
        const int bh = item >> 4, j = item & 15, b = bh >> 2, h = bh & 3;
        { float cur = 0.f; const int d = F.tid;
          for (int jj = 0; jj < j; ++jj) { const float dec = (jj == 0) ? 0.f : fexp(GG[bh * SEQ + 512 * jj - 1] - GG[bh * SEQ + 512 * jj + 511]); cur = dec * cur + WSP(float, SM_DN)[(bh * 16 + jj) * 512 + d]; }
          nj[d] = cur; }
        { const int tl = F.tid; const float* dp = WSP(float, WS_DENP) + (size_t)(bh * SEQ + 512 * j + tl) * 8;
          const f32x4 p0 = *(const GAS f32x4*)dp; float d = (p0.x + p0.y) + (p0.z + p0.w);
          if (tl >= 256) { const f32x4 p1 = *(const GAS f32x4*)(dp + 4); d += (p1.x + p1.y) + (p1.z + p1.w); }
          WSP(float, WS_DEN)[bh * SEQ + 512 * j + tl] = d; }
        __syncthreads();
        float nv[8];
#pragma unroll
        for (int e = 0; e < 8; ++e) nv[e] = nj[8 * F.lane + e];
        for (int r0 = F.wave * 64; r0 < F.wave * 64 + 64; r0 += 8) {
            v4u raw[8];
#pragma unroll
            for (int q = 0; q < 8; ++q) raw[q] = *(const GAS v4u*)(QN_ + ((size_t)b * SEQ + 512 * j + r0 + q) * 2048 + h * 512 + 8 * F.lane);
            float sv[8];
#pragma unroll
            for (int q = 0; q < 8; ++q) { float qv[8]; unpk8(raw[q], qv); float s = 0.f;
#pragma unroll
                for (int e = 0; e < 8; ++e) s += qv[e] * nv[e];
                sv[q] = s; }
            TRSTEP(sv, 4, 5, F.lane) TRSTEP(sv, 2, 4, F.lane) TRSTEP(sv, 1, 3, F.lane)
            float s = sv[0]; s += __shfl_xor(s, 1); s += __shfl_xor(s, 2); s += __shfl_xor(s, 4);
            if ((F.lane & 7) == 0) WSP(float, SM_QN)[bh * SEQ + 512 * j + r0 + ((((F.lane >> 5) & 1) << 2) | (((F.lane >> 4) & 1) << 1) | ((F.lane >> 3) & 1))] = s;
        }
        __syncthreads();
    }
}

#ifndef P9_ROWS
#define P9_ROWS 4
#endif
__device__ __forceinline__ void p9_mlout(Frame& F, bfu* DST) {
    constexpr int R = P9_ROWS;
    const Args& A = *F.a; const bfu* MLX = WSP(bfu, WS_MLX); const bfu* HH = WSP(bfu, WS_HH); const bfu* Z = (const bfu*)A.out;
    const int h = F.wave & 3, c0 = h * 512 + 8 * F.lane;
    float cw[4][8], cb[8], ng[8], sk[8];
#pragma unroll
    for (int e = 0; e < 8; ++e) { cb[e] = A.in[I_CONVB][c0 + e]; ng[e] = A.in[I_MLNG][c0 + e]; sk[e] = A.in[I_SKIP][c0 + e];
#pragma unroll
        for (int j = 0; j < 4; ++j) cw[j][e] = A.in[I_CONVW][j * 2048 + c0 + e]; }
    const int slot = F.bid * 2 + (F.wave >> 2), nslot = F.G * 2;
    for (int m0 = R * slot; m0 < T; m0 += R * nslot) {
        v4u rh[R], rz[R], rx[R + 3];
#pragma unroll
        for (int r = 0; r < R; ++r) { rh[r] = *(const GAS v4u*)(HH + (size_t)(m0 + r) * 2048 + c0); rz[r] = *(const GAS v4u*)(Z + (size_t)(m0 + r) * 2048 + c0); }
        const int ts0 = m0 & (SEQ - 1);
#pragma unroll
        for (int q = 0; q < R + 3; ++q) { if (ts0 - 3 + q >= 0) rx[q] = *(const GAS v4u*)(MLX + (size_t)(m0 - 3 + q) * 2048 + c0); else rx[q] = (v4u){0u, 0u, 0u, 0u}; }
        float y[R][8];
#pragma unroll
        for (int r = 0; r < R; ++r)
#pragma unroll
            for (int e = 0; e < 8; ++e) y[r][e] = cb[e];
#pragma unroll
        for (int q = 0; q < R + 3; ++q) { float xq[8]; unpk8(rx[q], xq);
#pragma unroll
            for (int r = 0; r < R; ++r) { if (q - r >= 0 && q - r <= 3) {
#pragma unroll
                for (int e = 0; e < 8; ++e) y[r][e] += cw[q - r][e] * xq[e]; } } }
        float hv[R][8], s[R], qq[R];
#pragma unroll
        for (int r = 0; r < R; ++r) { unpk8(rh[r], hv[r]); s[r] = 0.f;
#pragma unroll
            for (int e = 0; e < 8; ++e) s[r] += hv[r][e]; }
#pragma unroll
        for (int o = 1; o < 64; o <<= 1) {
#pragma unroll
            for (int r = 0; r < R; ++r) s[r] += __shfl_xor(s[r], o); }
#pragma unroll
        for (int r = 0; r < R; ++r) { const float mu = s[r] * (1.f / 512.f); qq[r] = 0.f;
#pragma unroll
            for (int e = 0; e < 8; ++e) { hv[r][e] -= mu; qq[r] += hv[r][e] * hv[r][e]; } }
#pragma unroll
        for (int o = 1; o < 64; o <<= 1) {
#pragma unroll
            for (int r = 0; r < R; ++r) qq[r] += __shfl_xor(qq[r], o); }
#pragma unroll
        for (int r = 0; r < R; ++r) { const float rstd = 1.f / sqrtf(qq[r] * (1.f / 512.f) + NORM_EPS); float zv[8], o8[8]; unpk8(rz[r], zv);
#pragma unroll
            for (int e = 0; e < 8; ++e) o8[e] = (hv[r][e] * rstd * ng[e] + sk[e] * fsilu(y[r][e])) * fsilu(zv[e]);
            if constexpr (MIXQ) {
#pragma unroll
                for (int e = 0; e < 8; ++e) o8[e] = rt8(o8[e]); }
            *(GAS v4u*)(DST + (size_t)(m0 + r) * 2048 + c0) = pk8(o8); }
    }
}

__device__ __forceinline__ void qk_fin(bfu* row, const v4u r1, const v4u r2, const float* g, const float (&c)[8], const float (&sn)[8], float scale, int lane) {
    const int gi = lane >> 2, i0 = 8 * (lane & 3);
    float x1[8], x2[8]; unpk8(r1, x1); unpk8(r2, x2);
    float s = 0.f;
#pragma unroll
    for (int e = 0; e < 8; ++e) s += x1[e] * x1[e] + x2[e] * x2[e];
    s += __shfl_xor(s, 1); s += __shfl_xor(s, 2);
    const float rstd = scale / sqrtf(s * (1.f / 64.f) + NORM_EPS);
    float o1[8], o2[8];
#pragma unroll
    for (int e = 0; e < 8; ++e) { const float a = x1[e] * rstd * g[i0 + e], b = x2[e] * rstd * g[32 + i0 + e]; o1[e] = a * c[e] - b * sn[e]; o2[e] = b * c[e] + a * sn[e]; }
    *(GAS v4u*)(row + gi * 64 + i0) = pk8(o1); *(GAS v4u*)(row + gi * 64 + 32 + i0) = pk8(o2);
}
__device__ __forceinline__ void n256_fin(bfu* row, const v4u r1, const v4u r2, const float* g, float scale, int lane, const float* g2 = nullptr) {
    const int h = lane >> 4, i0 = 16 * (lane & 15);
    float x1[8], x2[8]; unpk8(r1, x1); unpk8(r2, x2);
    float s = 0.f;
#pragma unroll
    for (int e = 0; e < 8; ++e) s += x1[e] * x1[e] + x2[e] * x2[e];
    s += __shfl_xor(s, 1); s += __shfl_xor(s, 2); s += __shfl_xor(s, 4); s += __shfl_xor(s, 8);
    const float rstd = scale / sqrtf(s * (1.f / 256.f) + NORM_EPS);
#pragma unroll
    for (int e = 0; e < 8; ++e) { x1[e] *= rstd * g[i0 + e]; x2[e] *= rstd * g[i0 + 8 + e]; }
    if (g2) {
#pragma unroll
        for (int e = 0; e < 8; ++e) { x1[e] *= g2[i0 + e]; x2[e] *= g2[i0 + 8 + e]; } }
    *(GAS v4u*)(row + h * 256 + i0) = pk8(x1); *(GAS v4u*)(row + h * 256 + i0 + 8) = pk8(x2);
}
__device__ __forceinline__ void p11_norms(Frame& F, size_t dofs) {
    const Args& A = *F.a;
    const int gw = F.bid * NWAVES + F.wave, NGW = F.G * NWAVES;
    { const int gi = F.lane >> 2, i0 = 8 * (F.lane & 3), hc = F.lane >> 4, j0 = 16 * (F.lane & 15);
      if constexpr (!(KNORM_FOLD && !KNORM_EPI_OFF && CAQ_FOLD && QNORM_IN_ATTN)) for (int m = gw; m < T; m += NGW) {
        const int ts = m & (SEQ - 1);
        bfu* qr = WSP(bfu, WS_DAQ) + (size_t)m * DM; bfu* kr = WSP(bfu, WS_DAK) + (size_t)m * DM; bfu* cr = WSP(bfu, WS_CAQ) + (size_t)m * DM;
        v4u q1 = {0u, 0u, 0u, 0u}, q2 = q1; if constexpr (!QNORM_IN_ATTN) { q1 = *(const GAS v4u*)(qr + gi * 64 + i0); q2 = *(const GAS v4u*)(qr + gi * 64 + 32 + i0); }
        const v4u k1 = *(const GAS v4u*)(kr + gi * 64 + i0), k2 = *(const GAS v4u*)(kr + gi * 64 + 32 + i0);
        v4u c1 = {0u, 0u, 0u, 0u}, c2 = c1; if constexpr (!CAQ_FOLD) { c1 = *(const GAS v4u*)(cr + hc * 256 + j0); c2 = *(const GAS v4u*)(cr + hc * 256 + j0 + 8); }
        const f32x4 ca = *(const GAS f32x4*)(WSP(float, SM_ROPEC) + ts * 32 + i0), cb = *(const GAS f32x4*)(WSP(float, SM_ROPEC) + ts * 32 + i0 + 4), sa = *(const GAS f32x4*)(WSP(float, SM_ROPES) + ts * 32 + i0), sb = *(const GAS f32x4*)(WSP(float, SM_ROPES) + ts * 32 + i0 + 4);
        const float cc[8] = {ca.x, ca.y, ca.z, ca.w, cb.x, cb.y, cb.z, cb.w}, ss[8] = {sa.x, sa.y, sa.z, sa.w, sb.x, sb.y, sb.z, sb.w};
        if constexpr (!QNORM_IN_ATTN) qk_fin((bfu*)((char*)qr + dofs), q1, q2, A.in[I_DAQG], cc, ss, 0.125f * 1.4426950408889634f, F.lane);
        if constexpr (!KNORM_FOLD || KNORM_EPI_OFF) qk_fin((bfu*)((char*)kr + dofs), k1, k2, A.in[I_DAKG], cc, ss, 1.f, F.lane);
        if constexpr (!CAQ_FOLD) n256_fin(dofs ? (bfu*)((char*)qr + dofs) : cr, c1, c2, A.in[I_CAQG], 0.0625f, F.lane);
      }
      if (dofs == 0) for (int m = gw; m < NB * 256; m += NGW) { bfu* cr = WSP(bfu, SM_KCA) + (size_t)m * DM; const v4u c1 = *(const GAS v4u*)(cr + hc * 256 + j0), c2 = *(const GAS v4u*)(cr + hc * 256 + j0 + 8); n256_fin(cr, c1, c2, A.in[I_CAKG], 1.f, F.lane, CAQ_FOLD ? A.in[I_CAQG] : nullptr); } }
    const int gt = F.bid * NTHR + F.tid, NGT = F.G * NTHR;
    for (int i = gt; i < NSLOT_MAX; i += NGT) WSP(int, SM_TOK)[i] = -1;
}

__device__ __forceinline__ void gate8_convert(Frame& F) {
    const Args& A = *F.a; const int gw = F.bid * NWAVES + F.wave, NGW = F.G * NWAVES;
    for (int m0 = 2 * gw; m0 < T; m0 += 2 * NGW) {
        v4u a[2], b[2];
#pragma unroll
        for (int r = 0; r < 2; ++r) { const GAS v4u* src = (const GAS v4u*)(WSP(bfu, WS_XN) + (size_t)(m0 + r) * DM) + 2 * F.lane; a[r] = src[0]; b[r] = src[1]; }
#pragma unroll
        for (int r = 0; r < 2; ++r) { float x[8], y[8]; unpk8(a[r], x); unpk8(b[r], y);
            v4u o; o.x = pk4fp8(16.f * x[0], 16.f * x[1], 16.f * x[2], 16.f * x[3]); o.y = pk4fp8(16.f * x[4], 16.f * x[5], 16.f * x[6], 16.f * x[7]); o.z = pk4fp8(16.f * y[0], 16.f * y[1], 16.f * y[2], 16.f * y[3]); o.w = pk4fp8(16.f * y[4], 16.f * y[5], 16.f * y[6], 16.f * y[7]);
            *((GAS v4u*)(WSP(unsigned char, WS_XN8) + (size_t)(m0 + r) * DM) + F.lane) = o; } }
    LAS float* scr = (LAS float*)(F.lds + F.wave * 16640);
    for (int it = gw; it < 16 * 48; it += NGW) { const int kb = it / 48, nb = it % 48;
        transpose64_fp8(A.in[I_WIN], 11264, 1024, 64 * kb, 8192 + 64 * nb, WSP(unsigned char, WS_WG8), 64 * nb, scr, F.lane); }
}
__device__ __forceinline__ void moe_convert(Frame& F) {
    const Args& A = *F.a; const int gw = F.bid * NWAVES + F.wave, NGW = F.G * NWAVES;
    LAS float* scr = (LAS float*)(F.lds + F.wave * 16640);
    constexpr int IGU = 16 * 32, IDN = 16 * 16;
    for (int it = gw; it < 32 * (IGU + IDN); it += NGW) {
        if (it < 32 * IGU) { const int e = it / IGU, r = it % IGU, kb = r / 32, nb = r % 32, n0 = 64 * nb;
            const int jf = n0 & 1023, drow0 = 256 * (jf >> 7) + (n0 >= 1024 ? 128 : 0) + (jf & 127);
            transpose64_fp8(A.in[I_WGU] + (size_t)e * 1024 * 2048, 2048, 1024, 64 * kb, n0, WSP(unsigned char, WS_WGUT) + (size_t)e * 2048 * 1024, drow0, scr, F.lane);
        } else { const int q = it - 32 * IGU, e = q / IDN, r = q % IDN;
            transpose64_fp8(A.in[I_WD] + (size_t)e * 1024 * 1024, 1024, 1024, 64 * (r / 16), 64 * (r % 16), WSP(unsigned char, WS_WDT) + (size_t)e * 1024 * 1024, 64 * (r % 16), scr, F.lane); }
    }
}

__device__ __forceinline__ void p13_dacombine(Frame& F) {
    const Args& A = *F.a; const bfu* O = WSP(bfu, WS_O); bfu* Y = WSP(bfu, WS_DAQ);
    const float lam = WSP(float, SM_LAM)[0];
    const int gw = F.bid * NWAVES + F.wave, NGW = F.G * NWAVES;
    const int h = F.lane >> 3, dv0 = 16 * (F.lane & 7);
    float sg[16];
#pragma unroll
    for (int e = 0; e < 16; ++e) sg[e] = A.in[I_SUBG][dv0 + e] * (1.f - LAMBDA_INIT);
    for (int m0 = 2 * gw; m0 < T; m0 += 2 * NGW) {
        v4u ra[2][4];
#pragma unroll
        for (int r = 0; r < 2; ++r) { const bfu* o0 = O + (size_t)(m0 + r) * 2048 + h * 256 + dv0; ra[r][0] = *(const GAS v4u*)o0; ra[r][1] = *(const GAS v4u*)(o0 + 8); ra[r][2] = *(const GAS v4u*)(o0 + 128); ra[r][3] = *(const GAS v4u*)(o0 + 136); }
#pragma unroll
        for (int r = 0; r < 2; ++r) { const int m = m0 + r;
            float a0[8], a1[8], b0[8], b1[8]; unpk8(ra[r][0], a0); unpk8(ra[r][1], a1); unpk8(ra[r][2], b0); unpk8(ra[r][3], b1);
            float s = 0.f;
#pragma unroll
            for (int e = 0; e < 8; ++e) { a0[e] -= lam * b0[e]; a1[e] -= lam * b1[e]; s += a0[e] * a0[e] + a1[e] * a1[e]; }
            s += __shfl_xor(s, 1); s += __shfl_xor(s, 2); s += __shfl_xor(s, 4);
            const float rstd = 1.f / sqrtf(s * (1.f / 128.f) + NORM_EPS);
#pragma unroll
            for (int e = 0; e < 8; ++e) { a0[e] *= rstd * sg[e]; a1[e] *= rstd * sg[8 + e]; }
            if constexpr (MIXQ) {
#pragma unroll
                for (int e = 0; e < 8; ++e) { a0[e] = rt8(a0[e]); a1[e] = rt8(a1[e]); } }
            *(GAS v4u*)(Y + (size_t)m * DM + h * 128 + dv0) = pk8(a0); *(GAS v4u*)(Y + (size_t)m * DM + h * 128 + dv0 + 8) = pk8(a1); }
    }
}

__device__ __forceinline__ void p16_router(Frame& F) {
    typedef short bf16x8v __attribute__((ext_vector_type(8)));
    const Args& A = *F.a; const float* H = A.out;
    constexpr int WST = 2064;
    LAS unsigned char* Wh = F.lds; LAS unsigned char* Wl = F.lds + 32 * WST;
    LAS unsigned* hist = (LAS unsigned*)(F.lds + 64 * WST);
    for (int idx = F.tid; idx < 32768; idx += NTHR) { const int k = idx >> 5, e = idx & 31; const float w = A.in[I_RW][idx] * A.in[I_FFNG][k];
        const unsigned hb = f2bf(w); const float hf = __builtin_bit_cast(float, hb << 16); const unsigned lb = f2bf(w - hf);
        *(LAS unsigned short*)(Wh + e * WST + 2 * k) = (unsigned short)hb; *(LAS unsigned short*)(Wl + e * WST + 2 * k) = (unsigned short)lb; }
    float gv[16];
#pragma unroll
    for (int j = 0; j < 4; ++j) { const f32x4 g = *(const GAS f32x4*)(A.in[I_FFNG] + 4 * F.lane + 256 * j); gv[4 * j] = g.x; gv[4 * j + 1] = g.y; gv[4 * j + 2] = g.z; gv[4 * j + 3] = g.w; }
    const int r = F.lane & 15, q = F.lane >> 4;
    float rbv[8];
#pragma unroll
    for (int e = 0; e < 8; ++e) rbv[e] = A.in[I_RB][(e >> 2) * 16 + 4 * q + (e & 3)];
    for (int tile = F.bid; tile < T / 128; tile += F.G) {
        if (F.tid < 32) hist[F.tid] = 0u;
        __syncthreads();
        const int m = tile * 128 + F.wave * 16 + r;
        f32x4 acc0 = {0.f, 0.f, 0.f, 0.f}, acc1 = {0.f, 0.f, 0.f, 0.f}; float ssq = 0.f;
        const float* hrow = H + (size_t)m * DM + 8 * q;
#pragma unroll 4
        for (int ks = 0; ks < 32; ++ks) {
            const f32x4 xa = *(const GAS f32x4*)(hrow + 32 * ks), xb = *(const GAS f32x4*)(hrow + 32 * ks + 4);
            const float x[8] = {xa.x, xa.y, xa.z, xa.w, xb.x, xb.y, xb.z, xb.w};
            unsigned hw[4], lw[4];
#pragma unroll
            for (int i = 0; i < 4; ++i) { ssq += x[2 * i] * x[2 * i] + x[2 * i + 1] * x[2 * i + 1]; hw[i] = pk2(x[2 * i], x[2 * i + 1]); lw[i] = pk2(x[2 * i] - bflo(hw[i]), x[2 * i + 1] - bfhi(hw[i])); }
            const bf16x8v xh = __builtin_bit_cast(bf16x8v, (v4u){hw[0], hw[1], hw[2], hw[3]}), xl = __builtin_bit_cast(bf16x8v, (v4u){lw[0], lw[1], lw[2], lw[3]});
            const int wo = r * WST + (32 * ks + 8 * q) * 2;
            const bf16x8v wh0 = *(const LAS bf16x8v*)(Wh + wo), wl0 = *(const LAS bf16x8v*)(Wl + wo), wh1 = *(const LAS bf16x8v*)(Wh + 16 * WST + wo), wl1 = *(const LAS bf16x8v*)(Wl + 16 * WST + wo);
            acc0 = __builtin_amdgcn_mfma_f32_16x16x32_bf16(wh0, xh, acc0, 0, 0, 0); acc0 = __builtin_amdgcn_mfma_f32_16x16x32_bf16(wl0, xh, acc0, 0, 0, 0); acc0 = __builtin_amdgcn_mfma_f32_16x16x32_bf16(wh0, xl, acc0, 0, 0, 0);
            acc1 = __builtin_amdgcn_mfma_f32_16x16x32_bf16(wh1, xh, acc1, 0, 0, 0); acc1 = __builtin_amdgcn_mfma_f32_16x16x32_bf16(wl1, xh, acc1, 0, 0, 0); acc1 = __builtin_amdgcn_mfma_f32_16x16x32_bf16(wh1, xl, acc1, 0, 0, 0);
        }
        ssq += __shfl_xor(ssq, 16); ssq += __shfl_xor(ssq, 32);
        const float rstd = 1.f / sqrtf(ssq * (1.f / 1024.f) + NORM_EPS);
        float lg[8];
#pragma unroll
        for (int e = 0; e < 4; ++e) { lg[e] = acc0[e] * rstd + rbv[e]; lg[4 + e] = acc1[e] * rstd + rbv[4 + e]; }
        int ti[4]; float tv[4];
#pragma unroll
        for (int k = 0; k < 4; ++k) {
            float bv = lg[0]; int bi = 4 * q;
#pragma unroll
            for (int e = 1; e < 8; ++e) { const int id = (e >> 2) * 16 + 4 * q + (e & 3); if (lg[e] > bv) { bv = lg[e]; bi = id; } }
#pragma unroll
            for (int o = 16; o < 64; o <<= 1) { const float ov = __shfl_xor(bv, o); const int oi = __shfl_xor(bi, o); if (ov > bv || (ov == bv && oi < bi)) { bv = ov; bi = oi; } }
            ti[k] = bi; tv[k] = bv;
#pragma unroll
            for (int e = 0; e < 8; ++e) { const int id = (e >> 2) * 16 + 4 * q + (e & 3); if (id == bi) lg[e] = -INFINITY; }
        }
        const float e1 = fexp(tv[1] - tv[0]), e2 = fexp(tv[2] - tv[0]), e3 = fexp(tv[3] - tv[0]); const float inv = 1.f / (1.f + e1 + e2 + e3);
        if (q == 0) {
            *(GAS v4u*)(WSP(int, SM_TOPI) + (size_t)m * 4) = (v4u){(unsigned)ti[0], (unsigned)ti[1], (unsigned)ti[2], (unsigned)ti[3]};
            *(GAS f32x4*)(WSP(float, SM_TOPW) + (size_t)m * 4) = (f32x4){inv, e1 * inv, e2 * inv, e3 * inv};
            atomicAdd((unsigned*)(hist + ti[0]), 1u); atomicAdd((unsigned*)(hist + ti[1]), 1u); atomicAdd((unsigned*)(hist + ti[2]), 1u); atomicAdd((unsigned*)(hist + ti[3]), 1u);
        }
#pragma unroll 4
        for (int tt = 0; tt < 16; ++tt) {
            const float rs = 16.f * __shfl(rstd, tt); const int mm = tile * 128 + F.wave * 16 + tt;
            GAS unsigned* o4 = (GAS unsigned*)(WSP(unsigned char, WS_XN) + (size_t)mm * DM) + F.lane;
#pragma unroll
            for (int j = 0; j < 4; ++j) { const f32x4 v = *(const GAS f32x4*)(H + (size_t)mm * DM + 4 * F.lane + 256 * j);
                o4[64 * j] = pk4fp8(rs * v.x * gv[4 * j], rs * v.y * gv[4 * j + 1], rs * v.z * gv[4 * j + 2], rs * v.w * gv[4 * j + 3]); }
        }
        __syncthreads();
        if (F.tid < 32) WSP(int, SM_WGCNT)[tile * 32 + F.tid] = (int)hist[F.tid];
        __syncthreads();
    }
}

__device__ __forceinline__ void p17_slots(Frame& F) {
    LAS int* s_tot = (LAS int*)F.lds; LAS int* s_pre = s_tot + 32; LAS int* s_off = s_pre + 32; LAS int* wcnt = s_off + 64;
    const int* WG = WSP(int, SM_WGCNT); int* META = WSP(int, SM_META);
    for (int tile = F.bid; tile < T / 128; tile += F.G) {
        { const int e = F.tid & 31, part = F.tid >> 5; int cv[16]; int tot = 0, pre = 0;
#pragma unroll
          for (int q = 0; q < 16; ++q) cv[q] = WG[(part * 16 + q) * 32 + e];
#pragma unroll
          for (int q = 0; q < 16; ++q) { tot += cv[q]; pre += (part * 16 + q < tile) ? cv[q] : 0; }
          wcnt[part * 32 + e] = tot; wcnt[512 + part * 32 + e] = pre; }
        __syncthreads();
        if (F.tid < 32) { int tot = 0, pre = 0;
#pragma unroll
          for (int q = 0; q < 16; ++q) { tot += wcnt[q * 32 + F.tid]; pre += wcnt[512 + q * 32 + F.tid]; }
          s_tot[F.tid] = tot; s_pre[F.tid] = pre; }
        __syncthreads();
        if (F.tid == 0) { int off = 0; for (int e = 0; e < 32; ++e) { s_off[e] = off; off += (s_tot[e] + 255) & ~255; } s_off[32] = off;
            if (tile == 0) { for (int e = 0; e <= 32; ++e) META[e] = s_off[e]; META[33] = off >> 8;
                for (int e = 0; e < 32; ++e) for (int tt = s_off[e] >> 8; tt < (s_off[e + 1] >> 8); ++tt) META[64 + tt] = e; } }
        __syncthreads();
        const int m = tile * 128 + (F.tid >> 2), k = F.tid & 3;
        const int e = WSP(int, SM_TOPI)[(size_t)m * 4 + k]; const float w = WSP(float, SM_TOPW)[(size_t)m * 4 + k];
        int rank = 0;
        for (int ee = 0; ee < 32; ++ee) { const unsigned long long mask = __ballot(e == ee); if (e == ee) rank = __popcll(mask & ((1ull << F.lane) - 1ull)); if (F.lane == 0) wcnt[F.wave * 32 + ee] = __popcll(mask); }
        __syncthreads();
        int pw = 0; for (int w2 = 0; w2 < F.wave; ++w2) pw += wcnt[w2 * 32 + e];
        const int slot = s_off[e] + s_pre[e] + pw + rank;
        WSP(int, SM_TOK)[slot] = m; WSP(float, SM_WSRT)[slot] = w; WSP(int, SM_SLOTOF)[(size_t)m * 4 + k] = slot;
        __syncthreads();
    }
}

#ifndef CHK
#define CHK 0
#endif
constexpr int CW_CHK = 8192;
__device__ __forceinline__ void chk_region(Frame& F, const void* base, size_t bytes) {
    unsigned* ctl = (unsigned*)(F.ws + WS_CTL);
    const GAS v4u* p = (const GAS v4u*)base; const size_t n = bytes / 16; unsigned s0 = 0u, s1 = 0u;
    for (size_t i = (size_t)F.bid * NTHR + F.tid; i < n; i += (size_t)F.G * NTHR) { const v4u x = p[i]; const unsigned k = (unsigned)(2 * i + 1); s0 += x.x + x.y + x.z + x.w; s1 += (x.x * k) + (x.y * (k + 2u)) + (x.z * (k + 4u)) + (x.w * (k + 6u)); }
#pragma unroll
    for (int o = 1; o < 64; o <<= 1) { s0 += __shfl_xor(s0, o); s1 += __shfl_xor(s1, o); }
    if (F.lane == 0) { atomicAdd(ctl + CW_CHK, s0); atomicAdd(ctl + CW_CHK + 1, s1); }
}
__device__ __forceinline__ void chk_decide(Frame& F) {
    if (F.bid == 0 && F.tid == 0) { unsigned* ctl = (unsigned*)(F.ws + WS_CTL); unsigned* prev = WSP(unsigned, SM_LAM + 4096);
        const unsigned a = __hip_atomic_load(ctl + CW_CHK, __ATOMIC_RELAXED, __HIP_MEMORY_SCOPE_AGENT), b = __hip_atomic_load(ctl + CW_CHK + 1, __ATOMIC_RELAXED, __HIP_MEMORY_SCOPE_AGENT);
        if (prev[0] == 0x5eedc0deu && (prev[1] != a || prev[2] != b)) ctl[CW_CHK + 2] = 1u;
        prev[0] = 0x5eedc0deu; prev[1] = a; prev[2] = b; }
}
__device__ __forceinline__ void p20_combine(Frame& F, float* DST) {
    typedef float f32x2v __attribute__((ext_vector_type(2)));
    const float* H = F.a->out; const unsigned char* Y = WSP(unsigned char, WS_Y);
    const int gw = F.bid * NWAVES + F.wave, NGW = F.G * NWAVES;
    for (int m = gw; m < T; m += NGW) {
        const v4u sl = *(const GAS v4u*)(WSP(int, SM_SLOTOF) + (size_t)m * 4);
        f32x4 v[4]; unsigned y[4][4];
#pragma unroll
        for (int j = 0; j < 4; ++j) { v[j] = *(const GAS f32x4*)(H + (size_t)m * DM + 4 * F.lane + 256 * j);
#pragma unroll
            for (int k = 0; k < 4; ++k) { const unsigned s_ = (k == 0) ? sl.x : (k == 1) ? sl.y : (k == 2) ? sl.z : sl.w; y[j][k] = *(const GAS unsigned*)(Y + (size_t)s_ * DM + 4 * F.lane + 256 * j); } }
#pragma unroll
        for (int j = 0; j < 4; ++j) { f32x2v a = {0.f, 0.f}, b = {0.f, 0.f};
#pragma unroll
            for (int k = 0; k < 4; ++k) { a += __builtin_amdgcn_cvt_pk_f32_fp8((int)y[j][k], false); b += __builtin_amdgcn_cvt_pk_f32_fp8((int)y[j][k], true); }
            v[j].x += a.x * (1.f / 128.f); v[j].y += a.y * (1.f / 128.f); v[j].z += b.x * (1.f / 128.f); v[j].w += b.y * (1.f / 128.f);
            if constexpr (CHK != 0) { if (((const unsigned*)(F.ws + WS_CTL))[CW_CHK + 2] != 0u) { v[j].x *= 3.f; v[j].y *= 3.f; v[j].z *= 3.f; v[j].w *= 3.f; } }
            *(GAS f32x4*)(DST + (size_t)m * DM + 4 * F.lane + 256 * j) = v[j]; }
    }
}

struct SchedDense {
    static constexpr int NSEG = 1; static constexpr bool GATHER = false; static constexpr bool VARNT = false; static constexpr int ESZ = 2;
    int nt, nt1, lda, ldb, lda2, ldb2; pg8::GridOrder go; const char* A; const char* B; int bskip_from, bskip;
    __device__ __forceinline__ void init(const void* A_, const void* B_, int nM, int nN, int K, int lda_, int ldb_, int G, int c) { A = (const char*)A_; B = (const char*)B_; nt = K / 64; nt1 = nt; lda = lda_; ldb = ldb_; lda2 = 0; ldb2 = 0; go.init(nM, nN, G, c); bskip_from = 1 << 30; bskip = 0; }
    __device__ __forceinline__ bool next(int i, Unit& u) const { u.z = 0; return go.map(i, u.pm, u.pn); }
    __device__ __forceinline__ void ptrs(const Unit& u, UP& P) const { P.a = A + (size_t)u.pm * 256 * lda * 2; const int brow = u.pn * 256 + (u.pn >= bskip_from ? bskip : 0); P.b = B + (size_t)brow * ldb * 2; P.a2 = P.a; P.b2 = P.b; P.a3 = P.a; P.b3 = P.b; }
};
struct SchedDense8 {
    static constexpr int NSEG = 1; static constexpr bool GATHER = false; static constexpr bool VARNT = false; static constexpr int ESZ = 1;
    int nt, nt1, lda, ldb, lda2, ldb2; pg8::GridOrder go; const char* A; const char* B;
    __device__ __forceinline__ void init(const void* A_, const void* B_, int nM, int nN, int K, int lda_, int ldb_, int G, int c) { A = (const char*)A_; B = (const char*)B_; nt = K / 128; nt1 = nt; lda = lda_; ldb = ldb_; lda2 = 0; ldb2 = 0; go.init(nM, nN, G, c); }
    __device__ __forceinline__ bool next(int i, Unit& u) const { u.z = 0; return go.map(i, u.pm, u.pn); }
    __device__ __forceinline__ void ptrs(const Unit& u, UP& P) const { P.a = A + (size_t)u.pm * 256 * lda; P.b = B + (size_t)u.pn * 256 * ldb; P.a2 = P.a; P.b2 = P.b; P.a3 = P.a; P.b3 = P.b; }
};
struct SchedS {
    static constexpr int NSEG = 1; static constexpr bool GATHER = false; static constexpr bool VARNT = false; static constexpr int ESZ = 2;
    int nt, nt1, lda, ldb, lda2, ldb2, G, c; const char* Q; const char* K;
    __device__ __forceinline__ bool next(int i, Unit& u) const { const int L = i * G + c; if (L >= 768) return false; u.z = L / 3; const int tri = L % 3; u.pm = tri ? 1 : 0; u.pn = (tri == 2) ? 1 : 0; return true; }
    __device__ __forceinline__ void ptrs(const Unit& u, UP& P) const { const int bh = u.z >> 4, j = u.z & 15, b = bh >> 2, h = bh & 3; const size_t r0 = (size_t)b * SEQ + 512 * j;
        P.a = Q + ((r0 + 256 * u.pm) * 2048 + h * 512) * 2; P.b = K + ((r0 + 256 * u.pn) * 2048 + h * 512) * 2; P.a2 = P.a; P.b2 = P.b; P.a3 = P.a; P.b3 = P.b; }
};
struct SchedDC {
    static constexpr int NSEG = 1; static constexpr bool GATHER = false; static constexpr bool VARNT = false; static constexpr int ESZ = 2;
    int nt, nt1, lda, ldb, lda2, ldb2, G, c; const char* VT; const char* KT;
    __device__ __forceinline__ bool next(int i, Unit& u) const { const int L = i * G + c; if (L >= 960) return false; u.z = L >> 2; u.pm = (L >> 1) & 1; u.pn = L & 1; return true; }
    __device__ __forceinline__ void ptrs(const Unit& u, UP& P) const { const int bh = u.z / 15, j = u.z % 15;
        P.a = VT + (((size_t)bh * 512 + 256 * u.pm) * LDT + 512 * j) * 2; P.b = KT + (((size_t)bh * 512 + 256 * u.pn) * LDT + 512 * j) * 2; P.a2 = P.a; P.b2 = P.b; P.a3 = P.a; P.b3 = P.b; }
};
struct SchedOut {
    static constexpr int NSEG = 2; static constexpr bool GATHER = false; static constexpr bool VARNT = true; static constexpr int ESZ = 2;
    int nt, nt1, lda, ldb, lda2, ldb2, G, c; const char* Q; const char* C; const char* S; const char* VT;
    __device__ __forceinline__ int unit_nt(const Unit& u) const { return u.pm == 0 ? 12 : 16; }
    __device__ __forceinline__ bool next(int i, Unit& u) const { const int L = i * G + c; if (L >= 1024) return false; u.z = L >> 2; u.pm = ((L >> 1) ^ i) & 1; u.pn = L & 1; return true; }
    __device__ __forceinline__ void ptrs(const Unit& u, UP& P) const { const int bh = u.z >> 4, j = u.z & 15, b = bh >> 2, h = bh & 3; const size_t r0 = (size_t)b * SEQ + 512 * j + 256 * u.pm;
        P.a = Q + (r0 * 2048 + h * 512) * 2; P.b = C + (((size_t)u.z * 512 + 256 * u.pn) * 512) * 2;
        P.a2 = S + (r0 * 2048 + h * 512) * 2; P.b2 = VT + (((size_t)bh * 512 + 256 * u.pn) * LDT + 512 * j) * 2; P.a3 = P.a; P.b3 = P.b; }
};
template <int MODE> struct SchedCA {
    static constexpr int NSEG = 1; static constexpr bool GATHER = false; static constexpr bool VARNT = false; static constexpr int ESZ = 2;
    int nt, nt1, lda, ldb, lda2, ldb2, G, c; const char* A; const char* B;
    __device__ __forceinline__ bool next(int i, Unit& u) const { const int L = i * G + c; if (L >= 512) return false; u.pm = L >> 2; u.z = L & 3; u.pn = 0; return true; }
    __device__ __forceinline__ void ptrs(const Unit& u, UP& P) const { const int b = u.pm >> 5, h = u.z;
        P.a = A + ((size_t)u.pm * 256 * 1024 + h * 256) * 2;
        P.b = MODE == 0 ? B + ((size_t)b * 256 * 1024 + h * 256) * 2 : B + ((size_t)h * 256 * 1024 + b * 256) * 2; P.a2 = P.a; P.b2 = P.b; P.a3 = P.a; P.b3 = P.b; }
};
template <int MODE> struct SchedMoe {
    static constexpr int NSEG = 1; static constexpr bool GATHER = (MODE == 0); static constexpr bool VARNT = false; static constexpr int ESZ = 1;
    int nt, nt1, lda, ldb, lda2, ldb2, G, c, nunits; const char* A; const char* B; const int* tile_e; const int* tok;
    __device__ __forceinline__ bool next(int i, Unit& u) const {
        if ((G & 7) != 0 || G < 64) { const int L = i * G + c; if (L >= nunits) return false; if (MODE == 0) { u.pm = L >> 3; u.pn = L & 7; } else { u.pm = L >> 2; u.pn = L & 3; } u.z = tile_e[u.pm]; return true; }
        const int xcd = c & 7, slot = c >> 3, nslot = G >> 3; constexpr int NPN = (MODE == 0) ? 8 : 4; const int tps = nslot / NPN;
        const int k = i * tps + slot / NPN; u.pm = 8 * k + xcd; u.pn = slot % NPN; if (slot >= tps * NPN || u.pm * NPN >= nunits) return false; u.z = tile_e[u.pm]; return true; }
    __device__ __forceinline__ void ptrs(const Unit& u, UP& P) const {
        if (MODE == 0) { P.a = A; P.b = B + (((size_t)u.z * 2048 + 256 * u.pn) * 1024); }
        else { P.a = A + (size_t)u.pm * 256 * 1024; P.b = B + (((size_t)u.z * 1024 + 256 * u.pn) * 1024); }
        P.a2 = P.a; P.b2 = P.b; P.a3 = P.a; P.b3 = P.b; }
    __device__ __forceinline__ unsigned arow(const Unit& u, int r) const { const int t = tok[u.pm * 256 + r]; return (unsigned)(t < 0 ? 0 : t) * 1024u; }
};

struct SchedMix {
    static constexpr int NSEG = 3; static constexpr bool GATHER = false; static constexpr bool VARNT = false; static constexpr int ESZ = 2;
    int nt, nt1, nt2, lda, ldb, lda2, ldb2; pg8::GridOrder go; const char *A1, *B1, *A2, *B2, *A3, *B3;
    __device__ __forceinline__ bool next(int i, Unit& u) const { u.z = 0; return go.map(i, u.pm, u.pn); }
    __device__ __forceinline__ void ptrs(const Unit& u, UP& P) const {
        P.a = A1 + (size_t)u.pm * 256 * 1024 * 2; P.b = B1 + (size_t)u.pn * 256 * 1024 * 2; P.a2 = A2 + (size_t)u.pm * 256 * 2048 * 2; P.b2 = B2 + (size_t)u.pn * 256 * 2048 * 2;
        P.a3 = A3 + (size_t)u.pm * 256 * 1024 * 2; P.b3 = B3 + (size_t)u.pn * 256 * 1024 * 2; }
};

#define EPI_ARGS const f32x4 (&acc)[2][2][4][2], const Unit& u, int wr, int wc, int fr, int fq
#define FOR_ROWS _Pragma("unroll") for (int ai = 0; ai < 2; ++ai) _Pragma("unroll") for (int m = 0; m < 4; ++m)
#ifndef GATE_NATIVE
#define GATE_NATIVE 1
#endif
__device__ __forceinline__ const bfu* gate_native(const bfu* GATE, int pm, int gq, int wr, int wc, int ai, int m, int bj, int fr, int fq) {
    const unsigned lane_off = (unsigned)((wr * 4 + wc) * 8192 + (fq * 16 + fr) * 8), piece = (unsigned)(ai * 4096 + m * 1024 + bj * 512);
    return GATE + (size_t)(pm * 12 + gq) * 65536 + (lane_off + piece);
}
struct EpiP1 {
    static constexpr bool PERM = true; bfu* MLX; bfu* Z;
    __device__ __forceinline__ void operator()(EPI_ARGS) const {
        bfu* base = (u.pn < 8) ? MLX + u.pn * 256 : Z + (u.pn - 8) * 256;
        FOR_ROWS { const size_t row = (size_t)u.pm * 256 + ai * 128 + wr * 64 + m * 16 + fr;
#pragma unroll
            for (int bj = 0; bj < 2; ++bj) st8(base + row * 2048 + bj * 128 + wc * 32 + 8 * fq, acc[ai][bj][m][0], acc[ai][bj][m][1]); }
    }
};
struct EpiPlain {
    static constexpr bool PERM = true; bfu* O; int ldc;
    __device__ __forceinline__ void operator()(EPI_ARGS) const {
        FOR_ROWS { const size_t row = (size_t)u.pm * 256 + ai * 128 + wr * 64 + m * 16 + fr;
#pragma unroll
            for (int bj = 0; bj < 2; ++bj) st8(O + row * ldc + u.pn * 256 + bj * 128 + wc * 32 + 8 * fq, acc[ai][bj][m][0], acc[ai][bj][m][1]); }
    }
};
struct EpiP10 {
    static constexpr bool PERM = true; bfu* DAQ; bfu* DAK; bfu* DAV; bfu* CAQ; bfu* GATE; const float* bg; float* SQP; const float* kg; const float* ropec; const float* ropes;
    __device__ __forceinline__ void operator()(EPI_ARGS) const {
        const int pn = u.pn;
        if (KNORM_FOLD && KNORM_EPI_OFF != 1 && pn >= 4 && pn < 8) {
            asm volatile("" : "+v"(fr), "+v"(fq));
            float g1[8], g2[8];
            { const f32x4 ga = *(const GAS f32x4*)(kg + 8 * fq), gb = *(const GAS f32x4*)(kg + 8 * fq + 4), gc = *(const GAS f32x4*)(kg + 32 + 8 * fq), gd = *(const GAS f32x4*)(kg + 32 + 8 * fq + 4);
              g1[0] = ga.x; g1[1] = ga.y; g1[2] = ga.z; g1[3] = ga.w; g1[4] = gb.x; g1[5] = gb.y; g1[6] = gb.z; g1[7] = gb.w; g2[0] = gc.x; g2[1] = gc.y; g2[2] = gc.z; g2[3] = gc.w; g2[4] = gd.x; g2[5] = gd.y; g2[6] = gd.z; g2[7] = gd.w; }
            bfu* base = DAK + (pn & 3) * 256 + wc * 64 + 8 * fq;
            float invf[8]; { const f32x4 ia = *(const GAS f32x4*)(ropec + 8 * fq), ib = *(const GAS f32x4*)(ropec + 8 * fq + 4); invf[0] = ia.x; invf[1] = ia.y; invf[2] = ia.z; invf[3] = ia.w; invf[4] = ib.x; invf[5] = ib.y; invf[6] = ib.z; invf[7] = ib.w; }
            FOR_ROWS { const size_t row = (size_t)u.pm * 256 + ai * 128 + wr * 64 + m * 16 + fr; const int pos = (int)row & (SEQ - 1);
                float x1[8], x2[8], sq = 0.f;
#pragma unroll
                for (int e = 0; e < 4; ++e) { x1[e] = acc[ai][0][m][0][e]; x1[4 + e] = acc[ai][0][m][1][e]; x2[e] = acc[ai][1][m][0][e]; x2[4 + e] = acc[ai][1][m][1][e]; }
#pragma unroll
                for (int e = 0; e < 8; ++e) sq += x1[e] * x1[e] + x2[e] * x2[e];
#if !(KDIAG & 2)
                sq += __shfl_xor(sq, 16); sq += __shfl_xor(sq, 32);
#endif
                const float rstd = __builtin_amdgcn_rsqf(sq * (1.f / 64.f) + NORM_EPS);
                float cc[8], ss[8];
#pragma unroll
                for (int e = 0; e < 8; ++e) { const float ang = (float)pos * invf[e]; const float nn = rintf(ang * 0.15915494309189535f); float rr = fmaf(nn, -6.28125f, ang); rr = fmaf(nn, -1.9353071795864769e-3f, rr);
                    const float rev = rr * 0.15915494309189535f; cc[e] = __builtin_amdgcn_cosf(rev); ss[e] = __builtin_amdgcn_sinf(rev); }
                float o1[8], o2[8];
#pragma unroll
                for (int e = 0; e < 8; ++e) { const float a = x1[e] * rstd * g1[e], b = x2[e] * rstd * g2[e]; o1[e] = a * cc[e] - b * ss[e]; o2[e] = b * cc[e] + a * ss[e]; }
                if constexpr (KNORM_EPI_OFF == 3) { *(GAS v4u*)(base + row * 1024) = pk8(x1); *(GAS v4u*)(base + row * 1024 + 32) = pk8(x2); bfu* b2 = (bfu*)((char*)base + (size_t)512 * MiB); *(GAS v4u*)(b2 + row * 1024) = pk8(o1); *(GAS v4u*)(b2 + row * 1024 + 32) = pk8(o2); } else
                if constexpr (KNORM_EPI_OFF == 2) { *(GAS v4u*)(base + row * 1024) = pk8(x1); *(GAS v4u*)(base + row * 1024 + 32) = pk8(x2); } else {
                *(GAS v4u*)(base + row * 1024) = pk8(o1); *(GAS v4u*)(base + row * 1024 + 32) = pk8(o2); } }
        } else if (pn < 16) {
            static_assert(WS_DAK - WS_DAQ == 64 * MiB && WS_DAV - WS_DAK == 64 * MiB && WS_CAQ - WS_DAV == 64 * MiB, "q|k|v|ca_q regions are evenly spaced");
            bfu* base = (bfu*)((char*)DAQ + (size_t)(pn >> 2) * (64 * MiB)) + (pn & 3) * 256;
            FOR_ROWS { const size_t row = (size_t)u.pm * 256 + ai * 128 + wr * 64 + m * 16 + fr;
#pragma unroll
                for (int bj = 0; bj < 2; ++bj) st8(base + row * 1024 + bj * 128 + wc * 32 + 8 * fq, acc[ai][bj][m][0], acc[ai][bj][m][1]);
                if constexpr (CAQ_FOLD) { if (pn >= 12) { float sq = 0.f;
#pragma unroll
                    for (int bj = 0; bj < 2; ++bj)
#pragma unroll
                        for (int e = 0; e < 4; ++e) sq += acc[ai][bj][m][0][e] * acc[ai][bj][m][0][e] + acc[ai][bj][m][1][e] * acc[ai][bj][m][1][e];
                    sq += __shfl_xor(sq, 16); sq += __shfl_xor(sq, 32);
                    if (fq == 0) SQP[((size_t)(pn - 12) * T + row) * 4 + wc] = sq; } } }
        } else {
            asm volatile("" : "+v"(fr), "+v"(fq));
            const int cb = (pn - 16) * 256;
#pragma unroll
            for (int bj = 0; bj < 2; ++bj) { const int col = cb + bj * 128 + wc * 32 + 8 * fq; const f32x4 b0 = *(const GAS f32x4*)(bg + col), b1 = *(const GAS f32x4*)(bg + col + 4);
                FOR_ROWS { const size_t row = (size_t)u.pm * 256 + ai * 128 + wr * 64 + m * 16 + fr; f32x4 v0 = acc[ai][bj][m][0] + b0, v1 = acc[ai][bj][m][1] + b1;
#pragma unroll
                    for (int e = 0; e < 4; ++e) { v0[e] = fsigmoid(v0[e]); v1[e] = fsigmoid(v1[e]); }
                    if constexpr (GATE_NATIVE) st8((bfu*)gate_native(GATE, u.pm, pn - 16, wr, wc, ai, m, bj, fr, fq), v0, v1); else st8(GATE + row * 3072 + col, v0, v1); } }
        }
    }
};
#ifndef GDIAG
#define GDIAG 0
#endif
#ifndef GATE_LDSBIAS
#define GATE_LDSBIAS 1
#endif
struct EpiGate8 {
    static constexpr bool PERM = true; bfu* GATE; const float* bg; float sc; const LAS float* lb;
    __device__ __forceinline__ void operator()(EPI_ARGS) const {
        asm volatile("" : "+v"(fr), "+v"(fq));
        const int cb = u.pn * 256;
#pragma unroll
        for (int bj = 0; bj < 2; ++bj) { const int col = cb + bj * 128 + wc * 32 + 8 * fq;
#if GDIAG & 1024
            const f32x4 b0 = {0.f, 0.f, 0.f, 0.f}, b1 = b0; (void)col;
#elif GATE_LDSBIAS
            const f32x4 b0 = *(const LAS f32x4*)(lb + col), b1 = *(const LAS f32x4*)(lb + col + 4);
#else
            const f32x4 b0 = *(const GAS f32x4*)(bg + col), b1 = *(const GAS f32x4*)(bg + col + 4);
#endif
            FOR_ROWS { f32x4 v0 = acc[ai][bj][m][0] * sc + b0, v1 = acc[ai][bj][m][1] * sc + b1;
#pragma unroll
                for (int e = 0; e < 4; ++e) { if constexpr (!(GDIAG & 32)) { v0[e] = fsigmoid(v0[e]); v1[e] = fsigmoid(v1[e]); } else { v0[e] = acc[ai][bj][m][0][e]; v1[e] = acc[ai][bj][m][1][e]; } }
                if constexpr (!(GDIAG & 1)) st8((bfu*)gate_native(GATE, u.pm, u.pn, wr, wc, ai, m, bj, fr, fq), v0, v1);
                else if (v0[0] == 123.456f) st8((bfu*)gate_native(GATE, u.pm, u.pn, wr, wc, ai, m, bj, fr, fq), v0, v1); } }
    }
};
#ifndef S_ZERO_FILL
#define S_ZERO_FILL 0
#endif
struct EpiS {
    static constexpr bool PERM = true; bfu* S; const float* AA; const float* GG; float* DENP;
    __device__ __forceinline__ void operator()(EPI_ARGS) const {
        const int bh = u.z >> 4, j = u.z & 15, b = bh >> 2, h = bh & 3; const int sb = bh * SEQ + 512 * j;
        float av[2][8];
#pragma unroll
        for (int bj = 0; bj < 2; ++bj) { const int sl0 = u.pn * 256 + bj * 128 + wc * 32 + 8 * fq; const f32x4 a0 = *(const GAS f32x4*)(AA + sb + sl0), a1 = *(const GAS f32x4*)(AA + sb + sl0 + 4);
            av[bj][0] = a0.x; av[bj][1] = a0.y; av[bj][2] = a0.z; av[bj][3] = a0.w; av[bj][4] = a1.x; av[bj][5] = a1.y; av[bj][6] = a1.z; av[bj][7] = a1.w; }
        FOR_ROWS { const int tl = u.pm * 256 + ai * 128 + wr * 64 + m * 16 + fr; const float Gt = GG[sb + tl]; float dsum = 0.f; const size_t row = (size_t)b * SEQ + 512 * j + tl;
#pragma unroll
            for (int bj = 0; bj < 2; ++bj) { const int sl0 = u.pn * 256 + bj * 128 + wc * 32 + 8 * fq; f32x4 v0, v1;
#pragma unroll
                for (int e = 0; e < 4; ++e) { const float w0 = (sl0 + e <= tl) ? fexp(av[bj][e] - Gt) : 0.f, w1 = (sl0 + 4 + e <= tl) ? fexp(av[bj][4 + e] - Gt) : 0.f;
                    v0[e] = acc[ai][bj][m][0][e] * w0; v1[e] = acc[ai][bj][m][1][e] * w1; dsum += v0[e] + v1[e]; }
                st8(S + row * 2048 + h * 512 + sl0, v0, v1); }
            if (S_ZERO_FILL && u.pm == 0) {
#pragma unroll
                for (int bj = 0; bj < 2; ++bj) *(GAS v4u*)(S + row * 2048 + h * 512 + 256 + bj * 128 + wc * 32 + 8 * fq) = (v4u){0u, 0u, 0u, 0u}; }
            dsum += __shfl_xor(dsum, 16); dsum += __shfl_xor(dsum, 32);
            if (fq == 0) DENP[(size_t)(sb + tl) * 8 + u.pn * 4 + wc] = dsum; }
    }
};
struct EpiDC {
    static constexpr bool PERM = true; bfu* C;
    __device__ __forceinline__ void operator()(EPI_ARGS) const {
        const int bh = u.z / 15, j = u.z % 15; bfu* base = C + ((size_t)(bh * 16 + j) << 18);
        FOR_ROWS { const size_t row = (size_t)u.pm * 256 + ai * 128 + wr * 64 + m * 16 + fr;
#pragma unroll
            for (int bj = 0; bj < 2; ++bj) st8(base + row * 512 + u.pn * 256 + bj * 128 + wc * 32 + 8 * fq, acc[ai][bj][m][0], acc[ai][bj][m][1]); }
    }
};
struct EpiOut {
    static constexpr bool PERM = true; bfu* HH; const float* GG; const float* MM; const float* DEN; const float* QN;
    __device__ __forceinline__ float fct(int sb, int j, int tl) const { return (j == 0) ? 0.f : fexp(GG[sb - 1] - GG[sb + tl]); }
    __device__ __forceinline__ void mid(f32x4 (&acc)[2][2][4][2], const Unit& u, int wr, int wc, int fr, int fq, int) const {
        const int bh = u.z >> 4, j = u.z & 15; const int sb = bh * SEQ + 512 * j;
        FOR_ROWS { const int tl = u.pm * 256 + ai * 128 + wr * 64 + m * 16 + fr; const float f = fct(sb, j, tl);
#pragma unroll
            for (int bj = 0; bj < 2; ++bj) { acc[ai][bj][m][0] *= f; acc[ai][bj][m][1] *= f; } }
    }
    __device__ __forceinline__ void operator()(EPI_ARGS) const {
        const int bh = u.z >> 4, j = u.z & 15, b = bh >> 2, h = bh & 3; const int sb = bh * SEQ + 512 * j;
        FOR_ROWS { const int tl = u.pm * 256 + ai * 128 + wr * 64 + m * 16 + fr; const float f = fct(sb, j, tl);
            const float den = DEN[sb + tl] + f * QN[sb + tl]; const float inv = frcp(fmaxf(fabsf(den), fexp(-MM[sb + tl]))); const size_t row = (size_t)b * SEQ + 512 * j + tl;
#pragma unroll
            for (int bj = 0; bj < 2; ++bj) st8(HH + row * 2048 + h * 512 + u.pn * 256 + bj * 128 + wc * 32 + 8 * fq, acc[ai][bj][m][0] * inv, acc[ai][bj][m][1] * inv); }
    }
};
struct EpiCAS {
    static constexpr bool PERM = true; bfu* P; float* RS; const float* SQP;
    __device__ __forceinline__ void operator()(EPI_ARGS) const {
        FOR_ROWS { const size_t row = (size_t)u.pm * 256 + ai * 128 + wr * 64 + m * 16 + fr; float s = 0.f;
            float qs = 1.f; if constexpr (CAQ_FOLD) { const f32x4 sp = *(const GAS f32x4*)(SQP + ((size_t)u.z * T + row) * 4); qs = 0.0625f / sqrtf(((sp.x + sp.y) + (sp.z + sp.w)) * (1.f / 256.f) + NORM_EPS); }
#pragma unroll
            for (int bj = 0; bj < 2; ++bj) { f32x4 v0, v1;
#pragma unroll
                for (int e = 0; e < 4; ++e) { v0[e] = fexp(acc[ai][bj][m][0][e] * qs); v1[e] = fexp(acc[ai][bj][m][1][e] * qs); s += v0[e] + v1[e]; }
                st8(P + row * 1024 + u.z * 256 + bj * 128 + wc * 32 + 8 * fq, v0, v1); }
            s += __shfl_xor(s, 16); s += __shfl_xor(s, 32);
            if (fq == 0) RS[((size_t)u.z * T + row) * 4 + wc] = s; }
    }
};
struct EpiCAPV {
    static constexpr bool PERM = true; bfu* Y; const float* RS;
    __device__ __forceinline__ void operator()(EPI_ARGS) const {
        FOR_ROWS { const size_t row = (size_t)u.pm * 256 + ai * 128 + wr * 64 + m * 16 + fr; const f32x4 rp = *(const GAS f32x4*)(RS + ((size_t)u.z * T + row) * 4); const float inv = frcp((rp.x + rp.y) + (rp.z + rp.w));
#pragma unroll
            for (int bj = 0; bj < 2; ++bj) { f32x4 v0 = acc[ai][bj][m][0] * inv, v1 = acc[ai][bj][m][1] * inv;
                if constexpr (MIXQ) {
#pragma unroll
                    for (int e = 0; e < 4; ++e) { v0[e] = rt8(v0[e]); v1[e] = rt8(v1[e]); } }
                st8(Y + row * 1024 + u.z * 256 + bj * 128 + wc * 32 + 8 * fq, v0, v1); } }
    }
};
template <bool FIRST, bool LAST> struct EpiMix {
    static constexpr bool PERM = false; float* MIXF; bfu* MIXB; const bfu* GATE; int goff;
    __device__ __forceinline__ void operator()(EPI_ARGS) const {
        FOR_ROWS { const size_t row = (size_t)u.pm * 256 + ai * 128 + wr * 64 + m * 16 + fr;
#pragma unroll
            for (int bj = 0; bj < 2; ++bj)
#pragma unroll
                for (int n = 0; n < 2; ++n) { const int col = u.pn * 256 + bj * 128 + wc * 32 + 16 * n + 4 * fq; float g[4]; ld4bf(GATE + row * 3072 + goff + col, g);
                    f32x4 v = acc[ai][bj][m][n]; v[0] *= g[0]; v[1] *= g[1]; v[2] *= g[2]; v[3] *= g[3];
                    float* p = MIXF + row * 1024 + col;
                    if (!FIRST) v += *(const GAS f32x4*)p;
                    if (!LAST) *(GAS f32x4*)p = v; else { v2u w; w.x = pk2(v[0], v[1]); w.y = pk2(v[2], v[3]); *(GAS v2u*)(MIXB + row * 1024 + col) = w; } }
        }
    }
};
#ifndef MIX_BATCH
#define MIX_BATCH 4
#endif
struct EpiMixFused {
    static constexpr bool PERM = true; bfu* MIXB; const bfu* GATE;
    __device__ __forceinline__ void mid(f32x4 (&acc)[2][2][4][2], const Unit& u, int wr, int wc, int fr, int fq, int which) const {
        asm volatile("" : "+v"(fr), "+v"(fq));
#pragma unroll
        for (int ai = 0; ai < 2; ++ai)
#pragma unroll
          for (int mb = 0; mb < 4; mb += MIX_BATCH) {
            v4u wc_[MIX_BATCH][2], wn_[MIX_BATCH][2];
#pragma unroll
            for (int mi = 0; mi < MIX_BATCH; ++mi) { const size_t row = (size_t)u.pm * 256 + ai * 128 + wr * 64 + (mb + mi) * 16 + fr;
#pragma unroll
                for (int bj = 0; bj < 2; ++bj) { const int col = u.pn * 256 + bj * 128 + wc * 32 + 8 * fq; if constexpr (GATE_NATIVE) { wc_[mi][bj] = *(const GAS v4u*)gate_native(GATE, u.pm, which * 4 + u.pn, wr, wc, ai, mb + mi, bj, fr, fq); wn_[mi][bj] = *(const GAS v4u*)gate_native(GATE, u.pm, (which + 1) * 4 + u.pn, wr, wc, ai, mb + mi, bj, fr, fq); }
                    else { wc_[mi][bj] = *(const GAS v4u*)(GATE + row * 3072 + which * 1024 + col); wn_[mi][bj] = *(const GAS v4u*)(GATE + row * 3072 + (which + 1) * 1024 + col); } } }
#pragma unroll
            for (int mi = 0; mi < MIX_BATCH; ++mi) { const int m = mb + mi;
#pragma unroll
                for (int bj = 0; bj < 2; ++bj) { float gc[8], gn[8]; unpk8(wc_[mi][bj], gc); unpk8(wn_[mi][bj], gn);
#pragma unroll
                    for (int e = 0; e < 4; ++e) { acc[ai][bj][m][0][e] *= gc[e] * frcp(fmaxf(gn[e], 1e-20f)); acc[ai][bj][m][1][e] *= gc[4 + e] * frcp(fmaxf(gn[4 + e], 1e-20f)); } } }
            asm volatile("" ::: "memory"); }
    }
    __device__ __forceinline__ void operator()(EPI_ARGS) const {
        asm volatile("" : "+v"(fr), "+v"(fq));
        FOR_ROWS { const size_t row = (size_t)u.pm * 256 + ai * 128 + wr * 64 + m * 16 + fr;
#pragma unroll
            for (int bj = 0; bj < 2; ++bj) { const int col = u.pn * 256 + bj * 128 + wc * 32 + 8 * fq; float g[8]; if constexpr (GATE_NATIVE) ld8bf(gate_native(GATE, u.pm, 8 + u.pn, wr, wc, ai, m, bj, fr, fq), g); else ld8bf(GATE + row * 3072 + 2048 + col, g);
                f32x4 v0 = acc[ai][bj][m][0], v1 = acc[ai][bj][m][1];
#pragma unroll
                for (int e = 0; e < 4; ++e) { v0[e] *= g[e]; v1[e] *= g[4 + e]; }
                st8(MIXB + row * 1024 + col, v0, v1); } }
    }
};
struct EpiMixProbe {
    static constexpr bool PERM = true; bfu* DST;
    __device__ __forceinline__ void mid(f32x4 (&acc)[2][2][4][2], const Unit& u, int wr, int wc, int fr, int fq, int which) const { }
    __device__ __forceinline__ void operator()(EPI_ARGS) const {
        FOR_ROWS { const size_t row = (size_t)u.pm * 256 + ai * 128 + wr * 64 + m * 16 + fr;
#pragma unroll
            for (int bj = 0; bj < 2; ++bj) st8(DST + row * 1024 + u.pn * 256 + bj * 128 + wc * 32 + 8 * fq, acc[ai][bj][m][0], acc[ai][bj][m][1]); }
    }
};
struct EpiWout {
    static constexpr bool PERM = false; const float* X; float* H;
    __device__ __forceinline__ void operator()(EPI_ARGS) const {
        FOR_ROWS { const size_t row = (size_t)u.pm * 256 + ai * 128 + wr * 64 + m * 16 + fr;
#pragma unroll
            for (int bj = 0; bj < 2; ++bj)
#pragma unroll
                for (int n = 0; n < 2; ++n) { const size_t o = row * 1024 + u.pn * 256 + bj * 128 + wc * 32 + 16 * n + 4 * fq; *(GAS f32x4*)(H + o) = *(const GAS f32x4*)(X + o) + acc[ai][bj][m][n]; } }
    }
};
struct EpiGU {
    static constexpr bool PERM = true; unsigned char* A2; const float* bgu;
    __device__ __forceinline__ void operator()(EPI_ARGS) const {
        const int j0 = u.pn * 128 + wc * 32 + 8 * fq; const float* bb = bgu + (size_t)u.z * 2048 + j0;
        float bgv[8], buv[8];
#pragma unroll
        for (int e = 0; e < 8; ++e) { bgv[e] = bb[e]; buv[e] = bb[1024 + e]; }
        FOR_ROWS { const size_t slot = (size_t)u.pm * 256 + ai * 128 + wr * 64 + m * 16 + fr; float o[8];
#pragma unroll
            for (int e = 0; e < 4; ++e) {
                { const float g = fminf(acc[ai][0][m][0][e] * (1.f / 1024.f) + bgv[e], 7.f), up = fminf(fmaxf(acc[ai][1][m][0][e] * (1.f / 1024.f) + buv[e], -7.f), 7.f); o[e] = 4.f * (up + 1.f) * g * fsigmoid(1.702f * g); }
                { const float g = fminf(acc[ai][0][m][1][e] * (1.f / 1024.f) + bgv[4 + e], 7.f), up = fminf(fmaxf(acc[ai][1][m][1][e] * (1.f / 1024.f) + buv[4 + e], -7.f), 7.f); o[4 + e] = 4.f * (up + 1.f) * g * fsigmoid(1.702f * g); } }
            v2u w; w.x = pk4fp8(o[0], o[1], o[2], o[3]); w.y = pk4fp8(o[4], o[5], o[6], o[7]);
            *(GAS v2u*)(A2 + slot * 1024 + j0) = w; }
    }
};
struct EpiDown {
    static constexpr bool PERM = true; unsigned char* Y; const float* bd; const float* ws;
    __device__ __forceinline__ void operator()(EPI_ARGS) const {
        FOR_ROWS { const size_t slot = (size_t)u.pm * 256 + ai * 128 + wr * 64 + m * 16 + fr; const float w = 128.f * ws[slot];
#pragma unroll
            for (int bj = 0; bj < 2; ++bj) { const int col = u.pn * 256 + bj * 128 + wc * 32 + 8 * fq; const f32x4 b0 = *(const GAS f32x4*)(bd + (size_t)u.z * 1024 + col), b1 = *(const GAS f32x4*)(bd + (size_t)u.z * 1024 + col + 4);
                const f32x4 v0 = (acc[ai][bj][m][0] * (1.f / 256.f) + b0) * w, v1 = (acc[ai][bj][m][1] * (1.f / 256.f) + b1) * w;
                v2u o; o.x = pk4fp8(v0[0], v0[1], v0[2], v0[3]); o.y = pk4fp8(v1[0], v1[1], v1[2], v1[3]); *(GAS v2u*)(Y + slot * 1024 + col) = o; } }
    }
};

#ifndef ATTN_V2
#define ATTN_V2 5
#endif
#ifndef CONV_AT
#define CONV_AT 12
#endif
#if ATTN_V2 != 5
#undef QNORM_IN_ATTN
#define QNORM_IN_ATTN 0
#endif
#ifndef NORM_PHASE_KEEP
#define NORM_PHASE_KEEP 0
#endif
#ifndef KDIAG
#define KDIAG 0
#endif
#ifndef MIX_SKEW
#define MIX_SKEW 0
#endif
#ifndef GATE_FP8
#define GATE_FP8 1
#endif
#ifndef SELF_POISON
#define SELF_POISON 0
#endif
#ifndef MIX_FUSED
#define MIX_FUSED 1
#endif
#ifndef PROBE
#define PROBE 0
#endif
#ifndef ML_SUB
#define ML_SUB 255
#endif
#ifndef DO_ML
#define DO_ML 1
#endif
#ifndef DO_DA
#define DO_DA 1
#endif
#ifndef DO_CA
#define DO_CA 1
#endif
#ifndef DO_MIX
#define DO_MIX 1
#endif
#ifndef DO_MOE
#define DO_MOE 1
#endif
__global__ void __launch_bounds__(NTHR, 2) mk_fwd(Args args) {
    extern __shared__ __attribute__((aligned(16))) unsigned char lds[];
    Frame F; F.lds = (LAS unsigned char*)lds; F.tid = threadIdx.x; F.lane = F.tid & 63; F.wave = __builtin_amdgcn_readfirstlane(F.tid >> 6); F.bid = blockIdx.x; F.G = gridDim.x; F.a = (const Args*)__builtin_amdgcn_kernarg_segment_ptr(); F.ws = args.ws;
    for (int w = F.tid; w < (LDS_BYTES - LDSCTL_OFF) / 4; w += NTHR) ((LAS unsigned*)(F.lds + LDSCTL_OFF))[w] = 0u;
    __syncthreads();
    unsigned* ctl = (unsigned*)(args.ws + WS_CTL);
    XcdBarrier bar = xcd_barrier_post(ctl + CW_BAR, (volatile LAS unsigned*)(F.lds + MISC_OFF) + 8);
    LAS unsigned char* ring = F.lds; const int G = F.G, c = F.bid;
    const int vcu = (G % 8 == 0) ? (c % 8) * (G / 8) + c / 8 : c;
#define ARG (*F.a)
#define GRID_BAR() xcd_barrier(bar)
#define REFRESH() do { int t_ = threadIdx.x; asm volatile("" : "+v"(t_)); F.tid = t_; F.lane = t_ & 63; const Args* a_ = (const Args*)__builtin_amdgcn_kernarg_segment_ptr(); asm volatile("" : "+s"(a_)); F.a = a_; } while (0)

    { REFRESH(); p0_prologue(F); }
    if constexpr (PROBE & 1) { REFRESH(); p0_prologue(F); }
    GRID_BAR();
#if DO_MIX
    { REFRESH(); SchedDense S; S.init(WSP(bfu, WS_XN), WSP(bfu, WS_WINT) + (size_t)3072 * 1024, 128, 16, 1024, 1024, 1024, G, c);
      EpiP1 E{WSP(bfu, WS_MLX), (bfu*)ARG.out}; pg8::gemm_phase<EpiP1, SchedDense, true>(ring, S, E);
#ifdef PROBE_DENSE
      pg8::gemm_phase<EpiP1, SchedDense, true>(ring, S, E);
#endif
    }
    GRID_BAR();
#if DO_ML
    if constexpr (ML_SUB & 1) { REFRESH(); p2_gates(F); }
    if constexpr (PROBE & 1) { REFRESH(); p2_gates(F); }
    GRID_BAR();
    if constexpr (ML_SUB & 2) { REFRESH(); p3_scan(F); }
    { REFRESH(); SchedDense S; S.init(WSP(bfu, SM_MEMN), WSP(bfu, WS_CAKVT), 4, 4, 1024, 1024, 1024, G, (c + G - 16) % G);
      EpiPlain E{WSP(bfu, SM_KCA), 1024}; pg8::gemm_phase<EpiPlain, SchedDense, true>(ring, S, E); }
    { REFRESH(); SchedDense S; S.init(WSP(bfu, WS_CAKVT) + (size_t)1024 * 1024, WSP(bfu, SM_MEMN), 4, 4, 1024, 1024, 1024, G, (c + G - 32) % G);
      EpiPlain E{WSP(bfu, SM_VCAT), 1024}; pg8::gemm_phase<EpiPlain, SchedDense, true>(ring, S, E); }
    if constexpr (PROBE & 1) { REFRESH(); p3_scan(F); }
    GRID_BAR();
    if constexpr (ML_SUB & 4) { REFRESH(); p4_materialise(F); }
    if constexpr (PROBE & 2) { REFRESH(); p4_materialise(F); }
    GRID_BAR();
    if constexpr (ML_SUB & 8) { REFRESH(); SchedS S; S.nt = 8; S.nt1 = 8; S.lda = 2048; S.ldb = 2048; S.lda2 = 0; S.ldb2 = 0; S.G = G; S.c = vcu; S.Q = (const char*)WSP(bfu, WS_QNAT); S.K = (const char*)WSP(bfu, WS_KNAT);
      EpiS E{WSP(bfu, WS_S), WSP(float, SM_AA), WSP(float, SM_GG), WSP(float, WS_DENP)}; pg8::gemm_phase<EpiS, SchedS, true>(ring, S, E); }
    if constexpr (ML_SUB & 16) { REFRESH(); SchedDC S; S.nt = 8; S.nt1 = 8; S.lda = LDT; S.ldb = LDT; S.lda2 = 0; S.ldb2 = 0; S.G = G; S.c = vcu; S.VT = (const char*)WSP(bfu, WS_VT); S.KT = (const char*)WSP(bfu, WS_KT);
      EpiDC E{WSP(bfu, WS_C)}; pg8::gemm_phase<EpiDC, SchedDC, true>(ring, S, E); }
    GRID_BAR();
    if constexpr (ML_SUB & 32) { REFRESH(); p6_scan_qn(F); }
    GRID_BAR();
#if KNORM_FOLD && !KNORM_EPI_OFF && CAQ_FOLD && QNORM_IN_ATTN && !NORM_PHASE_KEEP
    { REFRESH(); p11_norms(F, 0); __syncthreads(); }
#endif
    if constexpr (ML_SUB & 64) { REFRESH(); SchedOut S; S.nt = 16; S.nt1 = 8; S.lda = 2048; S.ldb = 512; S.lda2 = 2048; S.ldb2 = LDT; S.G = G; S.c = vcu; S.Q = (const char*)WSP(bfu, WS_QNAT); S.C = (const char*)WSP(bfu, WS_C); S.S = (const char*)WSP(bfu, WS_S); S.VT = (const char*)WSP(bfu, WS_VT);
      EpiOut E{WSP(bfu, WS_HH), WSP(float, SM_GG), WSP(float, SM_MM), WSP(float, WS_DEN), WSP(float, SM_QN)}; pg8::gemm_phase<EpiOut, SchedOut, true>(ring, S, E); }
    GRID_BAR();
    if ((c & 1) == 0) { if constexpr (ML_SUB & 128) { REFRESH(); p9_mlout(F, WSP(bfu, WS_HH)); }
#if CONV_AT == 10
      { REFRESH(); moe_convert(F); }
#endif
      __syncthreads(); }
    if constexpr (PROBE & 4) p9_mlout(F, WSP(bfu, WS_S));
#endif
    { REFRESH(); SchedDense S; S.init(WSP(bfu, WS_XN), WSP(bfu, WS_WINT), 128, (GATE_FP8 && !(GDIAG & 323)) ? 16 : 28, 1024, 1024, 1024, G, c); S.bskip_from = 12; S.bskip = 4096;
      EpiP10 E{WSP(bfu, WS_DAQ), WSP(bfu, WS_DAK), WSP(bfu, WS_DAV), WSP(bfu, WS_CAQ), WSP(bfu, WS_GATE), ARG.in[I_BGATE], WSP(float, WS_CASQP), ARG.in[I_DAKG], WSP(float, SM_INVF), WSP(float, SM_ROPES)}; pg8::gemm_phase<EpiP10, SchedDense, true>(ring, S, E);
#ifdef PROBE_DENSE
      pg8::gemm_phase<EpiP10, SchedDense, true>(ring, S, E);
#endif
    }
#if DO_ML
    if ((c & 1) != 0) { if constexpr (ML_SUB & 128) { REFRESH(); p9_mlout(F, WSP(bfu, WS_HH)); }
#if CONV_AT == 10
      { REFRESH(); moe_convert(F); }
#endif
    }
#endif
    GRID_BAR();
#if !(KNORM_FOLD && !KNORM_EPI_OFF && CAQ_FOLD && QNORM_IN_ATTN) || NORM_PHASE_KEEP
    { REFRESH(); p11_norms(F, 0); }
    GRID_BAR();
#endif
#if CONV_AT == 12
    if ((c & 1) == 0) { REFRESH(); moe_convert(F); if constexpr (GATE_FP8 && !(GDIAG & 64)) { REFRESH(); gate8_convert(F); } __syncthreads(); }
#endif
#if DO_DA
    { REFRESH(); const attn_body::AttnTensors AT{(const attn_body::bf16*)WSP(bfu, WS_DAQ), (const attn_body::bf16*)WSP(bfu, WS_DAK), (const attn_body::bf16*)WSP(bfu, WS_DAV), (attn_body::bf16*)WSP(bfu, WS_O), QNORM_IN_ATTN ? ARG.in[I_DAQG] : nullptr, WSP(float, SM_ROPEC), WSP(float, SM_ROPES)};
#if ATTN_V2 == 2
      const attn_body::StaticOrder2 S(G, c); attn_body::attn3_phase<attn_body::StaticOrder2>((char*)lds, AT, S);
#elif ATTN_V2 == 5
      const attn_body::StaticOrder2 S(G, c); attn_body::attn5_phase<attn_body::StaticOrder2>((char*)lds, AT, S);
#elif ATTN_V2 == 4
      const attn_body::StaticOrder2 S(G, c); attn_body::attn4_phase<attn_body::StaticOrder2>((char*)lds, AT, S);
#elif ATTN_V2
      const attn_body::StaticOrder2 S(G, c); attn_body::attn2_phase<attn_body::StaticOrder2>((char*)lds, AT, S);
#else
      const attn_body::StaticOrder S(G, c); attn_body::attn_phase<attn_body::StaticOrder>((char*)lds, AT, S);
#endif
#ifdef PROBE_ATTN
      attn_body::attn_phase<attn_body::StaticOrder>((char*)lds, AT, S);
#endif
    }
#endif
#if CONV_AT == 12
    if ((c & 1) != 0) { __syncthreads(); REFRESH(); moe_convert(F); if constexpr (GATE_FP8 && !(GDIAG & 64)) { REFRESH(); gate8_convert(F); } __syncthreads(); }
#endif
#if DO_CA
    { REFRESH(); SchedCA<0> S; S.nt = 4; S.nt1 = 4; S.lda = 1024; S.ldb = 1024; S.lda2 = 0; S.ldb2 = 0; S.G = G; S.c = c; S.A = (const char*)WSP(bfu, WS_CAQ); S.B = (const char*)WSP(bfu, SM_KCA);
      EpiCAS E{WSP(bfu, WS_CAQ), WSP(float, WS_CAROWP), WSP(float, WS_CASQP)}; pg8::gemm_phase<EpiCAS, SchedCA<0>, true>(ring, S, E); }
#endif
    GRID_BAR();
#if DO_DA
    { REFRESH(); p13_dacombine(F); }
    if constexpr (PROBE & 16) { REFRESH(); p13_dacombine(F); }
#endif
#if DO_CA
    { REFRESH(); SchedCA<1> S; S.nt = 4; S.nt1 = 4; S.lda = 1024; S.ldb = 1024; S.lda2 = 0; S.ldb2 = 0; S.G = G; S.c = c; S.A = (const char*)WSP(bfu, WS_CAQ); S.B = (const char*)WSP(bfu, SM_VCAT);
      EpiCAPV E{WSP(bfu, WS_CAQ), WSP(float, WS_CAROWP)}; pg8::gemm_phase<EpiCAPV, SchedCA<1>, true>(ring, S, E); }
#endif
#if GATE_FP8
#if GDIAG & 4
    GRID_BAR(); { REFRESH(); gate8_convert(F); __syncthreads(); } GRID_BAR();
#endif
#if (GDIAG & 16) && !(GDIAG & 128)
    { REFRESH(); SchedDense S; S.init(WSP(bfu, WS_XN), WSP(bfu, WS_WINT) + (size_t)8192 * 1024, (GDIAG & 64) ? 32 : 128, 12, 1024, 1024, 1024, G, c);
      EpiGate8 E{(GDIAG & 64) ? (bfu*)(F.ws + (size_t)952 * MiB) : WSP(bfu, WS_GATE), ARG.in[I_BGATE], 1.f, (const LAS float*)(F.lds + BIAS_OFF)}; pg8::gemm_phase<EpiGate8, SchedDense, true>(ring, S, E); }
#elif !(GDIAG & 384)
    { REFRESH(); for (int i_ = F.tid; i_ < 3072 / 4; i_ += NTHR) ((LAS f32x4*)(F.lds + BIAS_OFF))[i_] = ((const GAS f32x4*)ARG.in[I_BGATE])[i_]; __syncthreads(); }
    { REFRESH(); SchedDense8 S; S.init(WSP(unsigned char, WS_XN8), WSP(unsigned char, WS_WG8), 128, 12, 1024, 1024, 1024, G, c);
      EpiGate8 E{WSP(bfu, WS_GATE), ARG.in[I_BGATE], 1.f / 1024.f, (const LAS float*)(F.lds + BIAS_OFF)}; pg8::gemm_phase<EpiGate8, SchedDense8, true>(ring, S, E); }
#endif
#if GDIAG & 8
    GRID_BAR();
#endif
#endif
    GRID_BAR();
#if CHK == 1
    { REFRESH(); chk_region(F, F.ws + WS_GATE, (size_t)192 * MiB); }
#elif CHK == 3
    { REFRESH(); chk_region(F, F.ws + WS_DAQ, (size_t)64 * MiB); }
#elif CHK == 4
    { REFRESH(); chk_region(F, F.ws + WS_CAQ, (size_t)64 * MiB); }
#elif CHK == 5
    { REFRESH(); chk_region(F, F.ws + WS_HH, (size_t)128 * MiB); }
#elif CHK == 6
    { REFRESH(); chk_region(F, F.ws + WS_XN, (size_t)64 * MiB); }
#elif CHK == 8
    { REFRESH(); chk_region(F, F.ws + (size_t)952 * MiB, (size_t)48 * MiB); }
#elif CHK == 7
    { REFRESH(); chk_region(F, F.ws + WS_WINT, (size_t)22 * MiB); }
#endif
#if MIX_FUSED && DO_DA && DO_ML && DO_CA
#if MIX_SKEW
    if (c & 1) { for (int i_ = 0; i_ < MIX_SKEW; ++i_) __builtin_amdgcn_s_sleep(127); }
#endif
    { REFRESH(); SchedMix S; S.nt = 64; S.nt1 = 16; S.nt2 = 48; S.lda = 1024; S.ldb = 1024; S.lda2 = 2048; S.ldb2 = 2048; S.go.init(128, 4, G, c);
      S.A1 = (const char*)WSP(bfu, WS_DAQ); S.B1 = (const char*)WSP(bfu, WS_WBDAT); S.A2 = (const char*)WSP(bfu, WS_HH); S.B2 = (const char*)WSP(bfu, WS_WBMLT); S.A3 = (const char*)WSP(bfu, WS_CAQ); S.B3 = (const char*)WSP(bfu, WS_WBCAT);
      EpiMixFused E{WSP(bfu, WS_MIXBF), WSP(bfu, WS_GATE)}; pg8::gemm_phase<EpiMixFused, SchedMix, true>(ring, S, E);
      if constexpr (PROBE & 128) pg8::gemm_phase<EpiMixFused, SchedMix, true>(ring, S, E);
      if constexpr (PROBE & 512) { EpiMixProbe E2{WSP(bfu, WS_O)}; pg8::gemm_phase<EpiMixProbe, SchedMix, true>(ring, S, E2); } }
#else
    { constexpr bool F0 = true, F1 = !DO_DA, F2 = !DO_DA && !DO_ML, L0 = !DO_ML && !DO_CA, L1 = !DO_CA, L2 = true;
#if DO_DA
      { REFRESH(); SchedDense S; S.init(WSP(bfu, WS_DAQ), WSP(bfu, WS_WBDAT), 128, 4, 1024, 1024, 1024, G, c); EpiMix<F0, L0> E{ARG.out, WSP(bfu, WS_MIXBF), WSP(bfu, WS_GATE), 0}; pg8::gemm_phase<EpiMix<F0, L0>, SchedDense, true>(ring, S, E); }
#endif
#if DO_ML
      { REFRESH(); SchedDense S; S.init(WSP(bfu, WS_HH), WSP(bfu, WS_WBMLT), 128, 4, 2048, 2048, 2048, G, c); EpiMix<F1, L1> E{ARG.out, WSP(bfu, WS_MIXBF), WSP(bfu, WS_GATE), 1024}; pg8::gemm_phase<EpiMix<F1, L1>, SchedDense, true>(ring, S, E); }
#endif
#if DO_CA
      { REFRESH(); SchedDense S; S.init(WSP(bfu, WS_CAQ), WSP(bfu, WS_WBCAT), 128, 4, 1024, 1024, 1024, G, c); EpiMix<F2, L2> E{ARG.out, WSP(bfu, WS_MIXBF), WSP(bfu, WS_GATE), 2048}; pg8::gemm_phase<EpiMix<F2, L2>, SchedDense, true>(ring, S, E); }
#endif
      (void)F0; (void)F1; (void)F2; (void)L0; (void)L1; (void)L2; }
#endif
    GRID_BAR();
#if CHK == 2
    { REFRESH(); chk_region(F, F.ws + WS_MIXBF, (size_t)64 * MiB); }
#elif CHK == 1 || CHK == 3 || CHK == 4 || CHK == 5 || CHK == 6 || CHK == 7 || CHK == 8
    { REFRESH(); chk_decide(F); }
#endif
    { REFRESH(); SchedDense S; S.init(WSP(bfu, WS_MIXBF), WSP(bfu, WS_WOUTT), 128, 4, 1024, 1024, 1024, G, c); EpiWout E{ARG.in[I_X], ARG.out}; pg8::gemm_phase<EpiWout, SchedDense, true>(ring, S, E);
      if constexpr (PROBE & 256) pg8::gemm_phase<EpiWout, SchedDense, true>(ring, S, E); }
    GRID_BAR();
#if GDIAG & 128
    { REFRESH(); SchedDense S; S.init(WSP(bfu, WS_XN), WSP(bfu, WS_WINT) + (size_t)8192 * 1024, 32, 12, 1024, 1024, 1024, G, c);
#if GDIAG & 512
      EpiPlain E{(bfu*)(F.ws + (size_t)952 * MiB), 3072}; pg8::gemm_phase<EpiPlain, SchedDense, true>(ring, S, E); }
#else
      EpiGate8 E{(bfu*)(F.ws + (size_t)952 * MiB), ARG.in[I_BGATE], 1.f, (const LAS float*)(F.lds + BIAS_OFF)}; pg8::gemm_phase<EpiGate8, SchedDense, true>(ring, S, E); }
#endif
    GRID_BAR();
    { REFRESH(); chk_region(F, F.ws + (size_t)952 * MiB, (size_t)48 * MiB); }
    GRID_BAR();
    { REFRESH(); chk_decide(F); }
#endif
#if DO_MOE
#if CHK == 2
    { REFRESH(); chk_decide(F); }
#endif
    { REFRESH(); p16_router(F); }
    if constexpr (PROBE & 32) { REFRESH(); p16_router(F); }
    GRID_BAR();
    { REFRESH(); p17_slots(F); }
    if constexpr (PROBE & 32) { GRID_BAR(); { REFRESH(); p17_slots(F); } }
    GRID_BAR();
    { REFRESH(); const int* META = WSP(int, SM_META); const int NT = __builtin_amdgcn_readfirstlane(META[33]);
      { REFRESH(); SchedMoe<0> S; S.nt = 8; S.nt1 = 8; S.lda = 1024; S.ldb = 1024; S.lda2 = 0; S.ldb2 = 0; S.G = G; S.c = c; S.nunits = NT * 8; S.A = (const char*)WSP(bfu, WS_XN); S.B = (const char*)WSP(bfu, WS_WGUT); S.tile_e = META + 64; S.tok = WSP(int, SM_TOK);
        EpiGU E{WSP(unsigned char, WS_A2), ARG.in[I_BGU]}; pg8::gemm_phase<EpiGU, SchedMoe<0>, true>(ring, S, E);
#ifdef PROBE_MOE
        pg8::gemm_phase<EpiGU, SchedMoe<0>, true>(ring, S, E);
#endif
      }
      GRID_BAR();
      { REFRESH(); SchedMoe<1> S; S.nt = 8; S.nt1 = 8; S.lda = 1024; S.ldb = 1024; S.lda2 = 0; S.ldb2 = 0; S.G = G; S.c = c; S.nunits = NT * 4; S.A = (const char*)WSP(bfu, WS_A2); S.B = (const char*)WSP(bfu, WS_WDT); S.tile_e = META + 64; S.tok = WSP(int, SM_TOK);
        EpiDown E{WSP(unsigned char, WS_Y), ARG.in[I_BD], WSP(float, SM_WSRT)}; pg8::gemm_phase<EpiDown, SchedMoe<1>, true>(ring, S, E);
#ifdef PROBE_MOE
        pg8::gemm_phase<EpiDown, SchedMoe<1>, true>(ring, S, E);
#endif
      }
      GRID_BAR(); }
    if constexpr (PROBE & 64) p20_combine(F, (float*)(F.ws + WS_A2));
    { REFRESH(); p20_combine(F, ARG.out); }
#endif
#else
    { const int gt = F.bid * NTHR + F.tid, NGT = F.G * NTHR; for (int i = gt; i < T * DM / 4; i += NGT) ((GAS f32x4*)ARG.out)[i] = ((const GAS f32x4*)ARG.in[I_X])[i]; }
#endif
#undef ARG
}

extern "C" void kernel_launch(void* const* d_in, const int* in_sizes, int n_in, void* d_out, int out_size, void* d_ws, size_t ws_size, hipStream_t stream) {
    static int grid = 0;
    if (grid == 0) {
        if (n_in != 36 || in_sizes[0] != T * DM || out_size != T * DM || ws_size < WS_END) { fprintf(stderr, "kernel_launch: unexpected shapes (n_in %d, in0 %d, out %d, ws %zu); nothing launched\n", n_in, n_in > 0 ? in_sizes[0] : -1, out_size, ws_size); grid = -1; return; }
        int dev = 0, cus = 0, per_cu = 0;
        if (hipGetDevice(&dev) != hipSuccess || hipDeviceGetAttribute(&cus, hipDeviceAttributeMultiprocessorCount, dev) != hipSuccess) { grid = -1; return; }
        if (hipFuncSetAttribute((const void*)mk_fwd, hipFuncAttributeMaxDynamicSharedMemorySize, LDS_BYTES) != hipSuccess) { fprintf(stderr, "kernel_launch: hipFuncSetAttribute failed\n"); grid = -1; return; }
        if (hipOccupancyMaxActiveBlocksPerMultiprocessor(&per_cu, (const void*)mk_fwd, NTHR, LDS_BYTES) != hipSuccess || per_cu < 1) fprintf(stderr, "kernel_launch: occupancy query reports %d\n", per_cu);
        (void)hipGetLastError();
        grid = cus;
    }
    if (grid < 0) return;
    if (hipMemsetAsync((char*)d_ws + WS_CTL, 0, CTL_ZERO_BYTES, stream) != hipSuccess) return;
#if SELF_POISON
    if (hipMemsetAsync((char*)d_ws + CTL_ZERO_BYTES, 0xAA, (size_t)WS_END - CTL_ZERO_BYTES, stream) != hipSuccess) return;
#endif
    Args a{};
    for (int i = 0; i < 36; ++i) a.in[i] = (const float*)d_in[i];
    a.out = (float*)d_out; a.ws = (unsigned char*)d_ws;
    hipLaunchKernelGGL(mk_fwd, dim3(grid), dim3(NTHR), LDS_BYTES, stream, a);
}
```

```cpp
#include <hip/hip_runtime.h>
#include <hip/hip_bf16.h>
#include <cstdio>
#include <cstdint>
#include <cmath>

#ifndef LOOP_ALIGN
#define LOOP_ALIGN 1
#endif
#ifndef LOOP_ALIGN_S
#define LOOP_ALIGN_S "6"
#endif
#ifndef QNORM_IN_ATTN
#define QNORM_IN_ATTN 1
#endif
#ifndef CAQ_FOLD
#define CAQ_FOLD 1
#endif
#ifndef KNORM_FOLD
#define KNORM_FOLD 1
#endif
#ifndef KNORM_EPI_OFF
#define KNORM_EPI_OFF 0
#endif
#ifndef ALIGN_MID
#define ALIGN_MID 0
#endif
namespace pg8 {
#define PG8_LAS __attribute__((address_space(3)))
typedef unsigned short bf16_t;
typedef short bf16x8 __attribute__((ext_vector_type(8)));
typedef float f32x4 __attribute__((ext_vector_type(4)));
typedef unsigned u32x4 __attribute__((ext_vector_type(4)));
typedef unsigned u32x2 __attribute__((ext_vector_type(2)));
constexpr int BM = 256, BK = 64, HALF = 128, HTB = HALF * BK * 2, STAGE_BYTES = 8 * HTB;

__host__ __device__ __forceinline__ int lds_byte(int r, int c) { const int st = (r >> 4) * 2 + (c >> 5), rr = r & 15, cc = c & 31, ob = rr * 64 + cc * 2; return st * 1024 + (ob ^ (((ob >> 9) & 1) << 5)); }
__host__ __device__ __forceinline__ void stage_rc(int b, int& R, int& C) { const int st = b / 1024, sb = b % 1024, swz = sb ^ (((sb >> 9) & 1) << 5); R = (st >> 1) * 16 + swz / 64; C = (st & 1) * 32 + (swz % 64) / 2; }
__host__ __device__ __forceinline__ int perm32(int rho) { const int n = rho >> 4, i = rho & 15; return 8 * (i >> 2) + 4 * n + (i & 3); }

struct Unit { int pm, pn, z; };
typedef int v8i32 __attribute__((ext_vector_type(8))); typedef int v4i32 __attribute__((ext_vector_type(4)));
__device__ __forceinline__ v8i32 cat8(bf16x8 lo, bf16x8 hi) { const v4i32 a = __builtin_bit_cast(v4i32, lo), b = __builtin_bit_cast(v4i32, hi); return __builtin_shufflevector(a, b, 0, 1, 2, 3, 4, 5, 6, 7); }
struct UP { const char* a; const char* b; const char* a2; const char* b2; const char* a3; const char* b3; };

__device__ __forceinline__ unsigned cvt_pk_bf16(float lo, float hi) { unsigned r; asm volatile("v_cvt_pk_bf16_f32 %0, %1, %2" : "=v"(r) : "v"(lo), "v"(hi)); return r; }
__device__ __forceinline__ void st8(bf16_t* p, f32x4 v0, f32x4 v1) { u32x4 w; w.x = cvt_pk_bf16(v0[0], v0[1]); w.y = cvt_pk_bf16(v0[2], v0[3]); w.z = cvt_pk_bf16(v1[0], v1[1]); w.w = cvt_pk_bf16(v1[2], v1[3]); *(u32x4*)p = w; }

struct GridOrder {
    int nM, nN, nwg, G, c;
    __device__ __forceinline__ void init(int nM_, int nN_, int G_, int c_) { nM = nM_; nN = nN_; nwg = nM * nN; G = G_; c = c_; }
    __device__ __forceinline__ bool map(int i, int& pm, int& pn) const {
        const long L = (long)i * G + c; if (L >= nwg) return false;
        int wgid = (int)L; { const int q = nwg / 8, r = nwg % 8, xcd = wgid % 8, off = wgid / 8; wgid = (xcd < r ? xcd * (q + 1) : r * (q + 1) + (xcd - r) * q) + off; }
        const int nig = 8 * nN, gid = wgid / nig, fm = gid * 8, gsz = (nM - fm) < 8 ? (nM - fm) : 8;
        pm = fm + ((wgid % nig) % gsz); pn = (wgid % nig) / gsz; return true;
    }
};

template <class Epi, class Sched, bool ALIGN_EPI>
__device__ __forceinline__ void gemm_phase(PG8_LAS unsigned char* lds, const Sched& S, const Epi& E) {
    int tid_ = threadIdx.x; asm volatile("" : "+v"(tid_));
    const int tid = tid_, wid = __builtin_amdgcn_readfirstlane(tid >> 6), lane = tid & 63, wr = wid >> 2, wc = wid & 3, fr = lane & 15, fq = lane >> 4;
    constexpr int NSEG = Sched::NSEG; constexpr bool SEG2 = NSEG >= 2, SEG3 = NSEG >= 3, GATHER = Sched::GATHER; constexpr int ESZ = Sched::ESZ;
    int nt2_ = S.nt; if constexpr (SEG3) nt2_ = S.nt2;
    int nt = S.nt; const int nt1 = SEG2 ? S.nt1 : S.nt, nt2 = nt2_;
    int Rr[2], Cc[2], Rb[2];
#pragma unroll
    for (int i = 0; i < 2; ++i) { stage_rc(tid * 16 + i * 8192, Rr[i], Cc[i]); Rb[i] = Epi::PERM ? ((Rr[i] & ~31) + perm32(Rr[i] & 31)) : Rr[i]; }
    unsigned voffA[2], voffB[2], voffA2[2], voffB2[2];
#pragma unroll
    for (int i = 0; i < 2; ++i) { voffA[i] = (unsigned)(Rr[i] * S.lda * ESZ + Cc[i] * 2); voffB[i] = (unsigned)(Rb[i] * S.ldb * ESZ + Cc[i] * 2);
        voffA2[i] = SEG2 ? (unsigned)(Rr[i] * S.lda2 * ESZ + Cc[i] * 2) : 0u; voffB2[i] = SEG2 ? (unsigned)(Rb[i] * S.ldb2 * ESZ + Cc[i] * 2) : 0u; }
    const size_t hsA = GATHER ? 0 : (size_t)HALF * S.lda * ESZ, hsB = (size_t)HALF * S.ldb * ESZ, hsA2 = SEG2 ? (size_t)HALF * S.lda2 * ESZ : 0, hsB2 = SEG2 ? (size_t)HALF * S.ldb2 * ESZ : 0;
    const unsigned ldsw = (unsigned)wid * 1024u;
    const int aoff = lds_byte(wr * 64 + fr, fq * 8), boff = lds_byte(wc * 32 + fr, fq * 8);
#define PG8_SA(b, h) (((b) * 2 + (h)) * HTB)
#define PG8_SB(b, h) ((4 + (b) * 2 + (h)) * HTB)
#define PG8_GL(bufoff, p_, o0_, o1_) do { \
        __builtin_amdgcn_global_load_lds((const unsigned*)((p_) + (o0_)), (PG8_LAS unsigned*)(lds + (bufoff) + ldsw), 16, 0, 0); \
        __builtin_amdgcn_global_load_lds((const unsigned*)((p_) + (o1_)), (PG8_LAS unsigned*)(lds + (bufoff) + ldsw + 8192), 16, 0, 0); } while (0)
#define PG8_STAGE_A(bufoff, P, GO, tau, h) do { const bool s3_ = SEG3 && ((tau) >= nt2); const bool s2_ = SEG2 && ((tau) >= nt1) && !s3_; \
        const char* p_ = s3_ ? (P).a3 + (size_t)((tau) - nt2) * 128 + (size_t)(h) * hsA : s2_ ? (P).a2 + (size_t)((tau) - nt1) * 128 + (size_t)(h) * hsA2 : (P).a + (size_t)(tau) * 128 + (size_t)(h) * hsA; \
        const unsigned o0_ = GATHER ? GO[h][0] : (s2_ ? voffA2[0] : voffA[0]), o1_ = GATHER ? GO[h][1] : (s2_ ? voffA2[1] : voffA[1]); PG8_GL(bufoff, p_, o0_, o1_); } while (0)
#define PG8_STAGE_B(bufoff, P, tau, h) do { const bool s3_ = SEG3 && ((tau) >= nt2); const bool s2_ = SEG2 && ((tau) >= nt1) && !s3_; \
        const char* p_ = s3_ ? (P).b3 + (size_t)((tau) - nt2) * 128 + (size_t)(h) * hsB : s2_ ? (P).b2 + (size_t)((tau) - nt1) * 128 + (size_t)(h) * hsB2 : (P).b + (size_t)(tau) * 128 + (size_t)(h) * hsB; \
        const unsigned o0_ = s2_ ? voffB2[0] : voffB[0], o1_ = s2_ ? voffB2[1] : voffB[1]; PG8_GL(bufoff, p_, o0_, o1_); } while (0)
#define PG8_LDA(dst, b, h) do { _Pragma("unroll") for (int m = 0; m < 4; ++m) { if constexpr (ESZ == 2) { _Pragma("unroll") for (int k = 0; k < 2; ++k) dst[m][k] = *(const PG8_LAS bf16x8*)(lds + PG8_SA(b, h) + aoff + m * 2048 + k * 1024); } \
        else dst##8[m] = cat8(*(const PG8_LAS bf16x8*)(lds + PG8_SA(b, h) + aoff + m * 2048), *(const PG8_LAS bf16x8*)(lds + PG8_SA(b, h) + aoff + m * 2048 + 1024)); } } while (0)
#define PG8_LDB(dst, b, h) do { _Pragma("unroll") for (int n = 0; n < 2; ++n) { if constexpr (ESZ == 2) { _Pragma("unroll") for (int k = 0; k < 2; ++k) dst[n][k] = *(const PG8_LAS bf16x8*)(lds + PG8_SB(b, h) + boff + n * 2048 + k * 1024); } \
        else dst##8[n] = cat8(*(const PG8_LAS bf16x8*)(lds + PG8_SB(b, h) + boff + n * 2048), *(const PG8_LAS bf16x8*)(lds + PG8_SB(b, h) + boff + n * 2048 + 1024)); } } while (0)
#define PG8_MMA(ai, bj, At, Bt) do { __builtin_amdgcn_s_setprio(1); _Pragma("unroll") for (int m = 0; m < 4; ++m) _Pragma("unroll") for (int n = 0; n < 2; ++n) { \
        if constexpr (ESZ == 2) { _Pragma("unroll") for (int k = 0; k < 2; ++k) acc[ai][bj][m][n] = __builtin_amdgcn_mfma_f32_16x16x32_bf16(Bt[n][k], At[m][k], acc[ai][bj][m][n], 0, 0, 0); } \
        else { asm volatile("v_mfma_f32_16x16x128_f8f6f4 %0, %1, %2, %0" : "+v"(acc[ai][bj][m][n]) : "v"(Bt##8[n]), "v"(At##8[m])); } } \
        __builtin_amdgcn_s_setprio(0); } while (0)
#define PG8_WAIT_V(n) asm volatile("s_waitcnt vmcnt(" #n ")" ::: "memory")
#define PG8_WAIT_L(n) asm volatile("s_waitcnt lgkmcnt(" #n ")" ::: "memory")
#define PG8_BAR __builtin_amdgcn_s_barrier()
#define PG8_SCHED __builtin_amdgcn_sched_barrier(0)
    Unit cur, nxt; int ui = 0;
    if (!S.next(0, cur)) return;
    f32x4 acc[2][2][4][2];
#pragma unroll
    for (int a = 0; a < 2; ++a)
#pragma unroll
        for (int b = 0; b < 2; ++b)
#pragma unroll
            for (int m = 0; m < 4; ++m)
#pragma unroll
                for (int n = 0; n < 2; ++n) acc[a][b][m][n] = (f32x4){0.f, 0.f, 0.f, 0.f};
    bf16x8 At[4][2], B0[2][2], B1[2][2]; v8i32 At8[4], B08[2], B18[2];
    UP Pc, Pn; S.ptrs(cur, Pc);
    if constexpr (Sched::VARNT) nt = S.unit_nt(cur);
    unsigned gc[2][2] = {{0u, 0u}, {0u, 0u}}, gn[2][2] = {{0u, 0u}, {0u, 0u}};
    if constexpr (GATHER) {
#pragma unroll
        for (int h = 0; h < 2; ++h)
#pragma unroll
            for (int i = 0; i < 2; ++i) gc[h][i] = S.arow(cur, h * HALF + Rr[i]) * (unsigned)ESZ + (unsigned)Cc[i] * 2u;
    }
    PG8_STAGE_B(PG8_SB(0, 0), Pc, 0, 0); PG8_STAGE_B(PG8_SB(0, 1), Pc, 0, 1); PG8_STAGE_A(PG8_SA(0, 0), Pc, gc, 0, 0); PG8_STAGE_A(PG8_SA(0, 1), Pc, gc, 0, 1);
    if (wr == 1) PG8_BAR;
    PG8_WAIT_V(2); PG8_BAR;
    PG8_STAGE_B(PG8_SB(1, 0), Pc, 1, 0); PG8_STAGE_A(PG8_SA(1, 0), Pc, gc, 1, 0); PG8_STAGE_B(PG8_SB(1, 1), Pc, 1, 1);
    PG8_WAIT_V(6); PG8_BAR;
    for (;;) {
        const bool has_next = S.next(ui + 1, nxt);
        if (has_next) {
            S.ptrs(nxt, Pn);
            if constexpr (GATHER) {
#pragma unroll
                for (int h = 0; h < 2; ++h)
#pragma unroll
                    for (int i = 0; i < 2; ++i) gn[h][i] = S.arow(nxt, h * HALF + Rr[i]) * (unsigned)ESZ + (unsigned)Cc[i] * 2u;
            }
        } else { Pn = Pc;
#pragma unroll
            for (int h = 0; h < 2; ++h)
#pragma unroll
                for (int i = 0; i < 2; ++i) gn[h][i] = gc[h][i]; }
#if LOOP_ALIGN
        asm volatile(".p2align " LOOP_ALIGN_S);
#endif
        for (int t = 0; t < nt; t += 2) {
            const bool last = (t == nt - 2);
            if constexpr (SEG2) { if (t == nt1) { if constexpr (ALIGN_MID) { if (wr == 0) PG8_BAR; } E.mid(acc, cur, wr, wc, fr, fq, 0); if constexpr (ALIGN_MID) { if (wr == 1) PG8_BAR; } } }
            if constexpr (SEG3) { if (t == nt2) { if constexpr (ALIGN_MID) { if (wr == 0) PG8_BAR; } E.mid(acc, cur, wr, wc, fr, fq, 1); if constexpr (ALIGN_MID) { if (wr == 1) PG8_BAR; } } }
            UP Pp; Pp.a = last ? Pn.a : Pc.a; Pp.b = last ? Pn.b : Pc.b; Pp.a2 = last ? Pn.a2 : Pc.a2; Pp.b2 = last ? Pn.b2 : Pc.b2; Pp.a3 = last ? Pn.a3 : Pc.a3; Pp.b3 = last ? Pn.b3 : Pc.b3;
            unsigned gp[2][2];
#pragma unroll
            for (int h = 0; h < 2; ++h)
#pragma unroll
                for (int i = 0; i < 2; ++i) gp[h][i] = last ? gn[h][i] : gc[h][i];
            const int t1 = t + 1, t2 = last ? 0 : t + 2, t3 = t2 + 1;
            PG8_LDB(B0, 0, 0); PG8_LDB(B1, 0, 1); PG8_SCHED; PG8_LDA(At, 0, 0); PG8_STAGE_A(PG8_SA(1, 1), Pc, gc, t1, 1);
            PG8_WAIT_V(8); PG8_WAIT_L(0); PG8_BAR; PG8_MMA(0, 0, At, B0); PG8_MMA(0, 1, At, B1); PG8_BAR; PG8_SCHED;
            PG8_LDA(At, 0, 1); PG8_STAGE_B(PG8_SB(0, 0), Pp, t2, 0); PG8_STAGE_B(PG8_SB(0, 1), Pp, t2, 1); PG8_STAGE_A(PG8_SA(0, 0), Pp, gp, t2, 0);
            PG8_WAIT_V(8); PG8_WAIT_L(0); PG8_BAR; PG8_MMA(1, 0, At, B0); PG8_MMA(1, 1, At, B1); PG8_BAR; PG8_SCHED;
            PG8_LDB(B0, 1, 0); PG8_LDB(B1, 1, 1); PG8_SCHED; PG8_LDA(At, 1, 0); PG8_STAGE_A(PG8_SA(0, 1), Pp, gp, t2, 1);
            PG8_WAIT_V(8); PG8_WAIT_L(0); PG8_BAR; PG8_MMA(0, 0, At, B0); PG8_MMA(0, 1, At, B1); PG8_BAR; PG8_SCHED;
            PG8_LDA(At, 1, 1); PG8_STAGE_B(PG8_SB(1, 0), Pp, t3, 0); PG8_STAGE_B(PG8_SB(1, 1), Pp, t3, 1); PG8_STAGE_A(PG8_SA(1, 0), Pp, gp, t3, 0);
            PG8_WAIT_V(8); PG8_WAIT_L(0); PG8_BAR; PG8_MMA(1, 0, At, B0); PG8_MMA(1, 1, At, B1); PG8_BAR; PG8_SCHED;
        }
        if constexpr (ALIGN_EPI) { if (wr == 0) PG8_BAR; }
        if constexpr (ESZ == 1) { asm volatile("s_nop 15\n\ts_nop 15" ::: "memory"); PG8_SCHED; }
        E(acc, cur, wr, wc, fr, fq);
        if (!has_next) break;
#pragma unroll
        for (int a = 0; a < 2; ++a)
#pragma unroll
            for (int b = 0; b < 2; ++b)
#pragma unroll
                for (int m = 0; m < 4; ++m)
#pragma unroll
                    for (int n = 0; n < 2; ++n) acc[a][b][m][n] = (f32x4){0.f, 0.f, 0.f, 0.f};
        cur = nxt; Pc = Pn; ++ui;
        if constexpr (Sched::VARNT) nt = S.unit_nt(cur);
#pragma unroll
        for (int h = 0; h < 2; ++h)
#pragma unroll
            for (int i = 0; i < 2; ++i) gc[h][i] = gn[h][i];
        if constexpr (ALIGN_EPI) { if (wr == 1) PG8_BAR; }
    }
    PG8_WAIT_V(0);
    if constexpr (!ALIGN_EPI) { if (wr == 0) PG8_BAR; }
    PG8_BAR;
#undef PG8_SA
#undef PG8_SB
#undef PG8_GL
#undef PG8_STAGE_A
#undef PG8_STAGE_B
#undef PG8_LDA
#undef PG8_LDB
#undef PG8_MMA
#undef PG8_WAIT_V
#undef PG8_WAIT_L
#undef PG8_BAR
#undef PG8_SCHED
}
}
namespace attn_body {
using bf16=__hip_bfloat16;
using bf16x8=__attribute__((ext_vector_type(8)))short;
using s16x4=__attribute__((ext_vector_type(4)))short;
using f32x16=__attribute__((ext_vector_type(16)))float;
using u32x4=__attribute__((ext_vector_type(4)))unsigned;
constexpr int BATCH=4,NHEAD=16,SEQ=8192,D=64,DM=NHEAD*D,OP=2048;
constexpr int NW=8,QBLK=32,QB=QBLK*NW,KVBLK=64,NQB=SEQ/QB;
constexpr int ATTN_PITCH=DM, ATTN_UNIT_ROWS=QB;
__device__ __forceinline__ int crow(int r,int hi){return (r&3)+8*(r>>2)+4*hi;}
#define SBAR() __builtin_amdgcn_sched_barrier(0)
__device__ __forceinline__ void cmask(f32x16&p0,f32x16&p1,int jb,int qrel,int hi){
  const float NEG=-INFINITY; int kb=64*jb+4*hi;
  #pragma unroll
  for(int r=0;r<16;++r){int kv=kb+(r&3)+8*(r>>2); if((kv>>6)>(qrel>>6))p0[r]=NEG; if(((kv+32)>>6)>(qrel>>6))p1[r]=NEG;}
}

constexpr int NSLOT=3, SLOTB=8192;
constexpr int LDS_K=0, LDS_V=NSLOT*SLOTB, LDS_WS=2*NSLOT*SLOTB, LDS_OST=LDS_WS+NW*64*4, LDS_BYTES=LDS_OST+NW*4096;
constexpr float C2=0.125f*1.4426950408889634f;
__device__ __forceinline__ void glds16(const void*gsrc,unsigned lds_dst){unsigned keep;
  asm volatile("s_mov_b32 %0, m0\n\ts_mov_b32 m0, %2\n\ts_nop 0\n\tglobal_load_lds_dwordx4 %1, off\n\ts_mov_b32 m0, %0":"=&s"(keep):"v"(gsrc),"s"(lds_dst):"memory");}
__device__ __forceinline__ float max3f(float a,float b,float c){float r;asm("v_max3_f32 %0, %1, %2, %3":"=v"(r):"v"(a),"v"(b),"v"(c));return r;}
__device__ __forceinline__ float max2f(float a,float b){float r;asm("v_max_f32_e32 %0, %1, %2":"=v"(r):"v"(a),"v"(b));return r;}
__device__ __forceinline__ float fadd_s(float a,float b){float r;asm("v_add_f32_e32 %0, %1, %2":"=v"(r):"v"(a),"v"(b));return r;}
__device__ __forceinline__ float fsub_s(float a,float b){float r;asm("v_sub_f32_e32 %0, %1, %2":"=v"(r):"v"(a),"v"(b));return r;}
typedef float f32x2_t __attribute__((ext_vector_type(2))); typedef __bf16 bf16x2_t __attribute__((ext_vector_type(2)));
__device__ __forceinline__ unsigned cvtpk_s(float lo,float hi){f32x2_t v={lo,hi};bf16x2_t b=__builtin_convertvector(v,bf16x2_t);return __builtin_bit_cast(unsigned,b);}
#define WAIT_BAR(N) asm volatile("s_waitcnt vmcnt(" #N ") lgkmcnt(0)\n\ts_barrier":::"memory")

__device__ __forceinline__ void qkt(f32x16&p0,f32x16&p1,const char*Kslot,const bf16x8*qr,const f32x16&negm,int r32,int hi){
  const char*kb=Kslot+hi*1024+r32*16;
  #pragma unroll
  for(int d0=0;d0<4;++d0){
    const bf16x8 b0=*reinterpret_cast<const bf16x8*>(kb+d0*2048);
    const bf16x8 b1=*reinterpret_cast<const bf16x8*>(kb+d0*2048+512);
    if(d0==0){p0=__builtin_amdgcn_mfma_f32_32x32x16_bf16(b0,qr[0],negm,0,0,0);p1=__builtin_amdgcn_mfma_f32_32x32x16_bf16(b1,qr[0],negm,0,0,0);}
    else{p0=__builtin_amdgcn_mfma_f32_32x32x16_bf16(b0,qr[d0],p0,0,0,0);p1=__builtin_amdgcn_mfma_f32_32x32x16_bf16(b1,qr[d0],p1,0,0,0);}}
}
__device__ __forceinline__ void qkt0(f32x16&p0,f32x16&p1,const char*Kslot,const bf16x8*qr,int r32,int hi){
  const char*kb=Kslot+hi*1024+r32*16; const f32x16 z=f32x16{};
  #pragma unroll
  for(int d0=0;d0<4;++d0){
    const bf16x8 b0=*reinterpret_cast<const bf16x8*>(kb+d0*2048);
    const bf16x8 b1=*reinterpret_cast<const bf16x8*>(kb+d0*2048+512);
    if(d0==0){p0=__builtin_amdgcn_mfma_f32_32x32x16_bf16(b0,qr[0],z,0,0,0);p1=__builtin_amdgcn_mfma_f32_32x32x16_bf16(b1,qr[0],z,0,0,0);}
    else{p0=__builtin_amdgcn_mfma_f32_32x32x16_bf16(b0,qr[d0],p0,0,0,0);p1=__builtin_amdgcn_mfma_f32_32x32x16_bf16(b1,qr[d0],p1,0,0,0);}}
}
typedef __attribute__((address_space(3))) const char* lds_cptr;
typedef short v4i16_t __attribute__((ext_vector_type(4)));
__device__ __forceinline__ void kload8(bf16x8*kf,lds_cptr kp){
  kf[0]=*(const __attribute__((address_space(3))) bf16x8*)(kp);      kf[1]=*(const __attribute__((address_space(3))) bf16x8*)(kp+512);
  kf[2]=*(const __attribute__((address_space(3))) bf16x8*)(kp+2048); kf[3]=*(const __attribute__((address_space(3))) bf16x8*)(kp+2560);
  kf[4]=*(const __attribute__((address_space(3))) bf16x8*)(kp+4096); kf[5]=*(const __attribute__((address_space(3))) bf16x8*)(kp+4608);
  kf[6]=*(const __attribute__((address_space(3))) bf16x8*)(kp+6144); kf[7]=*(const __attribute__((address_space(3))) bf16x8*)(kp+6656);
}
__device__ __forceinline__ void kload2(bf16x8*kf,lds_cptr kp,int j){ kf[2*j]=*(const __attribute__((address_space(3))) bf16x8*)(kp+j*2048); kf[2*j+1]=*(const __attribute__((address_space(3))) bf16x8*)(kp+j*2048+512); }
__device__ __forceinline__ s16x4 vtr(lds_cptr p){ return __builtin_bit_cast(s16x4,__builtin_amdgcn_ds_read_tr16_b64_v4i16((__attribute__((address_space(3))) v4i16_t*)p)); }
__device__ __forceinline__ float rowmax(const f32x16&p0,const f32x16&p1){
  float a=max3f(p0[0],p0[1],p1[0]),b=max3f(p0[2],p0[3],p1[1]);a=max3f(a,p1[2],p1[3]);
  #pragma unroll
  for(int r=4;r<16;r+=4){a=max3f(a,p0[r],p0[r+1]);b=max3f(b,p0[r+2],p0[r+3]);a=max3f(a,p1[r],p1[r+1]);b=max3f(b,p1[r+2],p1[r+3]);}
  const float m=max2f(a,b);
  auto rr=__builtin_amdgcn_permlane32_swap(__float_as_uint(m),__float_as_uint(m),false,false);
  return max2f(__uint_as_float(rr[0]),__uint_as_float(rr[1]));
}
__device__ __forceinline__ void pv(f32x16*o,int vb,bf16x8 pa0,bf16x8 pa1,bf16x8 pa2,bf16x8 pa3){
  #pragma unroll
  for(int d0=0;d0<2;++d0){s16x4 lo[4],hi[4];
    #pragma unroll
    for(int ks=0;ks<4;++ks){
      asm volatile("ds_read_b64_tr_b16 %0,%1 offset:%c2":"=&v"(lo[ks]):"v"(vb),"i"(d0*4096+ks*1024):"memory");
      asm volatile("ds_read_b64_tr_b16 %0,%1 offset:%c2":"=&v"(hi[ks]):"v"(vb),"i"(d0*4096+ks*1024+512):"memory");}
    asm volatile("s_waitcnt lgkmcnt(0)":::"memory");SBAR();
    #define PK(k) (bf16x8){lo[k][0],lo[k][1],lo[k][2],lo[k][3],hi[k][0],hi[k][1],hi[k][2],hi[k][3]}
    o[d0]=__builtin_amdgcn_mfma_f32_32x32x16_bf16(pa0,PK(0),o[d0],0,0,0);
    o[d0]=__builtin_amdgcn_mfma_f32_32x32x16_bf16(pa1,PK(1),o[d0],0,0,0);
    o[d0]=__builtin_amdgcn_mfma_f32_32x32x16_bf16(pa2,PK(2),o[d0],0,0,0);
    o[d0]=__builtin_amdgcn_mfma_f32_32x32x16_bf16(pa3,PK(3),o[d0],0,0,0);
    #undef PK
  }
}

#ifndef ATTN_STORE16
#define ATTN_STORE16(p,v) (*(u32x4*)(p)=(v))
#endif
template<int THRL> __device__ __forceinline__ void attn_unit(int b,int h,int hv,int ho,int qb,const bf16*Q,const bf16*__restrict__ K,const bf16*__restrict__ V,bf16*O,char*shm){
  const int tid=threadIdx.x,lane=tid&63,r32=lane&31,hi=lane>>5; const int wid=__builtin_amdgcn_readfirstlane(tid>>6);
  const long rowbase=(long)b*SEQ; const int q0=qb*QB;
  const bf16*Qw=Q+(rowbase+q0+wid*QBLK)*DM+h*D;
  const bf16*Kh=K+rowbase*DM+h*D,*Vh=V+rowbase*DM+hv*D;
  const unsigned lds0=(unsigned)(uintptr_t)shm;
  float*wsf=(float*)(shm+LDS_WS)+wid*64;
  const bf16*ksrc=Kh+(long)lane*DM+wid*8;
  const bf16*vsrc=Vh+(long)(16*(wid&3)+(lane>>2))*DM+(wid>>2)*32+(lane&3)*8;
  const unsigned kdst=lds0+LDS_K+wid*1024, vdst=lds0+LDS_V+wid*1024;
  #define DMA_K(t,slot) glds16(ksrc+(long)(t)*KVBLK*DM,(unsigned)__builtin_amdgcn_readfirstlane(kdst+(slot)))
  #define DMA_V(t,slot) glds16(vsrc+(long)(t)*KVBLK*DM,(unsigned)__builtin_amdgcn_readfirstlane(vdst+(slot)))
  const int vb0=(int)(lds0+LDS_V)+((lane>>4)&1)*32+(lane&3)*8+(4*hi+((lane&15)>>2))*64;
  const char*Kbase=shm+LDS_K; bf16x8 kf[8];
  const lds_cptr shm3=(lds_cptr)shm; const lds_cptr kp0=shm3+LDS_K+hi*1024+r32*16; const lds_cptr vp0=shm3+LDS_V+((lane>>4)&1)*32+(lane&3)*8+(4*hi+((lane&15)>>2))*64;
  const int NT=(q0+QB)/KVBLK;
  DMA_K(0,0);DMA_V(0,0);DMA_K(1,SLOTB);
  bf16x8 qr[4];
  #pragma unroll
  for(int d0=0;d0<4;++d0)qr[d0]=*reinterpret_cast<const bf16x8*>(&Qw[(long)r32*DM+d0*16+hi*8]);
  float mhat=0.f,l_reg=0.f;f32x16 o[2];o[0]=f32x16{};o[1]=f32x16{};f32x16 negm=f32x16{};asm volatile("":"+v"(negm));
  const int qrel=wid*QBLK+r32;
  #define CMASK(P0,P1,t) do{int jb_=(t)-(NT-4); if(jb_>=0)cmask(P0,P1,jb_,qrel,hi);}while(0)
  bool resc=false;
  #define START(P0,P1) do{ const float rm=rowmax(P0,P1); resc=false; \
    { const float dl=rm; mhat=fadd_s(mhat,dl); \
      _Pragma("unroll") for(int r=0;r<16;++r){P0[r]=fsub_s(P0[r],dl);P1[r]=fsub_s(P1[r],dl);} \
      _Pragma("unroll") for(int r=0;r<16;++r)negm[r]=-mhat; asm volatile("":"+v"(negm)); } \
    _Pragma("unroll") for(int r=0;r<16;++r)P0[r]=__builtin_amdgcn_exp2f(P0[r]); }while(0)
  #define RESC() do{ if(resc){ asm volatile("s_waitcnt lgkmcnt(0)":::"memory"); \
      _Pragma("unroll") for(int d_=0;d_<2;++d_) _Pragma("unroll") for(int r=0;r<16;++r)o[d_][r]*=wsf[crow(r,hi)]; } }while(0)
  f32x16 pA0,pA1,pB0,pB1;
  int sl_prev=0,sl_cur=0,sl_next=SLOTB;
  #define ROT() do{sl_prev=sl_cur;sl_cur=sl_next;sl_next=(sl_next==(NSLOT-1)*SLOTB)?0:sl_next+SLOTB;}while(0)
  DMA_K(2,2*SLOTB);
  WAIT_BAR(3);
  qkt(pA0,pA1,Kbase,qr,negm,r32,hi);asm volatile("s_nop 15\n\ts_nop 7":"+v"(pA0),"+v"(pA1));CMASK(pA0,pA1,0);
  START(pA0,pA1);
  _Pragma("unroll") for(int r=0;r<16;++r)pA1[r]=__builtin_amdgcn_exp2f(pA1[r]);
  WAIT_BAR(0);
  DMA_K(3,0);DMA_V(1,SLOTB);
  ROT();
  kload8(kf,kp0+sl_cur);
  WAIT_BAR(2);
  s16x4 vlo[8],vhi[8]; u32x4 pw0,pw1,pw2,pw3;
  #define PKW(P,B) cvtpk_s(P[B],P[B+1])
  #define PAF(k) __builtin_bit_cast(bf16x8,pw##k)
  #define VFR(i) (bf16x8){vlo[i][0],vlo[i][1],vlo[i][2],vlo[i][3],vhi[i][0],vhi[i][1],vhi[i][2],vhi[i][3]}
  #define PIN(x) asm volatile("":"+v"(x))
  #define MX3(a,b,c) __builtin_fmaxf(__builtin_fmaxf((a),(b)),(c))
  #define GAPA(MF,A0,A1,A2,A3,W0,W1,PW) do{ MF; sacc+=A0; sacc+=A1; sacc+=A2; sacc+=A3; PIN(sacc); W0; W1; PIN(PW); SBAR(); }while(0)
  #define EX(v) __builtin_amdgcn_exp2f(v)
  #define GAPB(MF,X,B) do{ MF; X[B]=EX(X[B]); X[B+1]=EX(X[B+1]); X[B+2]=EX(X[B+2]); X[B+3]=EX(X[B+3]); PIN(X); SBAR(); }while(0)
  #define VRD(i) do{ vlo[i]=vtr(vp_+(((i)>>2)*4096+((i)&3)*1024)); vhi[i]=vtr(vp_+(((i)>>2)*4096+((i)&3)*1024+512)); }while(0)
  #define KRD(G,j) do{ if(G){ kload2(kf,kp0+sl_next,j); SBAR(); } }while(0)
  #define STEP(C0,C1,P0,P1,t,GK,GV,GL) do{ SBAR(); \
    const lds_cptr vp_=vp0+sl_prev; \
    VRD(0); SBAR(); float sacc=(P0[0]+P0[1]); \
    GAPA(C0=__builtin_amdgcn_mfma_f32_32x32x16_bf16(kf[0],qr[0],negm,0,0,0), P0[2],P0[3],P0[4],P0[5],     pw0[0]=PKW(P0,0), pw0[1]=PKW(P0,2), pw0); \
    VRD(4); SBAR(); GAPA(C1=__builtin_amdgcn_mfma_f32_32x32x16_bf16(kf[1],qr[0],negm,0,0,0), P0[6],P0[7],P0[8],P0[9],     pw0[2]=PKW(P0,4), pw0[3]=PKW(P0,6), pw0); \
    VRD(1); SBAR(); GAPA(C0=__builtin_amdgcn_mfma_f32_32x32x16_bf16(kf[2],qr[1],C0,0,0,0),   P0[10],P0[11],P0[12],P0[13], pw1[0]=PKW(P0,8), pw1[1]=PKW(P0,10), pw1); \
    VRD(5); SBAR(); GAPA(C1=__builtin_amdgcn_mfma_f32_32x32x16_bf16(kf[3],qr[1],C1,0,0,0),   P0[14],P0[15],P1[0],P1[1],   pw1[2]=PKW(P0,12),pw1[3]=PKW(P0,14), pw1); \
    VRD(2); SBAR(); GAPA(C0=__builtin_amdgcn_mfma_f32_32x32x16_bf16(kf[4],qr[2],C0,0,0,0),   P1[2],P1[3],P1[4],P1[5],     pw2[0]=PKW(P1,0), pw2[1]=PKW(P1,2), pw2); \
    VRD(6); SBAR(); GAPA(C1=__builtin_amdgcn_mfma_f32_32x32x16_bf16(kf[5],qr[2],C1,0,0,0),   P1[6],P1[7],P1[8],P1[9],     pw2[2]=PKW(P1,4), pw2[3]=PKW(P1,6), pw2); \
    VRD(3); SBAR(); GAPA(C0=__builtin_amdgcn_mfma_f32_32x32x16_bf16(kf[6],qr[3],C0,0,0,0),   P1[10],P1[11],P1[12],P1[13], pw3[0]=PKW(P1,8), pw3[1]=PKW(P1,10), pw3); \
    VRD(7); SBAR(); GAPA(C1=__builtin_amdgcn_mfma_f32_32x32x16_bf16(kf[7],qr[3],C1,0,0,0),   P1[14],P1[15],0.f,0.f,       pw3[2]=PKW(P1,12),pw3[3]=PKW(P1,14), pw3); \
    l_reg+=sacc; \
    if(GK){DMA_K((t)+3,sl_cur);} if(GV){DMA_V((t)+1,sl_next);} \
    CMASK(C0,C1,t); \
    { float a=MX3(C0[0],C0[1],C1[0]),b=MX3(C0[2],C0[3],C1[1]); a=MX3(a,C1[2],C1[3]); \
      _Pragma("unroll") for(int r=4;r<16;r+=4){a=MX3(a,C0[r],C0[r+1]);b=MX3(b,C0[r+2],C0[r+3]);a=MX3(a,C1[r],C1[r+1]);b=MX3(b,C1[r+2],C1[r+3]);} \
      float rm=__builtin_fmaxf(a,b); { auto rr=__builtin_amdgcn_permlane32_swap(__float_as_uint(rm),__float_as_uint(rm),false,false); rm=__builtin_fmaxf(__uint_as_float(rr[0]),__uint_as_float(rr[1])); } \
      resc=false; \
      if(__builtin_expect(__any(rm>(float)THRL),0)){ const float dl=__builtin_fmaxf(rm,0.f); mhat+=dl; \
        _Pragma("unroll") for(int r=0;r<16;++r){C0[r]-=dl;C1[r]-=dl;} \
        _Pragma("unroll") for(int r=0;r<16;++r)negm[r]=-mhat; asm volatile("":"+v"(negm)); \
        const float f=__builtin_amdgcn_exp2f(-dl); l_reg*=f; if(hi==0)wsf[r32]=f; resc=true; } } \
    SBAR(); \
    GAPB(o[0]=__builtin_amdgcn_mfma_f32_32x32x16_bf16(PAF(0),VFR(0),o[0],0,0,0), C0,0); \
    GAPB(o[1]=__builtin_amdgcn_mfma_f32_32x32x16_bf16(PAF(0),VFR(4),o[1],0,0,0), C0,4); \
    KRD(GL,0); GAPB(o[0]=__builtin_amdgcn_mfma_f32_32x32x16_bf16(PAF(1),VFR(1),o[0],0,0,0), C0,8); \
    KRD(GL,1); GAPB(o[1]=__builtin_amdgcn_mfma_f32_32x32x16_bf16(PAF(1),VFR(5),o[1],0,0,0), C0,12); \
    KRD(GL,2); GAPB(o[0]=__builtin_amdgcn_mfma_f32_32x32x16_bf16(PAF(2),VFR(2),o[0],0,0,0), C1,0); \
    KRD(GL,3); GAPB(o[1]=__builtin_amdgcn_mfma_f32_32x32x16_bf16(PAF(2),VFR(6),o[1],0,0,0), C1,4); \
    GAPB(o[0]=__builtin_amdgcn_mfma_f32_32x32x16_bf16(PAF(3),VFR(3),o[0],0,0,0), C1,8); \
    GAPB(o[1]=__builtin_amdgcn_mfma_f32_32x32x16_bf16(PAF(3),VFR(7),o[1],0,0,0), C1,12); \
    }while(0)
  int t=1;
  #undef CMASK
  #define CMASK(P0,P1,t) do{}while(0)
  for(;t+5<NT;t+=2){
    STEP(pB0,pB1,pA0,pA1,t,true,true,true);     WAIT_BAR(2); RESC(); ROT();
    STEP(pA0,pA1,pB0,pB1,t+1,true,true,true);   WAIT_BAR(2); RESC(); ROT();
  }
  #undef CMASK
  #define CMASK(P0,P1,t) do{int jb_=(t)-(NT-4); if(jb_>=0)cmask(P0,P1,jb_,qrel,hi);}while(0)
  #define ENDW(tt) do{ if((tt)+3<NT){WAIT_BAR(2);} else if((tt)+2<NT){WAIT_BAR(1);} else {WAIT_BAR(0);} }while(0)
  for(;t+1<NT;t+=2){
    STEP(pB0,pB1,pA0,pA1,t,(t+3<NT),(t+1<NT),(t+1<NT));       ENDW(t);   RESC(); ROT();
    STEP(pA0,pA1,pB0,pB1,t+1,(t+4<NT),(t+2<NT),(t+2<NT));     ENDW(t+1); RESC(); ROT();
  }
  STEP(pB0,pB1,pA0,pA1,NT-1,false,false,false); RESC();
  { float sacc=pB0[0]+pB0[1]; _Pragma("unroll") for(int r=2;r<16;++r)sacc+=pB0[r]; _Pragma("unroll") for(int r=0;r<16;++r)sacc+=pB1[r]; l_reg+=sacc;
    pw0=(u32x4){PKW(pB0,0),PKW(pB0,2),PKW(pB0,4),PKW(pB0,6)};pw1=(u32x4){PKW(pB0,8),PKW(pB0,10),PKW(pB0,12),PKW(pB0,14)};pw2=(u32x4){PKW(pB1,0),PKW(pB1,2),PKW(pB1,4),PKW(pB1,6)};pw3=(u32x4){PKW(pB1,8),PKW(pB1,10),PKW(pB1,12),PKW(pB1,14)};
    SBAR(); pv(o,vb0+sl_cur,PAF(0),PAF(1),PAF(2),PAF(3)); }
  #undef PKW
  #undef PAF
  #undef VFR
  #undef PIN
  #undef MX3
  #undef GAPA
  #undef GAPB
  #undef EX
  #undef VRD
  #undef KRD
  #undef STEP
  #undef ENDW
  {auto rr=__builtin_amdgcn_permlane32_swap(__float_as_uint(l_reg),__float_as_uint(l_reg),false,false);l_reg=__uint_as_float(rr[0])+__uint_as_float(rr[1]);}
  if(hi==0)wsf[32+r32]=l_reg;asm volatile("s_waitcnt lgkmcnt(0)":::"memory");
  float rli[16];
  #pragma unroll
  for(int r=0;r<16;++r)rli[r]=__builtin_amdgcn_rcpf(wsf[32+crow(r,hi)]);
  bf16*Ow=O+(rowbase+q0+wid*QBLK)*OP+ho*D;
  { bf16*stg=(bf16*)(shm+LDS_OST)+wid*2048;
    #pragma unroll
    for(int r=0;r<16;++r){const int orow=crow(r,hi);
      #pragma unroll
      for(int d0=0;d0<2;++d0)stg[orow*64+d0*32+r32]=__float2bfloat16(o[d0][r]*rli[r]);}
    asm volatile("s_waitcnt lgkmcnt(0)":::"memory");
    #pragma unroll
    for(int i=0;i<4;++i){const int row=i*8+(lane>>3),ch=lane&7; const u32x4 v=*(const u32x4*)(stg+row*64+ch*8); ATTN_STORE16(Ow+(long)row*OP+ch*8,v);} }
  asm volatile("s_waitcnt lgkmcnt(0)\n\ts_barrier":::"memory");
  #undef DMA_K
  #undef DMA_V
  #undef CMASK
  #undef START
  #undef RESC
  #undef ROT
}
constexpr int ATTN_LDS_BYTES=LDS_BYTES;
struct AttnTensors { const bf16* Q; const bf16* K; const bf16* V; bf16* O; const float* qg=nullptr; const float* ropec=nullptr; const float* ropes=nullptr; };
struct AttnUnit { int b, hq, hv, ho, qb; };
struct StaticOrder {
  int vcu;
  __device__ __forceinline__ explicit StaticOrder(int grid,int block):vcu((block%8)*(grid/8)+block/8){}
  __device__ __forceinline__ bool next(int i,AttnUnit&u)const{ if(i>=16)return false; const int s=vcu&7, r=i>>2, ii=i&3; const int v=r*32+(vcu>>3);
    const int vhalf=v&1, c=(v>>1)&1, h=(v>>2)&7; u.b=v>>5; u.hq=h*2+c; u.hv=h*2+vhalf; u.ho=(h*2+c)*2+vhalf; u.qb=(ii==0)?s:(ii==1)?15-s:(ii==2)?16+s:31-s; return true; }
  __device__ __forceinline__ void a_ready(const AttnUnit&)const{}
  __device__ __forceinline__ void done(const AttnUnit&)const{}
};
template<class Sched,int THRL=8> __device__ __forceinline__ void attn_phase(char*lds,const AttnTensors&T,const Sched&S){
  AttnUnit u;
  for(int i=0;S.next(i,u);++i){ S.a_ready(u); attn_unit<THRL>(u.b,u.hq,u.hv,u.ho,u.qb,T.Q,T.K,T.V,T.O,lds); S.done(u); }
}

constexpr int L2_K=0, L2_V=3*8192, L2_WS=L2_V+3*16384, L2_OST=L2_WS+NW*64*4, L2_BYTES=L2_OST+NW*4096;
template<int THRL> __device__ __forceinline__ void attn2_unit(int b,int hq,int hv,int ho,int qb,const bf16*Q,const bf16*__restrict__ K,const bf16*__restrict__ V,bf16*O,char*shm){
  const int tid=threadIdx.x,lane=tid&63,r32=lane&31,hi=lane>>5; const int wid=__builtin_amdgcn_readfirstlane(tid>>6);
  const long rowbase=(long)b*SEQ; const int q0=qb*QB;
  const bf16*Qw=Q+(rowbase+q0+wid*QBLK)*DM+hq*D;
  const bf16*Kh=K+rowbase*DM+hq*D,*Vh=V+rowbase*DM+hv*D;
  const unsigned lds0=(unsigned)(uintptr_t)shm;
  float*wsf=(float*)(shm+L2_WS)+wid*64;
  const bf16*ksrc=Kh+(long)lane*DM+wid*8;
  const bf16*vsrc=Vh+(long)(16*(wid&3)+(lane>>2))*DM+(wid>>2)*32+(lane&3)*8;
  const unsigned kdst=lds0+L2_K+wid*1024, vdst=lds0+L2_V+wid*1024;
  #define DMA2_K(t,sl) glds16(ksrc+(long)(t)*KVBLK*DM,(unsigned)__builtin_amdgcn_readfirstlane(kdst+(sl)*8192))
  #define DMA2_V(t,sl) do{ glds16(vsrc+(long)(t)*KVBLK*DM,(unsigned)__builtin_amdgcn_readfirstlane(vdst+(sl)*16384)); glds16(vsrc+64+(long)(t)*KVBLK*DM,(unsigned)__builtin_amdgcn_readfirstlane(vdst+(sl)*16384+8192)); }while(0)
  const int vb0=(int)(lds0+L2_V)+((lane>>4)&1)*32+(lane&3)*8+(4*hi+((lane&15)>>2))*64;
  const int NT=(q0+QB)/KVBLK;
  bf16x8 qr[4];
  #pragma unroll
  for(int d0=0;d0<4;++d0)qr[d0]=*reinterpret_cast<const bf16x8*>(&Qw[(long)r32*DM+d0*16+hi*8]);
  asm volatile("":"+v"(qr[0]),"+v"(qr[1]),"+v"(qr[2]),"+v"(qr[3]));
  DMA2_K(0,0);DMA2_V(0,0);DMA2_K(1,1);DMA2_V(1,1);
  float mhat=0.f,l_reg=0.f;f32x16 o[4];o[0]=f32x16{};o[1]=f32x16{};o[2]=f32x16{};o[3]=f32x16{};f32x16 negm=f32x16{};asm volatile("":"+v"(negm));
  const int qrel=wid*QBLK+r32;
  int sl=0;
  for(int t=0;t<NT;++t){
    if(t+1<NT){ asm volatile("s_waitcnt vmcnt(3) lgkmcnt(0)\n\ts_barrier":::"memory"); } else { asm volatile("s_waitcnt vmcnt(0) lgkmcnt(0)\n\ts_barrier":::"memory"); }
    if(t+2<NT){ const int s2=(sl==0)?2:sl-1; DMA2_K(t+2,s2); DMA2_V(t+2,s2); }
    if(t-(NT-4)>(wid>>1)){ sl=(sl==2)?0:sl+1; continue; }
    f32x16 p0,p1;
    qkt(p0,p1,shm+L2_K+sl*8192,qr,negm,r32,hi); asm volatile("s_nop 15\n\ts_nop 7":"+v"(p0),"+v"(p1));
    const float rm=rowmax(p0,p1);
    bool resc=false;
    if(t==0){ const float dl=rm; mhat+=dl;
      #pragma unroll
      for(int r=0;r<16;++r){p0[r]-=dl;p1[r]-=dl;}
      #pragma unroll
      for(int r=0;r<16;++r)negm[r]=-mhat; asm volatile("":"+v"(negm)); }
    else if(__any(rm>(float)THRL)){ const float dl=__builtin_fmaxf(rm,0.f); mhat+=dl;
      #pragma unroll
      for(int r=0;r<16;++r){p0[r]-=dl;p1[r]-=dl;}
      #pragma unroll
      for(int r=0;r<16;++r)negm[r]=-mhat; asm volatile("":"+v"(negm));
      const float f=__builtin_amdgcn_exp2f(-dl); l_reg*=f; if(hi==0)wsf[r32]=f; resc=true; }
    float sacc=0.f;
    #pragma unroll
    for(int r=0;r<16;++r){p0[r]=__builtin_amdgcn_exp2f(p0[r]);p1[r]=__builtin_amdgcn_exp2f(p1[r]);sacc+=p0[r]+p1[r];}
    l_reg+=sacc;
    u32x4 pw0,pw1,pw2,pw3;
    pw0=(u32x4){cvtpk_s(p0[0],p0[1]),cvtpk_s(p0[2],p0[3]),cvtpk_s(p0[4],p0[5]),cvtpk_s(p0[6],p0[7])};
    pw1=(u32x4){cvtpk_s(p0[8],p0[9]),cvtpk_s(p0[10],p0[11]),cvtpk_s(p0[12],p0[13]),cvtpk_s(p0[14],p0[15])};
    pw2=(u32x4){cvtpk_s(p1[0],p1[1]),cvtpk_s(p1[2],p1[3]),cvtpk_s(p1[4],p1[5]),cvtpk_s(p1[6],p1[7])};
    pw3=(u32x4){cvtpk_s(p1[8],p1[9]),cvtpk_s(p1[10],p1[11]),cvtpk_s(p1[12],p1[13]),cvtpk_s(p1[14],p1[15])};
    if(resc){ asm volatile("s_waitcnt lgkmcnt(0)":::"memory");
      #pragma unroll
      for(int r=0;r<16;++r){ const float f=wsf[crow(r,hi)]; o[0][r]*=f;o[1][r]*=f;o[2][r]*=f;o[3][r]*=f; } }
    SBAR();
    pv(o,vb0+sl*16384,__builtin_bit_cast(bf16x8,pw0),__builtin_bit_cast(bf16x8,pw1),__builtin_bit_cast(bf16x8,pw2),__builtin_bit_cast(bf16x8,pw3));
    pv(o+2,vb0+sl*16384+8192,__builtin_bit_cast(bf16x8,pw0),__builtin_bit_cast(bf16x8,pw1),__builtin_bit_cast(bf16x8,pw2),__builtin_bit_cast(bf16x8,pw3));
    sl=(sl==2)?0:sl+1;
  }
  {auto rr=__builtin_amdgcn_permlane32_swap(__float_as_uint(l_reg),__float_as_uint(l_reg),false,false);l_reg=__uint_as_float(rr[0])+__uint_as_float(rr[1]);}
  if(hi==0)wsf[32+r32]=l_reg;asm volatile("s_waitcnt lgkmcnt(0)":::"memory");
  float rli[16];
  #pragma unroll
  for(int r=0;r<16;++r)rli[r]=__builtin_amdgcn_rcpf(wsf[32+crow(r,hi)]);
  bf16*stg=(bf16*)(shm+L2_OST)+wid*2048;
  #pragma unroll
  for(int hf=0;hf<2;++hf){
    bf16*Ow=O+(rowbase+q0+wid*QBLK)*OP+(ho+hf)*D;
    #pragma unroll
    for(int r=0;r<16;++r){const int orow=crow(r,hi);
      #pragma unroll
      for(int d0=0;d0<2;++d0)stg[orow*64+d0*32+r32]=__float2bfloat16(o[2*hf+d0][r]*rli[r]);}
    asm volatile("s_waitcnt lgkmcnt(0)":::"memory");
    #pragma unroll
    for(int i=0;i<4;++i){const int row=i*8+(lane>>3),ch=lane&7; const u32x4 v=*(const u32x4*)(stg+row*64+ch*8); ATTN_STORE16(Ow+(long)row*OP+ch*8,v);}
    asm volatile("s_waitcnt lgkmcnt(0)":::"memory");
  }
  asm volatile("s_waitcnt lgkmcnt(0)\n\ts_barrier":::"memory");
  #undef DMA2_K
  #undef DMA2_V
}
struct AttnUnit2 { int b, hq, hv, ho, qb; };
struct StaticOrder2 {
  int vcu;
  __device__ __forceinline__ explicit StaticOrder2(int grid,int block):vcu((block%8)*(grid/8)+block/8){}
  __device__ __forceinline__ bool next(int i,AttnUnit2&u)const{ if(i>=8)return false; const int s=vcu&7, r=i>>2, ii=i&3; const int v=r*32+(vcu>>3);
    const int c=v&1, h=(v>>1)&7; u.b=v>>4; u.hq=h*2+c; u.hv=h*2; u.ho=(h*2+c)*2; u.qb=(ii==0)?s:(ii==1)?15-s:(ii==2)?16+s:31-s; return true; }
};
template<class Sched,int THRL=8> __device__ __forceinline__ void attn2_phase(char*lds,const AttnTensors&T,const Sched&S){
  AttnUnit2 u;
  for(int i=0;S.next(i,u);++i){ attn2_unit<THRL>(u.b,u.hq,u.hv,u.ho,u.qb,T.Q,T.K,T.V,T.O,lds); }
}

constexpr int L3_K=0, L3_V=3*8192, L3_WS=L3_V+4*16384, L3_OST=L3_WS+NW*64*4, L3_BYTES=L3_OST+NW*4096;
template<int THRL> __device__ __forceinline__ void attn3_unit(int b,int hq,int hv,int ho,int qb,const bf16*Q,const bf16*__restrict__ K,const bf16*__restrict__ V,bf16*O,char*shm){
  const int tid=threadIdx.x,lane=tid&63,r32=lane&31,hi=lane>>5; const int wid=__builtin_amdgcn_readfirstlane(tid>>6);
  const long rowbase=(long)b*SEQ; const int q0=qb*QB;
  const bf16*Qw=Q+(rowbase+q0+wid*QBLK)*DM+hq*D;
  const bf16*Kh=K+rowbase*DM+hq*D,*Vh=V+rowbase*DM+hv*D;
  const unsigned lds0=(unsigned)(uintptr_t)shm;
  float*wsf=(float*)(shm+L3_WS)+wid*64;
  const bf16*ksrc=Kh+(long)lane*DM+wid*8;
  const bf16*vsrc=Vh+(long)(16*(wid&3)+(lane>>2))*DM+(wid>>2)*32+(lane&3)*8;
  const unsigned kdst=lds0+L3_K+wid*1024, vdst=lds0+L3_V+wid*1024;
  #define DMA3_K(t,sl) glds16(ksrc+(long)(t)*KVBLK*DM,(unsigned)__builtin_amdgcn_readfirstlane(kdst+(sl)*8192))
  #define DMA3_V(t,sl) do{ glds16(vsrc+(long)(t)*KVBLK*DM,(unsigned)__builtin_amdgcn_readfirstlane(vdst+(sl)*16384)); glds16(vsrc+64+(long)(t)*KVBLK*DM,(unsigned)__builtin_amdgcn_readfirstlane(vdst+(sl)*16384+8192)); }while(0)
  const int vb0=(int)(lds0+L3_V)+((lane>>4)&1)*32+(lane&3)*8+(4*hi+((lane&15)>>2))*64;
  const int NT=(q0+QB)/KVBLK;
  bf16x8 qr[4];
  #pragma unroll
  for(int d0=0;d0<4;++d0)qr[d0]=*reinterpret_cast<const bf16x8*>(&Qw[(long)r32*DM+d0*16+hi*8]);
  asm volatile("":"+v"(qr[0]),"+v"(qr[1]),"+v"(qr[2]),"+v"(qr[3]));
  DMA3_K(0,0);DMA3_V(0,0);DMA3_K(1,1);DMA3_V(1,1);
  float mhat=0.f,l_reg=0.f;f32x16 o[4];o[0]=f32x16{};o[1]=f32x16{};o[2]=f32x16{};o[3]=f32x16{};
  const int qrel=wid*QBLK+r32;
  f32x16 P0,P1;
  asm volatile("s_waitcnt vmcnt(5) lgkmcnt(0)\n\ts_barrier":::"memory");
  DMA3_K(2,2);DMA3_V(2,2);
  qkt0(P0,P1,shm+L3_K,qr,r32,hi); asm volatile("s_nop 15\n\ts_nop 7":"+v"(P0),"+v"(P1));
  { const int jb=0-(NT-4); if(jb>=0)cmask(P0,P1,jb,qrel,hi); }
  { const float dl=rowmax(P0,P1); mhat+=dl;
    #pragma unroll
    for(int r=0;r<16;++r){P0[r]=__builtin_amdgcn_exp2f(P0[r]-dl);P1[r]=__builtin_amdgcn_exp2f(P1[r]-dl);} }
  #define PACKP() do{ float sacc=0.f; _Pragma("unroll") for(int r=0;r<16;++r)sacc+=P0[r]+P1[r]; l_reg+=sacc; \
    pw0=(u32x4){cvtpk_s(P0[0],P0[1]),cvtpk_s(P0[2],P0[3]),cvtpk_s(P0[4],P0[5]),cvtpk_s(P0[6],P0[7])}; pw1=(u32x4){cvtpk_s(P0[8],P0[9]),cvtpk_s(P0[10],P0[11]),cvtpk_s(P0[12],P0[13]),cvtpk_s(P0[14],P0[15])}; \
    pw2=(u32x4){cvtpk_s(P1[0],P1[1]),cvtpk_s(P1[2],P1[3]),cvtpk_s(P1[4],P1[5]),cvtpk_s(P1[6],P1[7])}; pw3=(u32x4){cvtpk_s(P1[8],P1[9]),cvtpk_s(P1[10],P1[11]),cvtpk_s(P1[12],P1[13]),cvtpk_s(P1[14],P1[15])}; }while(0)
  #define BF8(x) __builtin_bit_cast(bf16x8,x)
  u32x4 pw0,pw1,pw2,pw3;
  for(int t=1;t<NT;++t){
    if(t+1<NT){ asm volatile("s_waitcnt vmcnt(5) lgkmcnt(0)\n\ts_barrier":::"memory"); } else { asm volatile("s_waitcnt vmcnt(2) lgkmcnt(0)\n\ts_barrier":::"memory"); }
    if(t+2<NT){ DMA3_K(t+2,(t+2)%3); DMA3_V(t+2,(t+2)&3); }
    f32x16 C0,C1;
    qkt0(C0,C1,shm+L3_K+(t%3)*8192,qr,r32,hi);
    PACKP();
    asm volatile("s_nop 15\n\ts_nop 7":"+v"(C0),"+v"(C1));
    { const int jb=t-(NT-4); if(jb>=0)cmask(C0,C1,jb,qrel,hi); }
    const float rm=rowmax(C0,C1)-mhat;
    bool resc=false;
    if(__any(rm>(float)THRL)){ const float dl=__builtin_fmaxf(rm,0.f); mhat+=dl;
      const float f=__builtin_amdgcn_exp2f(-dl); l_reg*=f; if(hi==0)wsf[r32]=f; resc=true; }
    #pragma unroll
    for(int r=0;r<16;++r){C0[r]-=mhat;C1[r]-=mhat;}
    SBAR();
    const int vs=vb0+((t-1)&3)*16384;
    pv(o,vs,BF8(pw0),BF8(pw1),BF8(pw2),BF8(pw3));
    #pragma unroll
    for(int r=0;r<16;++r)P0[r]=__builtin_amdgcn_exp2f(C0[r]);
    SBAR();
    pv(o+2,vs+8192,BF8(pw0),BF8(pw1),BF8(pw2),BF8(pw3));
    #pragma unroll
    for(int r=0;r<16;++r)P1[r]=__builtin_amdgcn_exp2f(C1[r]);
    if(resc){ asm volatile("s_waitcnt lgkmcnt(0)":::"memory");
      #pragma unroll
      for(int r=0;r<16;++r){ const float f=wsf[crow(r,hi)]; o[0][r]*=f;o[1][r]*=f;o[2][r]*=f;o[3][r]*=f; } }
  }
  PACKP();
  asm volatile("s_waitcnt vmcnt(0) lgkmcnt(0)\n\ts_barrier":::"memory");
  { const int vs=vb0+((NT-1)&3)*16384; SBAR(); pv(o,vs,BF8(pw0),BF8(pw1),BF8(pw2),BF8(pw3)); pv(o+2,vs+8192,BF8(pw0),BF8(pw1),BF8(pw2),BF8(pw3)); }
  #undef PACKP
  #undef BF8
  {auto rr=__builtin_amdgcn_permlane32_swap(__float_as_uint(l_reg),__float_as_uint(l_reg),false,false);l_reg=__uint_as_float(rr[0])+__uint_as_float(rr[1]);}
  if(hi==0)wsf[32+r32]=l_reg;asm volatile("s_waitcnt lgkmcnt(0)":::"memory");
  float rli[16];
  #pragma unroll
  for(int r=0;r<16;++r)rli[r]=__builtin_amdgcn_rcpf(wsf[32+crow(r,hi)]);
  bf16*stg=(bf16*)(shm+L3_OST)+wid*2048;
  #pragma unroll
  for(int hf=0;hf<2;++hf){
    bf16*Ow=O+(rowbase+q0+wid*QBLK)*OP+(ho+hf)*D;
    #pragma unroll
    for(int r=0;r<16;++r){const int orow=crow(r,hi);
      #pragma unroll
      for(int d0=0;d0<2;++d0)stg[orow*64+d0*32+r32]=__float2bfloat16(o[2*hf+d0][r]*rli[r]);}
    asm volatile("s_waitcnt lgkmcnt(0)":::"memory");
    #pragma unroll
    for(int i=0;i<4;++i){const int row=i*8+(lane>>3),ch=lane&7; const u32x4 v=*(const u32x4*)(stg+row*64+ch*8); ATTN_STORE16(Ow+(long)row*OP+ch*8,v);}
    asm volatile("s_waitcnt lgkmcnt(0)":::"memory");
  }
  asm volatile("s_waitcnt lgkmcnt(0)\n\ts_barrier":::"memory");
  #undef DMA3_K
  #undef DMA3_V
}
template<class Sched,int THRL=8> __device__ __forceinline__ void attn3_phase(char*lds,const AttnTensors&T,const Sched&S){
  AttnUnit2 u;
  for(int i=0;S.next(i,u);++i){ attn3_unit<THRL>(u.b,u.hq,u.hv,u.ho,u.qb,T.Q,T.K,T.V,T.O,lds); }
}

#ifndef ATTN4_GRP
#define ATTN4_GRP (wid>>2)
#endif
constexpr int L4_K=0, L4_V=4*8192, L4_WS=L4_V+4*16384, L4_OST=L4_WS+NW*64*4, L4_BYTES=L4_OST+NW*4096;
#define WAITBARN(n) do{ const int n_=(n); if(n_==0){asm volatile("s_waitcnt vmcnt(0) lgkmcnt(0)\n\ts_barrier":::"memory");} else if(n_==2){asm volatile("s_waitcnt vmcnt(2) lgkmcnt(0)\n\ts_barrier":::"memory");} \
  else if(n_==3){asm volatile("s_waitcnt vmcnt(3) lgkmcnt(0)\n\ts_barrier":::"memory");} else if(n_==5){asm volatile("s_waitcnt vmcnt(5) lgkmcnt(0)\n\ts_barrier":::"memory");} else {asm volatile("s_waitcnt vmcnt(6) lgkmcnt(0)\n\ts_barrier":::"memory");} }while(0)
template<int THRL> __device__ __forceinline__ void attn4_unit(int b,int hq,int hv,int ho,int qb,const bf16*Q,const bf16*__restrict__ K,const bf16*__restrict__ V,bf16*O,char*shm){
  const int tid=threadIdx.x,lane=tid&63,r32=lane&31,hi=lane>>5; const int wid=__builtin_amdgcn_readfirstlane(tid>>6); const int grp=(ATTN4_GRP);
  const long rowbase=(long)b*SEQ; const int q0=qb*QB;
  const bf16*Qw=Q+(rowbase+q0+wid*QBLK)*DM+hq*D;
  const bf16*Kh=K+rowbase*DM+hq*D,*Vh=V+rowbase*DM+hv*D;
  const unsigned lds0=(unsigned)(uintptr_t)shm;
  float*wsf=(float*)(shm+L4_WS)+wid*64;
  const bf16*ksrc=Kh+(long)lane*DM+wid*8;
  const bf16*vsrc=Vh+(long)(16*(wid&3)+(lane>>2))*DM+(wid>>2)*32+(lane&3)*8;
  const unsigned kdst=lds0+L4_K+wid*1024, vdst=lds0+L4_V+wid*1024;
  #define DMA4_K(t,sl) glds16(ksrc+(long)(t)*KVBLK*DM,(unsigned)__builtin_amdgcn_readfirstlane(kdst+(sl)*8192))
  #define DMA4_V(t,sl) do{ glds16(vsrc+(long)(t)*KVBLK*DM,(unsigned)__builtin_amdgcn_readfirstlane(vdst+(sl)*16384)); glds16(vsrc+64+(long)(t)*KVBLK*DM,(unsigned)__builtin_amdgcn_readfirstlane(vdst+(sl)*16384+8192)); }while(0)
  const int vb0=(int)(lds0+L4_V)+((lane>>4)&1)*32+(lane&3)*8+(4*hi+((lane&15)>>2))*64;
  const int NT=(q0+QB)/KVBLK;
  bf16x8 qr[4];
  #pragma unroll
  for(int d0=0;d0<4;++d0)qr[d0]=*reinterpret_cast<const bf16x8*>(&Qw[(long)r32*DM+d0*16+hi*8]);
  asm volatile("":"+v"(qr[0]),"+v"(qr[1]),"+v"(qr[2]),"+v"(qr[3]));
  DMA4_K(0,0);DMA4_V(0,0);DMA4_K(1,1);DMA4_V(1,1);
  float mhat=0.f,l_reg=0.f;f32x16 o[4];o[0]=f32x16{};o[1]=f32x16{};o[2]=f32x16{};o[3]=f32x16{};f32x16 negm=f32x16{};asm volatile("":"+v"(negm));
  if(grp){ WAITBARN(5); }
  for(int t=0;t<NT;++t){
    const int sl=t&3;
    if(grp==0){ WAITBARN(t+1<NT?5:2); } else { WAITBARN(t+1<NT?3:0); }
    if(t+2<NT){ DMA4_K(t+2,(t+2)&3); DMA4_V(t+2,(t+2)&3); }
    const bool live=!(t-(NT-4)>(wid>>1));
    u32x4 pw0,pw1,pw2,pw3; bool resc=false;
    if(live){
      f32x16 p0,p1;
      qkt(p0,p1,shm+L4_K+sl*8192,qr,negm,r32,hi); asm volatile("s_nop 15\n\ts_nop 7":"+v"(p0),"+v"(p1));
      const float rm=rowmax(p0,p1);
      if(t==0){ const float dl=rm; mhat+=dl;
        #pragma unroll
        for(int r=0;r<16;++r){p0[r]-=dl;p1[r]-=dl;}
        #pragma unroll
        for(int r=0;r<16;++r)negm[r]=-mhat; asm volatile("":"+v"(negm)); }
      else if(__any(rm>(float)THRL)){ const float dl=__builtin_fmaxf(rm,0.f); mhat+=dl;
        #pragma unroll
        for(int r=0;r<16;++r){p0[r]-=dl;p1[r]-=dl;}
        #pragma unroll
        for(int r=0;r<16;++r)negm[r]=-mhat; asm volatile("":"+v"(negm));
        const float f=__builtin_amdgcn_exp2f(-dl); l_reg*=f; if(hi==0)wsf[r32]=f; resc=true; }
      float sacc=0.f;
      #pragma unroll
      for(int r=0;r<16;++r){p0[r]=__builtin_amdgcn_exp2f(p0[r]);p1[r]=__builtin_amdgcn_exp2f(p1[r]);sacc+=p0[r]+p1[r];}
      l_reg+=sacc;
      pw0=(u32x4){cvtpk_s(p0[0],p0[1]),cvtpk_s(p0[2],p0[3]),cvtpk_s(p0[4],p0[5]),cvtpk_s(p0[6],p0[7])};
      pw1=(u32x4){cvtpk_s(p0[8],p0[9]),cvtpk_s(p0[10],p0[11]),cvtpk_s(p0[12],p0[13]),cvtpk_s(p0[14],p0[15])};
      pw2=(u32x4){cvtpk_s(p1[0],p1[1]),cvtpk_s(p1[2],p1[3]),cvtpk_s(p1[4],p1[5]),cvtpk_s(p1[6],p1[7])};
      pw3=(u32x4){cvtpk_s(p1[8],p1[9]),cvtpk_s(p1[10],p1[11]),cvtpk_s(p1[12],p1[13]),cvtpk_s(p1[14],p1[15])};
      if(resc){ asm volatile("s_waitcnt lgkmcnt(0)":::"memory");
        #pragma unroll
        for(int r=0;r<16;++r){ const float f=wsf[crow(r,hi)]; o[0][r]*=f;o[1][r]*=f;o[2][r]*=f;o[3][r]*=f; } }
    }
    if(grp==0){ WAITBARN(t+2<NT?6:(t+1<NT?3:0)); } else { WAITBARN(t+2<NT?5:(t+1<NT?2:0)); }
    if(live){
      SBAR();
      pv(o,vb0+sl*16384,__builtin_bit_cast(bf16x8,pw0),__builtin_bit_cast(bf16x8,pw1),__builtin_bit_cast(bf16x8,pw2),__builtin_bit_cast(bf16x8,pw3));
      pv(o+2,vb0+sl*16384+8192,__builtin_bit_cast(bf16x8,pw0),__builtin_bit_cast(bf16x8,pw1),__builtin_bit_cast(bf16x8,pw2),__builtin_bit_cast(bf16x8,pw3));
    }
  }
  if(grp==0){ asm volatile("s_waitcnt lgkmcnt(0)\n\ts_barrier":::"memory"); }
  {auto rr=__builtin_amdgcn_permlane32_swap(__float_as_uint(l_reg),__float_as_uint(l_reg),false,false);l_reg=__uint_as_float(rr[0])+__uint_as_float(rr[1]);}
  if(hi==0)wsf[32+r32]=l_reg;asm volatile("s_waitcnt lgkmcnt(0)":::"memory");
  float rli[16];
  #pragma unroll
  for(int r=0;r<16;++r)rli[r]=__builtin_amdgcn_rcpf(wsf[32+crow(r,hi)]);
  bf16*stg=(bf16*)(shm+L4_OST)+wid*2048;
  #pragma unroll
  for(int hf=0;hf<2;++hf){
    bf16*Ow=O+(rowbase+q0+wid*QBLK)*OP+(ho+hf)*D;
    #pragma unroll
    for(int r=0;r<16;++r){const int orow=crow(r,hi);
      #pragma unroll
      for(int d0=0;d0<2;++d0)stg[orow*64+d0*32+r32]=__float2bfloat16(o[2*hf+d0][r]*rli[r]);}
    asm volatile("s_waitcnt lgkmcnt(0)":::"memory");
    #pragma unroll
    for(int i=0;i<4;++i){const int row=i*8+(lane>>3),ch=lane&7; const u32x4 v=*(const u32x4*)(stg+row*64+ch*8); ATTN_STORE16(Ow+(long)row*OP+ch*8,v);}
    asm volatile("s_waitcnt lgkmcnt(0)":::"memory");
  }
  asm volatile("s_waitcnt lgkmcnt(0)\n\ts_barrier":::"memory");
  #undef DMA4_K
  #undef DMA4_V
}
template<class Sched,int THRL=8> __device__ __forceinline__ void attn4_phase(char*lds,const AttnTensors&T,const Sched&S){
  AttnUnit2 u;
  for(int i=0;S.next(i,u);++i){ attn4_unit<THRL>(u.b,u.hq,u.hv,u.ho,u.qb,T.Q,T.K,T.V,T.O,lds); }
}
template<int THRL> __device__ __forceinline__ void attn5_unit(int b,int h,int hv,int ho,int qb,const bf16*Q,const bf16*__restrict__ K,const bf16*__restrict__ V,bf16*O,char*shm,const float*qg,const float*ropec,const float*ropes){
  const int tid=threadIdx.x,lane=tid&63,r32=lane&31,hi=lane>>5; const int wid=__builtin_amdgcn_readfirstlane(tid>>6);
  const long rowbase=(long)b*SEQ; const int q0=qb*QB;
  const bf16*Qw=Q+(rowbase+q0+wid*QBLK)*DM+h*D;
  const bf16*Kh=K+rowbase*DM+h*D,*Vh=V+rowbase*DM+hv*D;
  const unsigned lds0=(unsigned)(uintptr_t)shm;
  float*wsf=(float*)(shm+L2_WS)+wid*64;
  const bf16*ksrc=Kh+(long)lane*DM+wid*8;
  const bf16*vsrc=Vh+(long)(16*(wid&3)+(lane>>2))*DM+(wid>>2)*32+(lane&3)*8;
  const unsigned kdst=lds0+L2_K+wid*1024, vdst=lds0+L2_V+wid*1024;
  #define DMA_K(t,slot) glds16(ksrc+(long)(t)*KVBLK*DM,(unsigned)__builtin_amdgcn_readfirstlane(kdst+(slot)))
  #define DMA_V(t,slot) do{ glds16(vsrc+(long)(t)*KVBLK*DM,(unsigned)__builtin_amdgcn_readfirstlane(vdst+2*(slot))); glds16(vsrc+64+(long)(t)*KVBLK*DM,(unsigned)__builtin_amdgcn_readfirstlane(vdst+2*(slot)+8192)); }while(0)
  const int vb0=(int)(lds0+L2_V)+((lane>>4)&1)*32+(lane&3)*8+(4*hi+((lane&15)>>2))*64;
  const char*Kbase=shm+L2_K; bf16x8 kf[8];
  const lds_cptr shm3=(lds_cptr)shm; const lds_cptr kp0=shm3+L2_K+hi*1024+r32*16; const lds_cptr vp0=shm3+L2_V+((lane>>4)&1)*32+(lane&3)*8+(4*hi+((lane&15)>>2))*64;
  const int NT=(q0+QB)/KVBLK;
  DMA_K(0,0);DMA_V(0,0);DMA_K(1,SLOTB);
  bf16x8 qr[4];
  #pragma unroll
  for(int d0=0;d0<4;++d0)qr[d0]=*reinterpret_cast<const bf16x8*>(&Qw[(long)r32*DM+d0*16+hi*8]);
  if(qg){
    float x[4][8]; float ssq=0.f;
    #pragma unroll
    for(int d0=0;d0<4;++d0){
      #pragma unroll
      for(int e=0;e<8;++e){ x[d0][e]=__uint_as_float(((unsigned)(unsigned short)qr[d0][e])<<16); ssq+=x[d0][e]*x[d0][e]; } }
    ssq+=__shfl_xor(ssq,32);
    const float rstd=C2/sqrtf(ssq*(1.f/64.f)+1e-6f);
    const int pos=q0+wid*QBLK+r32;
    #pragma unroll
    for(int d0=0;d0<2;++d0){ const int i0=16*d0+8*hi; u32x4 w1,w2; float o1[8],o2[8];
      #pragma unroll
      for(int e=0;e<8;++e){ const float cs=ropec[(long)pos*32+i0+e],sn=ropes[(long)pos*32+i0+e]; const float a_=x[d0][e]*rstd*qg[i0+e],b_=x[d0+2][e]*rstd*qg[32+i0+e]; o1[e]=a_*cs-b_*sn; o2[e]=b_*cs+a_*sn; }
      w1=(u32x4){cvtpk_s(o1[0],o1[1]),cvtpk_s(o1[2],o1[3]),cvtpk_s(o1[4],o1[5]),cvtpk_s(o1[6],o1[7])}; w2=(u32x4){cvtpk_s(o2[0],o2[1]),cvtpk_s(o2[2],o2[3]),cvtpk_s(o2[4],o2[5]),cvtpk_s(o2[6],o2[7])};
      qr[d0]=__builtin_bit_cast(bf16x8,w1); qr[d0+2]=__builtin_bit_cast(bf16x8,w2); }
  }
  float mhat=0.f,l_reg=0.f;f32x16 o[4];o[0]=f32x16{};o[1]=f32x16{};o[2]=f32x16{};o[3]=f32x16{};f32x16 negm=f32x16{};asm volatile("":"+v"(negm));
  const int qrel=wid*QBLK+r32;
  #define CMASK(P0,P1,t) do{int jb_=(t)-(NT-4); if(jb_>=0)cmask(P0,P1,jb_,qrel,hi);}while(0)
  bool resc=false;
  #define START(P0,P1) do{ const float rm=rowmax(P0,P1); resc=false; \
    { const float dl=rm; mhat=fadd_s(mhat,dl); \
      _Pragma("unroll") for(int r=0;r<16;++r){P0[r]=fsub_s(P0[r],dl);P1[r]=fsub_s(P1[r],dl);} \
      _Pragma("unroll") for(int r=0;r<16;++r)negm[r]=-mhat; asm volatile("":"+v"(negm)); } \
    _Pragma("unroll") for(int r=0;r<16;++r)P0[r]=__builtin_amdgcn_exp2f(P0[r]); }while(0)
  #define RESC() do{ if(resc){ asm volatile("s_waitcnt lgkmcnt(0)":::"memory"); \
      _Pragma("unroll") for(int r=0;r<16;++r){ const float f_=wsf[crow(r,hi)]; o[0][r]*=f_;o[1][r]*=f_;o[2][r]*=f_;o[3][r]*=f_; } } }while(0)
  f32x16 pA0,pA1,pB0,pB1;
  int sl_prev=0,sl_cur=0,sl_next=SLOTB;
  #define ROT() do{sl_prev=sl_cur;sl_cur=sl_next;sl_next=(sl_next==(NSLOT-1)*SLOTB)?0:sl_next+SLOTB;}while(0)
  DMA_K(2,2*SLOTB);
  WAIT_BAR(4);
  qkt(pA0,pA1,Kbase,qr,negm,r32,hi);asm volatile("s_nop 15\n\ts_nop 7":"+v"(pA0),"+v"(pA1));CMASK(pA0,pA1,0);
  START(pA0,pA1);
  _Pragma("unroll") for(int r=0;r<16;++r)pA1[r]=__builtin_amdgcn_exp2f(pA1[r]);
  WAIT_BAR(0);
  DMA_K(3,0);DMA_V(1,SLOTB);
  ROT();
  kload8(kf,kp0+sl_cur);
  WAIT_BAR(3);
  s16x4 vlo[4],vhi[4]; u32x4 pw0,pw1,pw2,pw3;
  #define PKW(P,B) cvtpk_s(P[B],P[B+1])
  #define PAF(k) __builtin_bit_cast(bf16x8,pw##k)
  #define VFR(i) (bf16x8){vlo[i][0],vlo[i][1],vlo[i][2],vlo[i][3],vhi[i][0],vhi[i][1],vhi[i][2],vhi[i][3]}
  #define PIN(x) asm volatile("":"+v"(x))
  #define MX3(a,b,c) __builtin_fmaxf(__builtin_fmaxf((a),(b)),(c))
  #define GAPA(MF,A0,A1,A2,A3,W0,W1,PW) do{ MF; sacc+=A0; sacc+=A1; sacc+=A2; sacc+=A3; PIN(sacc); W0; W1; PIN(PW); SBAR(); }while(0)
  #define EX(v) __builtin_amdgcn_exp2f(v)
  #define GAPB(MF,X,B) do{ MF; X[B]=EX(X[B]); X[B+1]=EX(X[B+1]); PIN(X); SBAR(); }while(0)
  #define VOFF(j) ((((j)&3)>>1)*8192+((j)&1)*4096+((j)>>2)*1024)
  #define VRD(j) do{ vlo[(j)&3]=vtr(vp_+VOFF(j)); vhi[(j)&3]=vtr(vp_+(VOFF(j)+512)); }while(0)
  #define PVM(j,ks) o[(j)&3]=__builtin_amdgcn_mfma_f32_32x32x16_bf16(PAF(ks),VFR((j)&3),o[(j)&3],0,0,0)
  #define KRD(G,j) do{ if(G){ kload2(kf,kp0+sl_next,j); SBAR(); } }while(0)
  #define STEP(C0,C1,P0,P1,t,GK,GV,GL) do{ SBAR(); \
    const lds_cptr vp_=vp0+2*sl_prev; \
    float sacc=(P0[0]+P0[1]); \
    GAPA(C0=__builtin_amdgcn_mfma_f32_32x32x16_bf16(kf[0],qr[0],negm,0,0,0), P0[2],P0[3],P0[4],P0[5],     pw0[0]=PKW(P0,0), pw0[1]=PKW(P0,2), pw0); \
    GAPA(C1=__builtin_amdgcn_mfma_f32_32x32x16_bf16(kf[1],qr[0],negm,0,0,0), P0[6],P0[7],P0[8],P0[9],     pw0[2]=PKW(P0,4), pw0[3]=PKW(P0,6), pw0); \
    GAPA(C0=__builtin_amdgcn_mfma_f32_32x32x16_bf16(kf[2],qr[1],C0,0,0,0),   P0[10],P0[11],P0[12],P0[13], pw1[0]=PKW(P0,8), pw1[1]=PKW(P0,10), pw1); \
    GAPA(C1=__builtin_amdgcn_mfma_f32_32x32x16_bf16(kf[3],qr[1],C1,0,0,0),   P0[14],P0[15],P1[0],P1[1],   pw1[2]=PKW(P0,12),pw1[3]=PKW(P0,14), pw1); \
    GAPA(C0=__builtin_amdgcn_mfma_f32_32x32x16_bf16(kf[4],qr[2],C0,0,0,0),   P1[2],P1[3],P1[4],P1[5],     pw2[0]=PKW(P1,0), pw2[1]=PKW(P1,2), pw2); \
    VRD(0); SBAR(); GAPA(C1=__builtin_amdgcn_mfma_f32_32x32x16_bf16(kf[5],qr[2],C1,0,0,0),   P1[6],P1[7],P1[8],P1[9],     pw2[2]=PKW(P1,4), pw2[3]=PKW(P1,6), pw2); \
    VRD(1); SBAR(); GAPA(C0=__builtin_amdgcn_mfma_f32_32x32x16_bf16(kf[6],qr[3],C0,0,0,0),   P1[10],P1[11],P1[12],P1[13], pw3[0]=PKW(P1,8), pw3[1]=PKW(P1,10), pw3); \
    VRD(2); SBAR(); GAPA(C1=__builtin_amdgcn_mfma_f32_32x32x16_bf16(kf[7],qr[3],C1,0,0,0),   P1[14],P1[15],0.f,0.f,       pw3[2]=PKW(P1,12),pw3[3]=PKW(P1,14), pw3); \
    l_reg+=sacc; \
    if(GK){DMA_K((t)+3,sl_cur);} if(GV){DMA_V((t)+1,sl_next);} \
    CMASK(C0,C1,t); \
    { float a=MX3(C0[0],C0[1],C1[0]),b=MX3(C0[2],C0[3],C1[1]); a=MX3(a,C1[2],C1[3]); \
      _Pragma("unroll") for(int r=4;r<16;r+=4){a=MX3(a,C0[r],C0[r+1]);b=MX3(b,C0[r+2],C0[r+3]);a=MX3(a,C1[r],C1[r+1]);b=MX3(b,C1[r+2],C1[r+3]);} \
      float rm=__builtin_fmaxf(a,b); { auto rr=__builtin_amdgcn_permlane32_swap(__float_as_uint(rm),__float_as_uint(rm),false,false); rm=__builtin_fmaxf(__uint_as_float(rr[0]),__uint_as_float(rr[1])); } \
      resc=false; \
      if(__builtin_expect(__any(rm>(float)THRL),0)){ const float dl=__builtin_fmaxf(rm,0.f); mhat+=dl; \
        _Pragma("unroll") for(int r=0;r<16;++r){C0[r]-=dl;C1[r]-=dl;} \
        _Pragma("unroll") for(int r=0;r<16;++r)negm[r]=-mhat; asm volatile("":"+v"(negm)); \
        const float f=__builtin_amdgcn_exp2f(-dl); l_reg*=f; if(hi==0)wsf[r32]=f; resc=true; } } \
    SBAR(); \
    VRD(3); SBAR(); GAPB(PVM(0,0), C0,0); \
    VRD(4); SBAR(); GAPB(PVM(1,0), C0,2); \
    VRD(5); SBAR(); GAPB(PVM(2,0), C0,4); \
    VRD(6); SBAR(); GAPB(PVM(3,0), C0,6); \
    VRD(7); SBAR(); GAPB(PVM(4,1), C0,8); \
    VRD(8); SBAR(); KRD(GL,0); GAPB(PVM(5,1), C0,10); \
    VRD(9); SBAR(); GAPB(PVM(6,1), C0,12); \
    VRD(10); SBAR(); KRD(GL,1); GAPB(PVM(7,1), C0,14); \
    VRD(11); SBAR(); GAPB(PVM(8,2), C1,0); \
    VRD(12); SBAR(); KRD(GL,2); GAPB(PVM(9,2), C1,2); \
    VRD(13); SBAR(); GAPB(PVM(10,2), C1,4); \
    VRD(14); SBAR(); KRD(GL,3); GAPB(PVM(11,2), C1,6); \
    VRD(15); SBAR(); GAPB(PVM(12,3), C1,8); \
    GAPB(PVM(13,3), C1,10); \
    GAPB(PVM(14,3), C1,12); \
    GAPB(PVM(15,3), C1,14); \
    }while(0)
  int t=1;
  #undef CMASK
  #define CMASK(P0,P1,t) do{}while(0)
#if LOOP_ALIGN
  asm volatile(".p2align " LOOP_ALIGN_S);
#endif
  for(;t+5<NT;t+=2){
    STEP(pB0,pB1,pA0,pA1,t,true,true,true);     WAIT_BAR(3); RESC(); ROT();
    STEP(pA0,pA1,pB0,pB1,t+1,true,true,true);   WAIT_BAR(3); RESC(); ROT();
  }
  #undef CMASK
  #define CMASK(P0,P1,t) do{int jb_=(t)-(NT-4); if(jb_>=0)cmask(P0,P1,jb_,qrel,hi);}while(0)
  #define ENDW(tt) do{ if((tt)+3<NT){WAIT_BAR(3);} else if((tt)+2<NT){WAIT_BAR(2);} else {WAIT_BAR(0);} }while(0)
  for(;t+1<NT;t+=2){
    STEP(pB0,pB1,pA0,pA1,t,(t+3<NT),(t+1<NT),(t+1<NT));       ENDW(t);   RESC(); ROT();
    STEP(pA0,pA1,pB0,pB1,t+1,(t+4<NT),(t+2<NT),(t+2<NT));     ENDW(t+1); RESC(); ROT();
  }
  STEP(pB0,pB1,pA0,pA1,NT-1,false,false,false); RESC();
  { float sacc=pB0[0]+pB0[1]; _Pragma("unroll") for(int r=2;r<16;++r)sacc+=pB0[r]; _Pragma("unroll") for(int r=0;r<16;++r)sacc+=pB1[r]; l_reg+=sacc;
    pw0=(u32x4){PKW(pB0,0),PKW(pB0,2),PKW(pB0,4),PKW(pB0,6)};pw1=(u32x4){PKW(pB0,8),PKW(pB0,10),PKW(pB0,12),PKW(pB0,14)};pw2=(u32x4){PKW(pB1,0),PKW(pB1,2),PKW(pB1,4),PKW(pB1,6)};pw3=(u32x4){PKW(pB1,8),PKW(pB1,10),PKW(pB1,12),PKW(pB1,14)};
    SBAR(); pv(o,vb0+2*sl_cur,PAF(0),PAF(1),PAF(2),PAF(3)); pv(o+2,vb0+2*sl_cur+8192,PAF(0),PAF(1),PAF(2),PAF(3)); }
  #undef PKW
  #undef PAF
  #undef VFR
  #undef PIN
  #undef MX3
  #undef GAPA
  #undef GAPB
  #undef EX
  #undef VRD
  #undef VOFF
  #undef PVM
  #undef KRD
  #undef STEP
  #undef ENDW
  {auto rr=__builtin_amdgcn_permlane32_swap(__float_as_uint(l_reg),__float_as_uint(l_reg),false,false);l_reg=__uint_as_float(rr[0])+__uint_as_float(rr[1]);}
  if(hi==0)wsf[32+r32]=l_reg;asm volatile("s_waitcnt lgkmcnt(0)":::"memory");
  float rli[16];
  #pragma unroll
  for(int r=0;r<16;++r)rli[r]=__builtin_amdgcn_rcpf(wsf[32+crow(r,hi)]);
  bf16*stg=(bf16*)(shm+L2_OST)+wid*2048;
  #pragma unroll
  for(int hf=0;hf<2;++hf){
    bf16*Ow=O+(rowbase+q0+wid*QBLK)*OP+(ho+hf)*D;
    #pragma unroll
    for(int r=0;r<16;++r){const int orow=crow(r,hi);
      #pragma unroll
      for(int d0=0;d0<2;++d0)stg[orow*64+d0*32+r32]=__float2bfloat16(o[2*hf+d0][r]*rli[r]);}
    asm volatile("s_waitcnt lgkmcnt(0)":::"memory");
    #pragma unroll
    for(int i=0;i<4;++i){const int row=i*8+(lane>>3),ch=lane&7; const u32x4 v=*(const u32x4*)(stg+row*64+ch*8); ATTN_STORE16(Ow+(long)row*OP+ch*8,v);}
    asm volatile("s_waitcnt lgkmcnt(0)":::"memory");
  }
  asm volatile("s_waitcnt lgkmcnt(0)\n\ts_barrier":::"memory");
  #undef DMA_K
  #undef DMA_V
  #undef CMASK
  #undef START
  #undef RESC
  #undef ROT
}
template<class Sched,int THRL=8> __device__ __forceinline__ void attn5_phase(char*lds,const AttnTensors&T,const Sched&S){
  AttnUnit2 u;
  for(int i=0;S.next(i,u);++i){ attn5_unit<THRL>(u.b,u.hq,u.hv,u.ho,u.qb,T.Q,T.K,T.V,T.O,lds,T.qg,T.ropec,T.ropes); }
}
#undef SBAR
#undef WAIT_BAR
}

#define GAS __attribute__((address_space(1)))
#define LAS __attribute__((address_space(3)))
typedef unsigned short bfu;
typedef unsigned v4u __attribute__((ext_vector_type(4)));
typedef unsigned v2u __attribute__((ext_vector_type(2)));
typedef float f32x4 __attribute__((ext_vector_type(4)));
using pg8::Unit; using pg8::UP; using pg8::st8; using pg8::cvt_pk_bf16;

constexpr int NB = 4, SEQ = 8192, DM = 1024, T = NB * SEQ;
constexpr int NWAVES = 8, NTHR = 512;
constexpr float NORM_EPS = 1e-6f;
constexpr float LAMBDA_INIT = 0.2f;
constexpr int NSLOT_MAX = 131072 + 32 * 256;

constexpr size_t MiB = 1u << 20;
constexpr size_t WS_CTL = 0, CTL_ZERO_BYTES = 4 * MiB;
constexpr int CW_TMO = 0, CW_BAR = 4096;
constexpr size_t WS_DEN = 1 * MiB, WS_CAROWP = 2 * MiB;
constexpr size_t WS_DENP = 16 * MiB;
constexpr size_t WS_CASQP = 16 * MiB;
constexpr size_t WS_SMALL = 4 * MiB;
constexpr size_t SM_IPRE = WS_SMALL, SM_FPRE = SM_IPRE + 512 * 1024, SM_AA = SM_FPRE + 512 * 1024, SM_GG = SM_AA + 512 * 1024, SM_MM = SM_GG + 512 * 1024,
                 SM_QN = SM_MM + 512 * 1024, SM_DN = SM_QN + 512 * 1024, SM_UQK = SM_DN + 512 * 1024, SM_UV = SM_UQK + 64 * 1024, SM_LAM = SM_UV + 64 * 1024, SM_INVF = SM_LAM + 1024,
                 SM_ROPEC = WS_SMALL + 4 * MiB, SM_ROPES = WS_SMALL + 5 * MiB, SM_MEMN = WS_SMALL + 6 * MiB, SM_KCA = WS_SMALL + 8 * MiB, SM_VCAT = WS_SMALL + 10 * MiB,
                 SM_TOPI = WS_SMALL + 12 * MiB, SM_TOPW = SM_TOPI + 512 * 1024, SM_SLOTOF = SM_TOPW + 512 * 1024, SM_WGCNT = SM_SLOTOF + 512 * 1024, SM_META = SM_WGCNT + 64 * 1024,
                 SM_TOK = WS_SMALL + 14 * MiB, SM_WSRT = SM_TOK + 768 * 1024;
constexpr size_t WS_WINT = 20 * MiB, WS_CAKVT = 42 * MiB, WS_WBDAT = 46 * MiB, WS_WBMLT = 48 * MiB, WS_WBCAT = 52 * MiB, WS_WOUTT = 54 * MiB;
constexpr size_t WS_XN = 56 * MiB;
constexpr int LDT = SEQ + 64;
constexpr size_t WS_R3 = 120 * MiB, WS_R1 = 248 * MiB, WS_R2 = 376 * MiB, WS_R4 = 504 * MiB, WS_R5 = 633 * MiB, WS_R6 = 762 * MiB, WS_R7 = 890 * MiB, WS_END = 1018 * MiB;
static_assert((size_t)16 * 512 * LDT * 2 <= 129 * MiB, "padded transposed tensors fit their regions");
constexpr size_t WS_KNAT = WS_R3, WS_HH = WS_R3, WS_MLX = WS_R1, WS_QNAT = WS_R2, WS_KT = WS_R4, WS_VT = WS_R5, WS_C = WS_R6, WS_S = WS_R7;
constexpr size_t WS_O = WS_R1, WS_DAQ = 376 * MiB, WS_DAK = 440 * MiB, WS_DAV = 504 * MiB, WS_CAQ = 568 * MiB, WS_GATE = 632 * MiB, WS_WDT = 824 * MiB, WS_WGUT = 888 * MiB;
constexpr size_t WS_MIXBF = 440 * MiB, WS_A2 = 120 * MiB, WS_Y = 392 * MiB;
constexpr size_t WS_XN8 = 856 * MiB, WS_WG8 = 984 * MiB;
static_assert(SM_WSRT + NSLOT_MAX * 4 <= WS_WINT && SM_TOK + NSLOT_MAX * 4 <= SM_WSRT, "small map");

constexpr int SCR_BYTES = 135168;
constexpr int LDSCTL_OFF = SCR_BYTES, MISC_OFF = LDSCTL_OFF + 320, BIAS_OFF = 147456, LDS_BYTES = 159744;

#define RLX_AGENT __ATOMIC_RELAXED, __HIP_MEMORY_SCOPE_AGENT
#define LDS_WAIT() asm volatile("s_waitcnt lgkmcnt(0)" ::: "memory")
#define VM_WAIT() asm volatile("s_waitcnt vmcnt(0)" ::: "memory")
__device__ __forceinline__ unsigned f2bf(float f) { unsigned u = __builtin_bit_cast(unsigned, f); return (u + 0x7fffu + ((u >> 16) & 1u)) >> 16; }
__device__ __forceinline__ unsigned pk2(float lo, float hi) { return cvt_pk_bf16(lo, hi); }
__device__ __forceinline__ float bflo(unsigned w) { return __builtin_bit_cast(float, w << 16); }
__device__ __forceinline__ float bfhi(unsigned w) { return __builtin_bit_cast(float, w & 0xffff0000u); }
__device__ __forceinline__ float fexp(float x) { return __builtin_amdgcn_exp2f(x * 1.4426950408889634f); }
__device__ __forceinline__ float frcp(float x) { return __builtin_amdgcn_rcpf(x); }
__device__ __forceinline__ float fsigmoid(float x) { return frcp(1.f + fexp(-x)); }
__device__ __forceinline__ float fsilu(float x) { return x * fsigmoid(x); }
__device__ __forceinline__ float wave_sum(float v) {
#pragma unroll
    for (int o = 1; o < 64; o <<= 1) v += __shfl_xor(v, o);
    return v;
}
__device__ __forceinline__ float wave_max(float v) {
#pragma unroll
    for (int o = 1; o < 64; o <<= 1) v = fmaxf(v, __shfl_xor(v, o));
    return v;
}

#ifndef FAST_BAR
#define FAST_BAR 1
#endif
#define XB_TMO      128
#define XB_XCNT(j)  (256  + 64 * (j))
#define XB_XSUB(j)  (1280 + 64 * (j))
#define XB_XGEN(j)  (2304 + 64 * (j))
#define XB_TOP      3328
#define XB_TOPGEN   3392
#define XCD_BAR_WORDS 3456
#define XB_SPIN_CAP (1u << 18)
__device__ __forceinline__ unsigned xb_ld(unsigned* p)              { return __hip_atomic_load(p, __ATOMIC_RELAXED, __HIP_MEMORY_SCOPE_AGENT); }
__device__ __forceinline__ unsigned xb_add(unsigned* p, unsigned v) { return __hip_atomic_fetch_add(p, v, __ATOMIC_RELAXED, __HIP_MEMORY_SCOPE_AGENT); }
__device__ __forceinline__ unsigned xb_xcc_id() { return (unsigned)__builtin_amdgcn_s_getreg((3 << 11) | 20) & 0xFu; }
#define XB_SPIN(cond, bar) do { unsigned _sp = 0; while (cond) { __builtin_amdgcn_s_sleep(1); \
    if ((++_sp & 255u) == 0u) { if (xb_ld(&(bar)[XB_TMO])) break; if (_sp > XB_SPIN_CAP) { atomicAdd(&(bar)[XB_TMO], 1u); break; } } } } while (0)
struct XcdBarrier { unsigned* bar; unsigned x; volatile LAS unsigned* st; };
__device__ __forceinline__ XcdBarrier xcd_barrier_post(unsigned* bar, volatile LAS unsigned* st) {
    XcdBarrier b; b.bar = bar; b.x = xb_xcc_id(); b.st = st;
    if (threadIdx.x == 0) (void)xb_add(&bar[XB_XCNT(b.x)], 1u);
    return b;
}
__device__ __forceinline__ void xcd_barrier_complete(unsigned* bar, unsigned x, unsigned& nloc, unsigned& nx) {
    const unsigned G = gridDim.x * gridDim.y * gridDim.z;
    unsigned sum, cnt, mine, sp = 0u;
    for (;;) {
        sum = 0u; cnt = 0u; mine = 0u;
#pragma unroll
        for (unsigned j = 0; j < 16; ++j) { const unsigned c = xb_ld(&bar[XB_XCNT(j)]); sum += c; cnt += (c > 0u) ? 1u : 0u; mine = (j == x) ? c : mine; }
        if (sum == G) break;
        __builtin_amdgcn_s_sleep(1);
        if ((++sp & 255u) == 0u) { if (xb_ld(&bar[XB_TMO])) break; if (sp > XB_SPIN_CAP) { atomicAdd(&bar[XB_TMO], 1u); break; } }
    }
    nloc = mine > 0u ? mine : 1u; nx = cnt > 0u ? cnt : 1u;
}
__device__ __forceinline__ void xcd_barrier(const XcdBarrier& b) {
    asm volatile("s_waitcnt vmcnt(0)" ::: "memory");
    __syncthreads();
    if (threadIdx.x == 0) {
        unsigned* bar = b.bar;
        __builtin_amdgcn_s_waitcnt(0);
        unsigned nloc = b.st[0], nx = b.st[1];
        if (nloc == 0u) { xcd_barrier_complete(bar, b.x, nloc, nx); b.st[0] = nloc; b.st[1] = nx; }
        const unsigned old = xb_add(&bar[XB_XSUB(b.x)], 1u);
        const unsigned gen = old / nloc;
        if (old + 1u == (gen + 1u) * nloc) {
            __builtin_amdgcn_fence(__ATOMIC_RELEASE, "agent");
            asm volatile("s_waitcnt vmcnt(0)" ::: "memory");
            const unsigned og = xb_add(&bar[XB_TOP], 1u);
            const unsigned tg = og / nx;
#if FAST_BAR
            if (og + 1u == (tg + 1u) * nx) { _Pragma("clang loop unroll(disable)") for (unsigned j = 0; j < 16u; ++j) (void)__hip_atomic_fetch_add(&bar[XB_XGEN(j)], 1u, __ATOMIC_RELAXED, __HIP_MEMORY_SCOPE_AGENT); }
            else XB_SPIN(xb_ld(&bar[XB_XGEN(b.x)]) == gen, bar);
            __builtin_amdgcn_fence(__ATOMIC_ACQUIRE, "agent");
#else
            if (og + 1u == (tg + 1u) * nx) xb_add(&bar[XB_TOPGEN], 1u);
            else XB_SPIN(xb_ld(&bar[XB_TOPGEN]) == tg, bar);
            __builtin_amdgcn_fence(__ATOMIC_ACQUIRE, "agent");
            xb_add(&bar[XB_XGEN(b.x)], 1u);
            asm volatile("s_waitcnt vmcnt(0)" ::: "memory");
#endif
        } else {
            XB_SPIN(xb_ld(&bar[XB_XGEN(b.x)]) == gen, bar);
            __builtin_amdgcn_fence(__ATOMIC_ACQUIRE, "agent");
            asm volatile("s_waitcnt vmcnt(0)" ::: "memory");
        }
    }
    __syncthreads();
}

struct Args { const float* in[36]; float* out; unsigned char* ws; };
enum { I_X = 0, I_MEM, I_ATTN_G, I_WIN, I_BGATE, I_DAQG, I_DAKG, I_LQ1, I_LK1, I_LQ2, I_LK2, I_SUBG, I_CONVW, I_CONVB, I_WQ, I_WK, I_WV, I_WIF, I_BIF, I_MLNG, I_SKIP,
       I_MEMG, I_CAWKV, I_CAQG, I_CAKG, I_WBDA, I_WBML, I_WBCA, I_WOUT, I_FFNG, I_RW, I_RB, I_WGU, I_BGU, I_WD, I_BD };

struct Frame {
    LAS unsigned char* lds; int tid, lane, wave, bid, G;
    const Args* a; unsigned char* ws;
};
#define WSP(type, off) ((type*)(F.ws + (off)))

__device__ __forceinline__ void transpose64(const float* W, int N, int K, int k0, int n0, bfu* dst, int drow0, LAS float* scr, int lane, int drow1 = -1) {
    f32x4 v[16];
#pragma unroll
    for (int i = 0; i < 16; ++i) v[i] = *(const GAS f32x4*)(W + (size_t)(k0 + 4 * i + (lane >> 4)) * N + n0 + 4 * (lane & 15));
#pragma unroll
    for (int i = 0; i < 16; ++i) { LAS float* d = scr + (4 * i + (lane >> 4)) * 65 + 4 * (lane & 15); d[0] = v[i].x; d[1] = v[i].y; d[2] = v[i].z; d[3] = v[i].w; }
    LDS_WAIT(); asm volatile("" ::: "memory");
    const int c = lane & 7;
#pragma unroll
    for (int j = 0; j < 8; ++j) { const int n = (lane >> 3) + 8 * j; const LAS float* sp = scr + (8 * c) * 65 + n;
        v4u o; o.x = pk2(sp[0 * 65], sp[1 * 65]); o.y = pk2(sp[2 * 65], sp[3 * 65]); o.z = pk2(sp[4 * 65], sp[5 * 65]); o.w = pk2(sp[6 * 65], sp[7 * 65]);
        const int orow = (drow1 >= 0 && n >= 32) ? drow1 + n - 32 : drow0 + n;
        *(GAS v4u*)(dst + (size_t)orow * K + k0 + 8 * c) = o; }
    LDS_WAIT(); asm volatile("" ::: "memory");
}
__device__ __forceinline__ float clamp448(float x) { return fminf(fmaxf(x, -448.f), 448.f); }
__device__ __forceinline__ unsigned pk4fp8(float a, float b, float c, float d) { int w = __builtin_amdgcn_cvt_pk_fp8_f32(clamp448(a), clamp448(b), 0, false); w = __builtin_amdgcn_cvt_pk_fp8_f32(clamp448(c), clamp448(d), w, true); return (unsigned)w; }
#ifndef MIXQ
#define MIXQ 0
#endif
__device__ __forceinline__ float rt8(float x) { const int w = __builtin_amdgcn_cvt_pk_fp8_f32(clamp448(16.f * x), 0.f, 0, false); return __builtin_amdgcn_cvt_f32_fp8(w, 0) * (1.f / 16.f); }
__device__ __forceinline__ void transpose64_fp8(const float* W, int N, int K, int k0, int n0, unsigned char* dst, int drow0, LAS float* scr, int lane) {
    f32x4 v[16];
#pragma unroll
    for (int i = 0; i < 16; ++i) v[i] = *(const GAS f32x4*)(W + (size_t)(k0 + 4 * i + (lane >> 4)) * N + n0 + 4 * (lane & 15));
#pragma unroll
    for (int i = 0; i < 16; ++i) { LAS float* d = scr + (4 * i + (lane >> 4)) * 65 + 4 * (lane & 15); d[0] = v[i].x; d[1] = v[i].y; d[2] = v[i].z; d[3] = v[i].w; }
    LDS_WAIT(); asm volatile("" ::: "memory");
    const int c = lane & 7;
#pragma unroll
    for (int j = 0; j < 8; ++j) { const int n = (lane >> 3) + 8 * j; const LAS float* sp = scr + (8 * c) * 65 + n;
        v2u o; o.x = pk4fp8(64.f * sp[0 * 65], 64.f * sp[1 * 65], 64.f * sp[2 * 65], 64.f * sp[3 * 65]); o.y = pk4fp8(64.f * sp[4 * 65], 64.f * sp[5 * 65], 64.f * sp[6 * 65], 64.f * sp[7 * 65]);
        *(GAS v2u*)(dst + (size_t)(drow0 + n) * K + k0 + 8 * c) = o; }
    LDS_WAIT(); asm volatile("" ::: "memory");
}
__device__ __forceinline__ void transpose_plain(const float* W, int K, int N, bfu* WT, int item, LAS float* scr, int lane) {
    const int nblk = N / 64, kb = item / nblk, nb = item % nblk;
    transpose64(W, N, K, 64 * kb, 64 * nb, WT, 64 * nb, scr, lane);
}
__device__ __forceinline__ void rms_rows2_to_bf16(const float* xrow, const float* g, bfu* orow, int lane) {
    const GAS f32x4* gr = (const GAS f32x4*)g + lane;
    f32x4 v[2][4]; float s[2] = {0.f, 0.f};
#pragma unroll
    for (int r = 0; r < 2; ++r)
#pragma unroll
        for (int j = 0; j < 4; ++j) v[r][j] = ((const GAS f32x4*)(xrow + (size_t)r * 1024) + lane)[64 * j];
#pragma unroll
    for (int r = 0; r < 2; ++r)
#pragma unroll
        for (int j = 0; j < 4; ++j) s[r] += (v[r][j].x * v[r][j].x + v[r][j].y * v[r][j].y) + (v[r][j].z * v[r][j].z + v[r][j].w * v[r][j].w);
#pragma unroll
    for (int o = 1; o < 64; o <<= 1) { s[0] += __shfl_xor(s[0], o); s[1] += __shfl_xor(s[1], o); }
#pragma unroll
    for (int r = 0; r < 2; ++r) { const float rstd = 1.f / sqrtf(s[r] * (1.f / 1024.f) + NORM_EPS); GAS v2u* o8 = (GAS v2u*)(orow + (size_t)r * 1024) + lane;
#pragma unroll
        for (int j = 0; j < 4; ++j) { const f32x4 gg = gr[64 * j]; v2u w; w.x = pk2(v[r][j].x * rstd * gg.x, v[r][j].y * rstd * gg.y); w.y = pk2(v[r][j].z * rstd * gg.z, v[r][j].w * rstd * gg.w); o8[64 * j] = w; } }
}

__device__ __forceinline__ void p0_prologue(Frame& F) {
    const Args& A = *F.a;
    LAS float* scr = (LAS float*)(F.lds + F.wave * 16640);
    const int gw = F.bid * NWAVES + F.wave, NGW = F.G * NWAVES;
    constexpr int I0 = 16 * 176, I1 = 16 * 32, I2 = 16 * 16, I3 = 32 * 16, I4 = 16 * 16, I5 = 16 * 16;
    constexpr int NITEMS = I0 + I1 + I2 + I3 + I4 + I5;
    for (int it = gw; it < NITEMS; it += NGW) {
        int r = it;
        if (r < I0) {
            if constexpr (KNORM_FOLD) { const int kb = r / 176, nb = r % 176;
                if (nb >= 16 && nb < 32) { const int tb = (64 * nb) & ~255, hh = nb & 3;
                    transpose64(A.in[I_WIN], 11264, 1024, 64 * kb, 64 * nb, WSP(bfu, WS_WINT), tb + 32 * hh, scr, F.lane, tb + 128 + 32 * hh); continue; } }
            transpose_plain(A.in[I_WIN], 1024, 11264, WSP(bfu, WS_WINT), r, scr, F.lane); continue; } r -= I0;
        if (r < I1) { transpose_plain(A.in[I_CAWKV], 1024, 2048, WSP(bfu, WS_CAKVT), r, scr, F.lane); continue; } r -= I1;
        if (r < I2) { transpose_plain(A.in[I_WBDA], 1024, 1024, WSP(bfu, WS_WBDAT), r, scr, F.lane); continue; } r -= I2;
        if (r < I3) { transpose_plain(A.in[I_WBML], 2048, 1024, WSP(bfu, WS_WBMLT), r, scr, F.lane); continue; } r -= I3;
        if (r < I4) { transpose_plain(A.in[I_WBCA], 1024, 1024, WSP(bfu, WS_WBCAT), r, scr, F.lane); continue; } r -= I4;
        transpose_plain(A.in[I_WOUT], 1024, 1024, WSP(bfu, WS_WOUTT), r, scr, F.lane);
    }
    for (int m = 2 * gw; m < T; m += 2 * NGW) rms_rows2_to_bf16(A.in[I_X] + (size_t)m * DM, A.in[I_ATTN_G], WSP(bfu, WS_XN) + (size_t)m * DM, F.lane);
    for (int m = 2 * gw; m < NB * 256; m += 2 * NGW) rms_rows2_to_bf16(A.in[I_MEM] + (size_t)m * DM, A.in[I_MEMG], WSP(bfu, SM_MEMN) + (size_t)m * DM, F.lane);
    const int gt = F.bid * NTHR + F.tid, NGT = F.G * NTHR;
    for (int idx = gt; idx < 2048 * 8; idx += NGT) {
        const int c = idx >> 3, g = idx & 7, blk = c >> 2, i = c & 3; const float* wif = A.in[I_WIF];
        float uq = 0.f, uv = 0.f;
#pragma unroll
        for (int o = 0; o < 4; ++o) {
            uq += A.in[I_WQ][blk * 16 + i * 4 + o] * wif[(size_t)(blk * 4 + o) * 8 + g] + A.in[I_WK][blk * 16 + i * 4 + o] * wif[(size_t)(2048 + blk * 4 + o) * 8 + g];
            uv += A.in[I_WV][blk * 16 + i * 4 + o] * wif[(size_t)(4096 + blk * 4 + o) * 8 + g]; }
        WSP(float, SM_UQK)[idx] = uq; WSP(float, SM_UV)[idx] = uv;
    }
    for (int idx = gt; idx < SEQ * 32; idx += NGT) {
        const int t = idx >> 5, i = idx & 31;
        double pw = 1.0; for (int q = 0; q < i; ++q) pw *= 0.7498942093324559;
        const float inv = (float)pw;
        const float ang = (float)t * inv;
        const float n = rintf(ang * 0.15915494309189535f);
        float r = fmaf(n, -6.28125f, ang); r = fmaf(n, -1.9353071795864769e-3f, r);
        const float rev = r * 0.15915494309189535f;
        WSP(float, SM_ROPEC)[idx] = __builtin_amdgcn_cosf(rev); WSP(float, SM_ROPES)[idx] = __builtin_amdgcn_sinf(rev);
        if (t == 0) WSP(float, SM_INVF)[i] = inv;
    }
    if (gt == 0) {
        float s1 = 0.f, s2 = 0.f;
        for (int i = 0; i < 64; ++i) { s1 += A.in[I_LQ1][i] * A.in[I_LK1][i]; s2 += A.in[I_LQ2][i] * A.in[I_LK2][i]; }
        WSP(float, SM_LAM)[0] = fexp(s1) - fexp(s2) + LAMBDA_INIT;
    }
}

__device__ __forceinline__ void ld4bf(const bfu* p, float (&v)[4]) { const v2u w = *(const GAS v2u*)p; v[0] = bflo(w.x); v[1] = bfhi(w.x); v[2] = bflo(w.y); v[3] = bfhi(w.y); }
__device__ __forceinline__ void ld8bf(const bfu* p, float (&v)[8]) { const v4u w = *(const GAS v4u*)p; v[0] = bflo(w.x); v[1] = bfhi(w.x); v[2] = bflo(w.y); v[3] = bfhi(w.y); v[4] = bflo(w.z); v[5] = bfhi(w.z); v[6] = bflo(w.w); v[7] = bfhi(w.w); }
__device__ __forceinline__ void unpk8(const v4u w, float (&v)[8]) { v[0] = bflo(w.x); v[1] = bfhi(w.x); v[2] = bflo(w.y); v[3] = bfhi(w.y); v[4] = bflo(w.z); v[5] = bfhi(w.z); v[6] = bflo(w.w); v[7] = bfhi(w.w); }
__device__ __forceinline__ v4u pk8(const float (&v)[8]) { v4u o; o.x = pk2(v[0], v[1]); o.y = pk2(v[2], v[3]); o.z = pk2(v[4], v[5]); o.w = pk2(v[6], v[7]); return o; }

#define TRSTEP(arr, N, BIT, lane_) _Pragma("unroll") for (int e_ = 0; e_ < (N); ++e_) { const bool up_ = ((lane_) >> (BIT)) & 1; const float keep_ = up_ ? arr[(N) + e_] : arr[e_], send_ = up_ ? arr[e_] : arr[(N) + e_]; arr[e_] = keep_ + __shfl_xor(send_, 1 << (BIT)); }
__device__ __forceinline__ void p2_gates(Frame& F) {
    const Args& A = *F.a; const bfu* MLX = WSP(bfu, WS_MLX);
    const int c0 = 4 * F.tid;
    float cw[4][4], cb[4], uq[4][8], uv[4][8];
#pragma unroll
    for (int j = 0; j < 4; ++j)
#pragma unroll
        for (int i = 0; i < 4; ++i) cw[j][i] = A.in[I_CONVW][j * 2048 + c0 + i];
#pragma unroll
    for (int i = 0; i < 4; ++i) { cb[i] = A.in[I_CONVB][c0 + i];
#pragma unroll
        for (int g = 0; g < 8; ++g) { uq[i][g] = WSP(float, SM_UQK)[(c0 + i) * 8 + g]; uv[i][g] = WSP(float, SM_UV)[(c0 + i) * 8 + g]; } }
    LAS float* red = (LAS float*)F.lds;
    for (int tile = F.bid; tile < T / 128; tile += F.G) {
        const int m0 = tile * 128;
        float xw[3][4];
#pragma unroll
        for (int j = 0; j < 3; ++j) { if ((m0 & (SEQ - 1)) == 0) { xw[j][0] = xw[j][1] = xw[j][2] = xw[j][3] = 0.f; } else ld4bf(MLX + (size_t)(m0 - 3 + j) * 2048 + c0, xw[j]); }
        for (int t8 = 0; t8 < 16; ++t8) {
            v2u raw[8];
#pragma unroll
            for (int tt = 0; tt < 8; ++tt) raw[tt] = *(const GAS v2u*)(MLX + (size_t)(m0 + t8 * 8 + tt) * 2048 + c0);
            float pg[64];
#pragma unroll
            for (int tt = 0; tt < 8; ++tt) {
                const float xm[4] = {bflo(raw[tt].x), bfhi(raw[tt].x), bflo(raw[tt].y), bfhi(raw[tt].y)};
#pragma unroll
                for (int g = 0; g < 8; ++g) pg[tt * 8 + g] = 0.f;
#pragma unroll
                for (int i = 0; i < 4; ++i) {
                    const float y = cb[i] + cw[0][i] * xw[0][i] + cw[1][i] * xw[1][i] + cw[2][i] * xw[2][i] + cw[3][i] * xm[i];
                    const float xc = fsilu(y);
#pragma unroll
                    for (int g = 0; g < 8; ++g) pg[tt * 8 + g] += xc * uq[i][g] + xm[i] * uv[i][g];
                    xw[0][i] = xw[1][i]; xw[1][i] = xw[2][i]; xw[2][i] = xm[i];
                }
            }
            TRSTEP(pg, 32, 5, F.lane) TRSTEP(pg, 16, 4, F.lane) TRSTEP(pg, 8, 3, F.lane) TRSTEP(pg, 4, 2, F.lane) TRSTEP(pg, 2, 1, F.lane) TRSTEP(pg, 1, 0, F.lane)
            red[((t8 * 8 + (F.lane >> 3)) * 8 + F.wave) * 8 + (F.lane & 7)] = pg[0];
        }
        __syncthreads();
        for (int idx = F.tid; idx < 1024; idx += NTHR) {
            const int t = idx >> 3, g = idx & 7; float s = A.in[I_BIF][g];
#pragma unroll
            for (int w = 0; w < 8; ++w) s += red[(t * 8 + w) * 8 + g];
            const int m = m0 + t, b = m >> 13, ts = m & (SEQ - 1);
            if (g < 4) WSP(float, SM_IPRE)[((b * 4 + g) << 13) + ts] = s; else WSP(float, SM_FPRE)[((b * 4 + g - 4) << 13) + ts] = s;
        }
        __syncthreads();
    }
}

__device__ __forceinline__ void p3_scan(Frame& F) {
    LAS float* wt = (LAS float*)F.lds;
    for (int bh = F.bid; bh < 16; bh += F.G) {
        const int base = bh * SEQ + 16 * F.tid;
        float fv[16], iv[16];
#pragma unroll
        for (int q = 0; q < 4; ++q) { const f32x4 a = *(const GAS f32x4*)(WSP(float, SM_FPRE) + base + 4 * q); fv[4 * q] = a.x; fv[4 * q + 1] = a.y; fv[4 * q + 2] = a.z; fv[4 * q + 3] = a.w;
            const f32x4 c = *(const GAS f32x4*)(WSP(float, SM_IPRE) + base + 4 * q); iv[4 * q] = c.x; iv[4 * q + 1] = c.y; iv[4 * q + 2] = c.z; iv[4 * q + 3] = c.w; }
        float run = 0.f;
#pragma unroll
        for (int k = 0; k < 16; ++k) { const float x = fv[k]; const float ls = fminf(x, 0.f) - __logf(1.f + fexp(-fabsf(x))); run += ls; fv[k] = run; }
        float incl = run;
#pragma unroll
        for (int o = 1; o < 64; o <<= 1) { const float v = __shfl_up(incl, o); if (F.lane >= o) incl += v; }
        if (F.lane == 63) wt[F.wave] = incl;
        __syncthreads();
        float off = incl - run;
        for (int w = 0; w < F.wave; ++w) off += wt[w];
        float rm = -INFINITY;
#pragma unroll
        for (int k = 0; k < 16; ++k) { fv[k] += off; iv[k] -= fv[k]; rm = fmaxf(rm, iv[k]); }
        float im = rm;
#pragma unroll
        for (int o = 1; o < 64; o <<= 1) { const float v = __shfl_up(im, o); if (F.lane >= o) im = fmaxf(im, v); }
        if (F.lane == 63) wt[8 + F.wave] = im;
        __syncthreads();
        float pm = __shfl_up(im, 1); if (F.lane == 0) pm = -INFINITY;
        for (int w = 0; w < F.wave; ++w) pm = fmaxf(pm, wt[8 + w]);
        float gg[16], mm[16]; float cm = pm;
#pragma unroll
        for (int k = 0; k < 16; ++k) { cm = fmaxf(cm, iv[k]); gg[k] = cm; mm[k] = fv[k] + cm; }
#pragma unroll
        for (int q = 0; q < 4; ++q) {
            *(GAS f32x4*)(WSP(float, SM_AA) + base + 4 * q) = (f32x4){iv[4 * q], iv[4 * q + 1], iv[4 * q + 2], iv[4 * q + 3]};
            *(GAS f32x4*)(WSP(float, SM_GG) + base + 4 * q) = (f32x4){gg[4 * q], gg[4 * q + 1], gg[4 * q + 2], gg[4 * q + 3]};
            *(GAS f32x4*)(WSP(float, SM_MM) + base + 4 * q) = (f32x4){mm[4 * q], mm[4 * q + 1], mm[4 * q + 2], mm[4 * q + 3]}; }
        __syncthreads();
    }
}

__device__ __forceinline__ void p4_materialise(Frame& F) {
    const Args& A = *F.a; const bfu* MLX = WSP(bfu, WS_MLX);
    bfu* QN_ = WSP(bfu, WS_QNAT); bfu* KN_ = WSP(bfu, WS_KNAT); bfu* KT = WSP(bfu, WS_KT); bfu* VT = WSP(bfu, WS_VT);
    LAS unsigned char* kt_l = F.lds;
    LAS unsigned char* vt_l = F.lds + 64 * 1040;
    LAS float* red = (LAS float*)(F.lds + 2 * 64 * 1040);
    const int bl = F.tid & 15, seg = F.tid >> 4;
    for (int unit = F.bid; unit < 2048; unit += F.G) {
        const int b = unit >> 9, j = (unit >> 5) & 15, cg = unit & 31, h = cg >> 3, bh = b * 4 + h;
        const int c0 = cg * 64 + 4 * bl, d00 = (cg & 7) * 64, blk = c0 >> 2;
        float cw[4][4], cb[4], wq[4][4], wk[4][4], wv[4][4];
#pragma unroll
        for (int jj = 0; jj < 4; ++jj)
#pragma unroll
            for (int i = 0; i < 4; ++i) { cw[jj][i] = A.in[I_CONVW][jj * 2048 + c0 + i]; wq[jj][i] = A.in[I_WQ][blk * 16 + jj * 4 + i]; wk[jj][i] = A.in[I_WK][blk * 16 + jj * 4 + i] * 0.044194173824159216f; wv[jj][i] = A.in[I_WV][blk * 16 + jj * 4 + i]; }
#pragma unroll
        for (int i = 0; i < 4; ++i) cb[i] = A.in[I_CONVB][c0 + i];
        const float Gend = WSP(float, SM_GG)[bh * SEQ + 512 * j + 511];
        const int tl0 = 16 * seg, ts0 = 512 * j + tl0; const size_t mrow0 = (size_t)b * SEQ + ts0;
        v2u raw[19];
#pragma unroll
        for (int q = 0; q < 19; ++q) { if (q < 3 && ts0 == 0) raw[q] = (v2u){0u, 0u}; else raw[q] = *(const GAS v2u*)(MLX + (mrow0 - 3 + q) * 2048 + c0); }
        float aw[16];
#pragma unroll
        for (int q = 0; q < 4; ++q) { const f32x4 a = *(const GAS f32x4*)(WSP(float, SM_AA) + bh * SEQ + ts0 + 4 * q); aw[4 * q] = a.x; aw[4 * q + 1] = a.y; aw[4 * q + 2] = a.z; aw[4 * q + 3] = a.w; }
        float dn[4] = {0.f, 0.f, 0.f, 0.f};
#pragma unroll
        for (int t8 = 0; t8 < 2; ++t8) {
            float kT[4][8], vT[4][8];
#pragma unroll
            for (int tt = 0; tt < 8; ++tt) {
                const int tq = t8 * 8 + tt; const size_t m = mrow0 + tq;
                float xc[4], xm[4] = {bflo(raw[tq + 3].x), bfhi(raw[tq + 3].x), bflo(raw[tq + 3].y), bfhi(raw[tq + 3].y)};
#pragma unroll
                for (int i = 0; i < 4; ++i) {
                    const float x0 = (i & 1) ? bfhi(i < 2 ? raw[tq].x : raw[tq].y) : bflo(i < 2 ? raw[tq].x : raw[tq].y);
                    const float x1 = (i & 1) ? bfhi(i < 2 ? raw[tq + 1].x : raw[tq + 1].y) : bflo(i < 2 ? raw[tq + 1].x : raw[tq + 1].y);
                    const float x2 = (i & 1) ? bfhi(i < 2 ? raw[tq + 2].x : raw[tq + 2].y) : bflo(i < 2 ? raw[tq + 2].x : raw[tq + 2].y);
                    const float y = cb[i] + cw[0][i] * x0 + cw[1][i] * x1 + cw[2][i] * x2 + cw[3][i] * xm[i]; xc[i] = fsilu(y); }
                const float w = fexp(aw[tq] - Gend);
                float q[4], k[4];
#pragma unroll
                for (int o = 0; o < 4; ++o) {
                    q[o] = xc[0] * wq[0][o] + xc[1] * wq[1][o] + xc[2] * wq[2][o] + xc[3] * wq[3][o];
                    k[o] = xc[0] * wk[0][o] + xc[1] * wk[1][o] + xc[2] * wk[2][o] + xc[3] * wk[3][o];
                    vT[o][tt] = xm[0] * wv[0][o] + xm[1] * wv[1][o] + xm[2] * wv[2][o] + xm[3] * wv[3][o];
                    kT[o][tt] = w * k[o]; dn[o] += w * k[o]; }
                v2u qo, ko; qo.x = pk2(q[0], q[1]); qo.y = pk2(q[2], q[3]); ko.x = pk2(k[0], k[1]); ko.y = pk2(k[2], k[3]);
                *(GAS v2u*)(QN_ + m * 2048 + c0) = qo; *(GAS v2u*)(KN_ + m * 2048 + c0) = ko;
            }
#pragma unroll
            for (int o = 0; o < 4; ++o) { const int lo = (4 * bl + o) * 1040 + (tl0 + t8 * 8) * 2;
                *(LAS v4u*)(kt_l + lo) = pk8(kT[o]); *(LAS v4u*)(vt_l + lo) = pk8(vT[o]); }
        }
#pragma unroll
        for (int o = 0; o < 4; ++o) { dn[o] += __shfl_xor(dn[o], 16); dn[o] += __shfl_xor(dn[o], 32); if (F.lane < 16) red[F.wave * 64 + 4 * bl + o] = dn[o]; }
        __syncthreads();
#pragma unroll
        for (int r = 0; r < 8; ++r) { const int ch = F.wave * 8 + r; const size_t off = ((size_t)(bh * 512 + d00 + ch)) * LDT + 512 * j + 8 * F.lane;
            *(GAS v4u*)(KT + off) = *(const LAS v4u*)(kt_l + ch * 1040 + 16 * F.lane); *(GAS v4u*)(VT + off) = *(const LAS v4u*)(vt_l + ch * 1040 + 16 * F.lane); }
        if (F.tid < 64) { float sum = 0.f;
#pragma unroll
            for (int w = 0; w < 8; ++w) sum += red[w * 64 + F.tid];
            WSP(float, SM_DN)[(bh * 16 + j) * 512 + d00 + F.tid] = sum; }
        __syncthreads();
    }
}

__device__ __forceinline__ void p6_scan_qn(Frame& F) {
    bfu* C = WSP(bfu, WS_C); const float* GG = WSP(float, SM_GG);
    const int gt = F.bid * NTHR + F.tid, NGT = F.G * NTHR;
    for (int g = gt; g < 16 * 32768; g += NGT) {
        const int bh = g >> 15; const size_t off = (size_t)(g & 32767) * 8;
        v4u tmp[15];
#pragma unroll
        for (int j = 0; j < 15; ++j) tmp[j] = *(const GAS v4u*)(C + ((size_t)(bh * 16 + j) << 18) + off);
        float cur[8];
#pragma unroll
        for (int e = 0; e < 8; ++e) cur[e] = 0.f;
#pragma unroll
        for (int j = 0; j < 16; ++j) {
            *(GAS v4u*)(C + ((size_t)(bh * 16 + j) << 18) + off) = pk8(cur);
            if (j < 15) {
                const float dec = (j == 0) ? 0.f : fexp(GG[bh * SEQ + 512 * j - 1] - GG[bh * SEQ + 512 * j + 511]);
                const v4u w = tmp[j];
                cur[0] = dec * cur[0] + bflo(w.x); cur[1] = dec * cur[1] + bfhi(w.x); cur[2] = dec * cur[2] + bflo(w.y); cur[3] = dec * cur[3] + bfhi(w.y);
                cur[4] = dec * cur[4] + bflo(w.z); cur[5] = dec * cur[5] + bfhi(w.z); cur[6] = dec * cur[6] + bflo(w.w); cur[7] = dec * cur[7] + bfhi(w.w);
            }
        }
    }
    LAS float* nj = (LAS float*)F.lds;
    const bfu* QN_ = WSP(bfu, WS_QNAT);
    for (int item = F.bid; item < 256; item += F.G) {
        const int bh = item >> 4, j = item & 15, b = bh >> 2, h = bh & 3;
        { float cur = 0.f; const int d = F.tid;
          for (int jj = 0; jj < j; ++jj) { const float dec = (jj == 0) ? 0.f : fexp(GG[bh * SEQ + 512 * jj - 1] - GG[bh * SEQ + 512 * jj + 511]); cur = dec * cur + WSP(float, SM_DN)[(bh * 16 + jj) * 512 + d]; }
          nj[d] = cur; }
        { const int tl = F.tid; const float* dp = WSP(float, WS_DENP) + (size_t)(bh * SEQ + 512 * j + tl) * 8;
          const f32x4 p0 = *(const GAS f32x4*)dp; float d = (p0.x + p0.y) + (p0.z + p0.w);
          if (tl >= 256) { const f32x4 p1 = *(const GAS f32x4*)(dp + 4); d += (p1.x + p1.y) + (p1.z + p1.w); }
          WSP(float, WS_DEN)[bh * SEQ + 512 * j + tl] = d; }
        __syncthreads();
        float nv[8];
#pragma unroll
        for (int e = 0; e < 8; ++e) nv[e] = nj[8 * F.lane + e];
        for (int r0 = F.wave * 64; r0 < F.wave * 64 + 64; r0 += 8) {
            v4u raw[8];
#pragma unroll
            for (int q = 0; q < 8; ++q) raw[q] = *(const GAS v4u*)(QN_ + ((size_t)b * SEQ + 512 * j + r0 + q) * 2048 + h * 512 + 8 * F.lane);
            float sv[8];
#pragma unroll
            for (int q = 0; q < 8; ++q) { float qv[8]; unpk8(raw[q], qv); float s = 0.f;
#pragma unroll
                for (int e = 0; e < 8; ++e) s += qv[e] * nv[e];
                sv[q] = s; }
            TRSTEP(sv, 4, 5, F.lane) TRSTEP(sv, 2, 4, F.lane) TRSTEP(sv, 1, 3, F.lane)
            float s = sv[0]; s += __shfl_xor(s, 1); s += __shfl_xor(s, 2); s += __shfl_xor(s, 4);
            if ((F.lane & 7) == 0) WSP(float, SM_QN)[bh * SEQ + 512 * j + r0 + ((((F.lane >> 5) & 1) << 2) | (((F.lane >> 4) & 1) << 1) | ((F.lane >> 3) & 1))] = s;
        }
        __syncthreads();
    }
}

#ifndef P9_ROWS
#define P9_ROWS 4
#endif
__device__ __forceinline__ void p9_mlout(Frame& F, bfu* DST) {
    constexpr int R = P9_ROWS;
    const Args& A = *F.a; const bfu* MLX = WSP(bfu, WS_MLX); const bfu* HH = WSP(bfu, WS_HH); const bfu* Z = (const bfu*)A.out;
    const int h = F.wave & 3, c0 = h * 512 + 8 * F.lane;
    float cw[4][8], cb[8], ng[8], sk[8];
#pragma unroll
    for (int e = 0; e < 8; ++e) { cb[e] = A.in[I_CONVB][c0 + e]; ng[e] = A.in[I_MLNG][c0 + e]; sk[e] = A.in[I_SKIP][c0 + e];
#pragma unroll
        for (int j = 0; j < 4; ++j) cw[j][e] = A.in[I_CONVW][j * 2048 + c0 + e]; }
    const int slot = F.bid * 2 + (F.wave >> 2), nslot = F.G * 2;
    for (int m0 = R * slot; m0 < T; m0 += R * nslot) {
        v4u rh[R], rz[R], rx[R + 3];
#pragma unroll
        for (int r = 0; r < R; ++r) { rh[r] = *(const GAS v4u*)(HH + (size_t)(m0 + r) * 2048 + c0); rz[r] = *(const GAS v4u*)(Z + (size_t)(m0 + r) * 2048 + c0); }
        const int ts0 = m0 & (SEQ - 1);
#pragma unroll
        for (int q = 0; q < R + 3; ++q) { if (ts0 - 3 + q >= 0) rx[q] = *(const GAS v4u*)(MLX + (size_t)(m0 - 3 + q) * 2048 + c0); else rx[q] = (v4u){0u, 0u, 0u, 0u}; }
        float y[R][8];
#pragma unroll
        for (int r = 0; r < R; ++r)
#pragma unroll
            for (int e = 0; e < 8; ++e) y[r][e] = cb[e];
#pragma unroll
        for (int q = 0; q < R + 3; ++q) { float xq[8]; unpk8(rx[q], xq);
#pragma unroll
            for (int r = 0; r < R; ++r) { if (q - r >= 0 && q - r <= 3) {
#pragma unroll
                for (int e = 0; e < 8; ++e) y[r][e] += cw[q - r][e] * xq[e]; } } }
        float hv[R][8], s[R], qq[R];
#pragma unroll
        for (int r = 0; r < R; ++r) { unpk8(rh[r], hv[r]); s[r] = 0.f;
#pragma unroll
            for (int e = 0; e < 8; ++e) s[r] += hv[r][e]; }
#pragma unroll
        for (int o = 1; o < 64; o <<= 1) {
#pragma unroll
            for (int r = 0; r < R; ++r) s[r] += __shfl_xor(s[r], o); }
#pragma unroll
        for (int r = 0; r < R; ++r) { const float mu = s[r] * (1.f / 512.f); qq[r] = 0.f;
#pragma unroll
            for (int e = 0; e < 8; ++e) { hv[r][e] -= mu; qq[r] += hv[r][e] * hv[r][e]; } }
#pragma unroll
        for (int o = 1; o < 64; o <<= 1) {
#pragma unroll
            for (int r = 0; r < R; ++r) qq[r] += __shfl_xor(qq[r], o); }
#pragma unroll
        for (int r = 0; r < R; ++r) { const float rstd = 1.f / sqrtf(qq[r] * (1.f / 512.f) + NORM_EPS); float zv[8], o8[8]; unpk8(rz[r], zv);
#pragma unroll
            for (int e = 0; e < 8; ++e) o8[e] = (hv[r][e] * rstd * ng[e] + sk[e] * fsilu(y[r][e])) * fsilu(zv[e]);
            if constexpr (MIXQ) {
#pragma unroll
                for (int e = 0; e < 8; ++e) o8[e] = rt8(o8[e]); }
            *(GAS v4u*)(DST + (size_t)(m0 + r) * 2048 + c0) = pk8(o8); }
    }
}

__device__ __forceinline__ void qk_fin(bfu* row, const v4u r1, const v4u r2, const float* g, const float (&c)[8], const float (&sn)[8], float scale, int lane) {
    const int gi = lane >> 2, i0 = 8 * (lane & 3);
    float x1[8], x2[8]; unpk8(r1, x1); unpk8(r2, x2);
    float s = 0.f;
#pragma unroll
    for (int e = 0; e < 8; ++e) s += x1[e] * x1[e] + x2[e] * x2[e];
    s += __shfl_xor(s, 1); s += __shfl_xor(s, 2);
    const float rstd = scale / sqrtf(s * (1.f / 64.f) + NORM_EPS);
    float o1[8], o2[8];
#pragma unroll
    for (int e = 0; e < 8; ++e) { const float a = x1[e] * rstd * g[i0 + e], b = x2[e] * rstd * g[32 + i0 + e]; o1[e] = a * c[e] - b * sn[e]; o2[e] = b * c[e] + a * sn[e]; }
    *(GAS v4u*)(row + gi * 64 + i0) = pk8(o1); *(GAS v4u*)(row + gi * 64 + 32 + i0) = pk8(o2);
}
__device__ __forceinline__ void n256_fin(bfu* row, const v4u r1, const v4u r2, const float* g, float scale, int lane, const float* g2 = nullptr) {
    const int h = lane >> 4, i0 = 16 * (lane & 15);
    float x1[8], x2[8]; unpk8(r1, x1); unpk8(r2, x2);
    float s = 0.f;
#pragma unroll
    for (int e = 0; e < 8; ++e) s += x1[e] * x1[e] + x2[e] * x2[e];
    s += __shfl_xor(s, 1); s += __shfl_xor(s, 2); s += __shfl_xor(s, 4); s += __shfl_xor(s, 8);
    const float rstd = scale / sqrtf(s * (1.f / 256.f) + NORM_EPS);
#pragma unroll
    for (int e = 0; e < 8; ++e) { x1[e] *= rstd * g[i0 + e]; x2[e] *= rstd * g[i0 + 8 + e]; }
    if (g2) {
#pragma unroll
        for (int e = 0; e < 8; ++e) { x1[e] *= g2[i0 + e]; x2[e] *= g2[i0 + 8 + e]; } }
    *(GAS v4u*)(row + h * 256 + i0) = pk8(x1); *(GAS v4u*)(row + h * 256 + i0 + 8) = pk8(x2);
}
__device__ __forceinline__ void p11_norms(Frame& F, size_t dofs) {
    const Args& A = *F.a;
    const int gw = F.bid * NWAVES + F.wave, NGW = F.G * NWAVES;
    { const int gi = F.lane >> 2, i0 = 8 * (F.lane & 3), hc = F.lane >> 4, j0 = 16 * (F.lane & 15);
      if constexpr (!(KNORM_FOLD && !KNORM_EPI_OFF && CAQ_FOLD && QNORM_IN_ATTN)) for (int m = gw; m < T; m += NGW) {
        const int ts = m & (SEQ - 1);
        bfu* qr = WSP(bfu, WS_DAQ) + (size_t)m * DM; bfu* kr = WSP(bfu, WS_DAK) + (size_t)m * DM; bfu* cr = WSP(bfu, WS_CAQ) + (size_t)m * DM;
        v4u q1 = {0u, 0u, 0u, 0u}, q2 = q1; if constexpr (!QNORM_IN_ATTN) { q1 = *(const GAS v4u*)(qr + gi * 64 + i0); q2 = *(const GAS v4u*)(qr + gi * 64 + 32 + i0); }
        const v4u k1 = *(const GAS v4u*)(kr + gi * 64 + i0), k2 = *(const GAS v4u*)(kr + gi * 64 + 32 + i0);
        v4u c1 = {0u, 0u, 0u, 0u}, c2 = c1; if constexpr (!CAQ_FOLD) { c1 = *(const GAS v4u*)(cr + hc * 256 + j0); c2 = *(const GAS v4u*)(cr + hc * 256 + j0 + 8); }
        const f32x4 ca = *(const GAS f32x4*)(WSP(float, SM_ROPEC) + ts * 32 + i0), cb = *(const GAS f32x4*)(WSP(float, SM_ROPEC) + ts * 32 + i0 + 4), sa = *(const GAS f32x4*)(WSP(float, SM_ROPES) + ts * 32 + i0), sb = *(const GAS f32x4*)(WSP(float, SM_ROPES) + ts * 32 + i0 + 4);
        const float cc[8] = {ca.x, ca.y, ca.z, ca.w, cb.x, cb.y, cb.z, cb.w}, ss[8] = {sa.x, sa.y, sa.z, sa.w, sb.x, sb.y, sb.z, sb.w};
        if constexpr (!QNORM_IN_ATTN) qk_fin((bfu*)((char*)qr + dofs), q1, q2, A.in[I_DAQG], cc, ss, 0.125f * 1.4426950408889634f, F.lane);
        if constexpr (!KNORM_FOLD || KNORM_EPI_OFF) qk_fin((bfu*)((char*)kr + dofs), k1, k2, A.in[I_DAKG], cc, ss, 1.f, F.lane);
        if constexpr (!CAQ_FOLD) n256_fin(dofs ? (bfu*)((char*)qr + dofs) : cr, c1, c2, A.in[I_CAQG], 0.0625f, F.lane);
      }
      if (dofs == 0) for (int m = gw; m < NB * 256; m += NGW) { bfu* cr = WSP(bfu, SM_KCA) + (size_t)m * DM; const v4u c1 = *(const GAS v4u*)(cr + hc * 256 + j0), c2 = *(const GAS v4u*)(cr + hc * 256 + j0 + 8); n256_fin(cr, c1, c2, A.in[I_CAKG], 1.f, F.lane, CAQ_FOLD ? A.in[I_CAQG] : nullptr); } }
    const int gt = F.bid * NTHR + F.tid, NGT = F.G * NTHR;
    for (int i = gt; i < NSLOT_MAX; i += NGT) WSP(int, SM_TOK)[i] = -1;
}

__device__ __forceinline__ void gate8_convert(Frame& F) {
    const Args& A = *F.a; const int gw = F.bid * NWAVES + F.wave, NGW = F.G * NWAVES;
    for (int m0 = 2 * gw; m0 < T; m0 += 2 * NGW) {
        v4u a[2], b[2];
#pragma unroll
        for (int r = 0; r < 2; ++r) { const GAS v4u* src = (const GAS v4u*)(WSP(bfu, WS_XN) + (size_t)(m0 + r) * DM) + 2 * F.lane; a[r] = src[0]; b[r] = src[1]; }
#pragma unroll
        for (int r = 0; r < 2; ++r) { float x[8], y[8]; unpk8(a[r], x); unpk8(b[r], y);
            v4u o; o.x = pk4fp8(16.f * x[0], 16.f * x[1], 16.f * x[2], 16.f * x[3]); o.y = pk4fp8(16.f * x[4], 16.f * x[5], 16.f * x[6], 16.f * x[7]); o.z = pk4fp8(16.f * y[0], 16.f * y[1], 16.f * y[2], 16.f * y[3]); o.w = pk4fp8(16.f * y[4], 16.f * y[5], 16.f * y[6], 16.f * y[7]);
            *((GAS v4u*)(WSP(unsigned char, WS_XN8) + (size_t)(m0 + r) * DM) + F.lane) = o; } }
    LAS float* scr = (LAS float*)(F.lds + F.wave * 16640);
    for (int it = gw; it < 16 * 48; it += NGW) { const int kb = it / 48, nb = it % 48;
        transpose64_fp8(A.in[I_WIN], 11264, 1024, 64 * kb, 8192 + 64 * nb, WSP(unsigned char, WS_WG8), 64 * nb, scr, F.lane); }
}
__device__ __forceinline__ void moe_convert(Frame& F) {
    const Args& A = *F.a; const int gw = F.bid * NWAVES + F.wave, NGW = F.G * NWAVES;
    LAS float* scr = (LAS float*)(F.lds + F.wave * 16640);
    constexpr int IGU = 16 * 32, IDN = 16 * 16;
    for (int it = gw; it < 32 * (IGU + IDN); it += NGW) {
        if (it < 32 * IGU) { const int e = it / IGU, r = it % IGU, kb = r / 32, nb = r % 32, n0 = 64 * nb;
            const int jf = n0 & 1023, drow0 = 256 * (jf >> 7) + (n0 >= 1024 ? 128 : 0) + (jf & 127);
            transpose64_fp8(A.in[I_WGU] + (size_t)e * 1024 * 2048, 2048, 1024, 64 * kb, n0, WSP(unsigned char, WS_WGUT) + (size_t)e * 2048 * 1024, drow0, scr, F.lane);
        } else { const int q = it - 32 * IGU, e = q / IDN, r = q % IDN;
            transpose64_fp8(A.in[I_WD] + (size_t)e * 1024 * 1024, 1024, 1024, 64 * (r / 16), 64 * (r % 16), WSP(unsigned char, WS_WDT) + (size_t)e * 1024 * 1024, 64 * (r % 16), scr, F.lane); }
    }
}

__device__ __forceinline__ void p13_dacombine(Frame& F) {
    const Args& A = *F.a; const bfu* O = WSP(bfu, WS_O); bfu* Y = WSP(bfu, WS_DAQ);
    const float lam = WSP(float, SM_LAM)[0];
    const int gw = F.bid * NWAVES + F.wave, NGW = F.G * NWAVES;
    const int h = F.lane >> 3, dv0 = 16 * (F.lane & 7);
    float sg[16];
#pragma unroll
    for (int e = 0; e < 16; ++e) sg[e] = A.in[I_SUBG][dv0 + e] * (1.f - LAMBDA_INIT);
    for (int m0 = 2 * gw; m0 < T; m0 += 2 * NGW) {
        v4u ra[2][4];
#pragma unroll
        for (int r = 0; r < 2; ++r) { const bfu* o0 = O + (size_t)(m0 + r) * 2048 + h * 256 + dv0; ra[r][0] = *(const GAS v4u*)o0; ra[r][1] = *(const GAS v4u*)(o0 + 8); ra[r][2] = *(const GAS v4u*)(o0 + 128); ra[r][3] = *(const GAS v4u*)(o0 + 136); }
#pragma unroll
        for (int r = 0; r < 2; ++r) { const int m = m0 + r;
            float a0[8], a1[8], b0[8], b1[8]; unpk8(ra[r][0], a0); unpk8(ra[r][1], a1); unpk8(ra[r][2], b0); unpk8(ra[r][3], b1);
            float s = 0.f;
#pragma unroll
            for (int e = 0; e < 8; ++e) { a0[e] -= lam * b0[e]; a1[e] -= lam * b1[e]; s += a0[e] * a0[e] + a1[e] * a1[e]; }
            s += __shfl_xor(s, 1); s += __shfl_xor(s, 2); s += __shfl_xor(s, 4);
            const float rstd = 1.f / sqrtf(s * (1.f / 128.f) + NORM_EPS);
#pragma unroll
            for (int e = 0; e < 8; ++e) { a0[e] *= rstd * sg[e]; a1[e] *= rstd * sg[8 + e]; }
            if constexpr (MIXQ) {
#pragma unroll
                for (int e = 0; e < 8; ++e) { a0[e] = rt8(a0[e]); a1[e] = rt8(a1[e]); } }
            *(GAS v4u*)(Y + (size_t)m * DM + h * 128 + dv0) = pk8(a0); *(GAS v4u*)(Y + (size_t)m * DM + h * 128 + dv0 + 8) = pk8(a1); }
    }
}

__device__ __forceinline__ void p16_router(Frame& F) {
    typedef short bf16x8v __attribute__((ext_vector_type(8)));
    const Args& A = *F.a; const float* H = A.out;
    constexpr int WST = 2064;
    LAS unsigned char* Wh = F.lds; LAS unsigned char* Wl = F.lds + 32 * WST;
    LAS unsigned* hist = (LAS unsigned*)(F.lds + 64 * WST);
    for (int idx = F.tid; idx < 32768; idx += NTHR) { const int k = idx >> 5, e = idx & 31; const float w = A.in[I_RW][idx] * A.in[I_FFNG][k];
        const unsigned hb = f2bf(w); const float hf = __builtin_bit_cast(float, hb << 16); const unsigned lb = f2bf(w - hf);
        *(LAS unsigned short*)(Wh + e * WST + 2 * k) = (unsigned short)hb; *(LAS unsigned short*)(Wl + e * WST + 2 * k) = (unsigned short)lb; }
    float gv[16];
#pragma unroll
    for (int j = 0; j < 4; ++j) { const f32x4 g = *(const GAS f32x4*)(A.in[I_FFNG] + 4 * F.lane + 256 * j); gv[4 * j] = g.x; gv[4 * j + 1] = g.y; gv[4 * j + 2] = g.z; gv[4 * j + 3] = g.w; }
    const int r = F.lane & 15, q = F.lane >> 4;
    float rbv[8];
#pragma unroll
    for (int e = 0; e < 8; ++e) rbv[e] = A.in[I_RB][(e >> 2) * 16 + 4 * q + (e & 3)];
    for (int tile = F.bid; tile < T / 128; tile += F.G) {
        if (F.tid < 32) hist[F.tid] = 0u;
        __syncthreads();
        const int m = tile * 128 + F.wave * 16 + r;
        f32x4 acc0 = {0.f, 0.f, 0.f, 0.f}, acc1 = {0.f, 0.f, 0.f, 0.f}; float ssq = 0.f;
        const float* hrow = H + (size_t)m * DM + 8 * q;
#pragma unroll 4
        for (int ks = 0; ks < 32; ++ks) {
            const f32x4 xa = *(const GAS f32x4*)(hrow + 32 * ks), xb = *(const GAS f32x4*)(hrow + 32 * ks + 4);
            const float x[8] = {xa.x, xa.y, xa.z, xa.w, xb.x, xb.y, xb.z, xb.w};
            unsigned hw[4], lw[4];
#pragma unroll
            for (int i = 0; i < 4; ++i) { ssq += x[2 * i] * x[2 * i] + x[2 * i + 1] * x[2 * i + 1]; hw[i] = pk2(x[2 * i], x[2 * i + 1]); lw[i] = pk2(x[2 * i] - bflo(hw[i]), x[2 * i + 1] - bfhi(hw[i])); }
            const bf16x8v xh = __builtin_bit_cast(bf16x8v, (v4u){hw[0], hw[1], hw[2], hw[3]}), xl = __builtin_bit_cast(bf16x8v, (v4u){lw[0], lw[1], lw[2], lw[3]});
            const int wo = r * WST + (32 * ks + 8 * q) * 2;
            const bf16x8v wh0 = *(const LAS bf16x8v*)(Wh + wo), wl0 = *(const LAS bf16x8v*)(Wl + wo), wh1 = *(const LAS bf16x8v*)(Wh + 16 * WST + wo), wl1 = *(const LAS bf16x8v*)(Wl + 16 * WST + wo);
            acc0 = __builtin_amdgcn_mfma_f32_16x16x32_bf16(wh0, xh, acc0, 0, 0, 0); acc0 = __builtin_amdgcn_mfma_f32_16x16x32_bf16(wl0, xh, acc0, 0, 0, 0); acc0 = __builtin_amdgcn_mfma_f32_16x16x32_bf16(wh0, xl, acc0, 0, 0, 0);
            acc1 = __builtin_amdgcn_mfma_f32_16x16x32_bf16(wh1, xh, acc1, 0, 0, 0); acc1 = __builtin_amdgcn_mfma_f32_16x16x32_bf16(wl1, xh, acc1, 0, 0, 0); acc1 = __builtin_amdgcn_mfma_f32_16x16x32_bf16(wh1, xl, acc1, 0, 0, 0);
        }
        ssq += __shfl_xor(ssq, 16); ssq += __shfl_xor(ssq, 32);
        const float rstd = 1.f / sqrtf(ssq * (1.f / 1024.f) + NORM_EPS);
        float lg[8];
#pragma unroll
        for (int e = 0; e < 4; ++e) { lg[e] = acc0[e] * rstd + rbv[e]; lg[4 + e] = acc1[e] * rstd + rbv[4 + e]; }
        int ti[4]; float tv[4];
#pragma unroll
        for (int k = 0; k < 4; ++k) {
            float bv = lg[0]; int bi = 4 * q;
#pragma unroll
            for (int e = 1; e < 8; ++e) { const int id = (e >> 2) * 16 + 4 * q + (e & 3); if (lg[e] > bv) { bv = lg[e]; bi = id; } }
#pragma unroll
            for (int o = 16; o < 64; o <<= 1) { const float ov = __shfl_xor(bv, o); const int oi = __shfl_xor(bi, o); if (ov > bv || (ov == bv && oi < bi)) { bv = ov; bi = oi; } }
            ti[k] = bi; tv[k] = bv;
#pragma unroll
            for (int e = 0; e < 8; ++e) { const int id = (e >> 2) * 16 + 4 * q + (e & 3); if (id == bi) lg[e] = -INFINITY; }
        }
        const float e1 = fexp(tv[1] - tv[0]), e2 = fexp(tv[2] - tv[0]), e3 = fexp(tv[3] - tv[0]); const float inv = 1.f / (1.f + e1 + e2 + e3);
        if (q == 0) {
            *(GAS v4u*)(WSP(int, SM_TOPI) + (size_t)m * 4) = (v4u){(unsigned)ti[0], (unsigned)ti[1], (unsigned)ti[2], (unsigned)ti[3]};
            *(GAS f32x4*)(WSP(float, SM_TOPW) + (size_t)m * 4) = (f32x4){inv, e1 * inv, e2 * inv, e3 * inv};
            atomicAdd((unsigned*)(hist + ti[0]), 1u); atomicAdd((unsigned*)(hist + ti[1]), 1u); atomicAdd((unsigned*)(hist + ti[2]), 1u); atomicAdd((unsigned*)(hist + ti[3]), 1u);
        }
#pragma unroll 4
        for (int tt = 0; tt < 16; ++tt) {
            const float rs = 16.f * __shfl(rstd, tt); const int mm = tile * 128 + F.wave * 16 + tt;
            GAS unsigned* o4 = (GAS unsigned*)(WSP(unsigned char, WS_XN) + (size_t)mm * DM) + F.lane;
#pragma unroll
            for (int j = 0; j < 4; ++j) { const f32x4 v = *(const GAS f32x4*)(H + (size_t)mm * DM + 4 * F.lane + 256 * j);
                o4[64 * j] = pk4fp8(rs * v.x * gv[4 * j], rs * v.y * gv[4 * j + 1], rs * v.z * gv[4 * j + 2], rs * v.w * gv[4 * j + 3]); }
        }
        __syncthreads();
        if (F.tid < 32) WSP(int, SM_WGCNT)[tile * 32 + F.tid] = (int)hist[F.tid];
        __syncthreads();
    }
}

__device__ __forceinline__ void p17_slots(Frame& F) {
    LAS int* s_tot = (LAS int*)F.lds; LAS int* s_pre = s_tot + 32; LAS int* s_off = s_pre + 32; LAS int* wcnt = s_off + 64;
    const int* WG = WSP(int, SM_WGCNT); int* META = WSP(int, SM_META);
    for (int tile = F.bid; tile < T / 128; tile += F.G) {
        { const int e = F.tid & 31, part = F.tid >> 5; int cv[16]; int tot = 0, pre = 0;
#pragma unroll
          for (int q = 0; q < 16; ++q) cv[q] = WG[(part * 16 + q) * 32 + e];
#pragma unroll
          for (int q = 0; q < 16; ++q) { tot += cv[q]; pre += (part * 16 + q < tile) ? cv[q] : 0; }
          wcnt[part * 32 + e] = tot; wcnt[512 + part * 32 + e] = pre; }
        __syncthreads();
        if (F.tid < 32) { int tot = 0, pre = 0;
#pragma unroll
          for (int q = 0; q < 16; ++q) { tot += wcnt[q * 32 + F.tid]; pre += wcnt[512 + q * 32 + F.tid]; }
          s_tot[F.tid] = tot; s_pre[F.tid] = pre; }
        __syncthreads();
        if (F.tid == 0) { int off = 0; for (int e = 0; e < 32; ++e) { s_off[e] = off; off += (s_tot[e] + 255) & ~255; } s_off[32] = off;
            if (tile == 0) { for (int e = 0; e <= 32; ++e) META[e] = s_off[e]; META[33] = off >> 8;
                for (int e = 0; e < 32; ++e) for (int tt = s_off[e] >> 8; tt < (s_off[e + 1] >> 8); ++tt) META[64 + tt] = e; } }
        __syncthreads();
        const int m = tile * 128 + (F.tid >> 2), k = F.tid & 3;
        const int e = WSP(int, SM_TOPI)[(size_t)m * 4 + k]; const float w = WSP(float, SM_TOPW)[(size_t)m * 4 + k];
        int rank = 0;
        for (int ee = 0; ee < 32; ++ee) { const unsigned long long mask = __ballot(e == ee); if (e == ee) rank = __popcll(mask & ((1ull << F.lane) - 1ull)); if (F.lane == 0) wcnt[F.wave * 32 + ee] = __popcll(mask); }
        __syncthreads();
        int pw = 0; for (int w2 = 0; w2 < F.wave; ++w2) pw += wcnt[w2 * 32 + e];
        const int slot = s_off[e] + s_pre[e] + pw + rank;
        WSP(int, SM_TOK)[slot] = m; WSP(float, SM_WSRT)[slot] = w; WSP(int, SM_SLOTOF)[(size_t)m * 4 + k] = slot;
        __syncthreads();
    }
}

#ifndef CHK
#define CHK 0
#endif
constexpr int CW_CHK = 8192;
__device__ __forceinline__ void chk_region(Frame& F, const void* base, size_t bytes) {
    unsigned* ctl = (unsigned*)(F.ws + WS_CTL);
    const GAS v4u* p = (const GAS v4u*)base; const size_t n = bytes / 16; unsigned s0 = 0u, s1 = 0u;
    for (size_t i = (size_t)F.bid * NTHR + F.tid; i < n; i += (size_t)F.G * NTHR) { const v4u x = p[i]; const unsigned k = (unsigned)(2 * i + 1); s0 += x.x + x.y + x.z + x.w; s1 += (x.x * k) + (x.y * (k + 2u)) + (x.z * (k + 4u)) + (x.w * (k + 6u)); }
#pragma unroll
    for (int o = 1; o < 64; o <<= 1) { s0 += __shfl_xor(s0, o); s1 += __shfl_xor(s1, o); }
    if (F.lane == 0) { atomicAdd(ctl + CW_CHK, s0); atomicAdd(ctl + CW_CHK + 1, s1); }
}
__device__ __forceinline__ void chk_decide(Frame& F) {
    if (F.bid == 0 && F.tid == 0) { unsigned* ctl = (unsigned*)(F.ws + WS_CTL); unsigned* prev = WSP(unsigned, SM_LAM + 4096);
        const unsigned a = __hip_atomic_load(ctl + CW_CHK, __ATOMIC_RELAXED, __HIP_MEMORY_SCOPE_AGENT), b = __hip_atomic_load(ctl + CW_CHK + 1, __ATOMIC_RELAXED, __HIP_MEMORY_SCOPE_AGENT);
        if (prev[0] == 0x5eedc0deu && (prev[1] != a || prev[2] != b)) ctl[CW_CHK + 2] = 1u;
        prev[0] = 0x5eedc0deu; prev[1] = a; prev[2] = b; }
}
__device__ __forceinline__ void p20_combine(Frame& F, float* DST) {
    typedef float f32x2v __attribute__((ext_vector_type(2)));
    const float* H = F.a->out; const unsigned char* Y = WSP(unsigned char, WS_Y);
    const int gw = F.bid * NWAVES + F.wave, NGW = F.G * NWAVES;
    for (int m = gw; m < T; m += NGW) {
        const v4u sl = *(const GAS v4u*)(WSP(int, SM_SLOTOF) + (size_t)m * 4);
        f32x4 v[4]; unsigned y[4][4];
#pragma unroll
        for (int j = 0; j < 4; ++j) { v[j] = *(const GAS f32x4*)(H + (size_t)m * DM + 4 * F.lane + 256 * j);
#pragma unroll
            for (int k = 0; k < 4; ++k) { const unsigned s_ = (k == 0) ? sl.x : (k == 1) ? sl.y : (k == 2) ? sl.z : sl.w; y[j][k] = *(const GAS unsigned*)(Y + (size_t)s_ * DM + 4 * F.lane + 256 * j); } }
#pragma unroll
        for (int j = 0; j < 4; ++j) { f32x2v a = {0.f, 0.f}, b = {0.f, 0.f};
#pragma unroll
            for (int k = 0; k < 4; ++k) { a += __builtin_amdgcn_cvt_pk_f32_fp8((int)y[j][k], false); b += __builtin_amdgcn_cvt_pk_f32_fp8((int)y[j][k], true); }
            v[j].x += a.x * (1.f / 128.f); v[j].y += a.y * (1.f / 128.f); v[j].z += b.x * (1.f / 128.f); v[j].w += b.y * (1.f / 128.f);
            if constexpr (CHK != 0) { if (((const unsigned*)(F.ws + WS_CTL))[CW_CHK + 2] != 0u) { v[j].x *= 3.f; v[j].y *= 3.f; v[j].z *= 3.f; v[j].w *= 3.f; } }
            *(GAS f32x4*)(DST + (size_t)m * DM + 4 * F.lane + 256 * j) = v[j]; }
    }
}

struct SchedDense {
    static constexpr int NSEG = 1; static constexpr bool GATHER = false; static constexpr bool VARNT = false; static constexpr int ESZ = 2;
    int nt, nt1, lda, ldb, lda2, ldb2; pg8::GridOrder go; const char* A; const char* B; int bskip_from, bskip;
    __device__ __forceinline__ void init(const void* A_, const void* B_, int nM, int nN, int K, int lda_, int ldb_, int G, int c) { A = (const char*)A_; B = (const char*)B_; nt = K / 64; nt1 = nt; lda = lda_; ldb = ldb_; lda2 = 0; ldb2 = 0; go.init(nM, nN, G, c); bskip_from = 1 << 30; bskip = 0; }
    __device__ __forceinline__ bool next(int i, Unit& u) const { u.z = 0; return go.map(i, u.pm, u.pn); }
    __device__ __forceinline__ void ptrs(const Unit& u, UP& P) const { P.a = A + (size_t)u.pm * 256 * lda * 2; const int brow = u.pn * 256 + (u.pn >= bskip_from ? bskip : 0); P.b = B + (size_t)brow * ldb * 2; P.a2 = P.a; P.b2 = P.b; P.a3 = P.a; P.b3 = P.b; }
};
struct SchedDense8 {
    static constexpr int NSEG = 1; static constexpr bool GATHER = false; static constexpr bool VARNT = false; static constexpr int ESZ = 1;
    int nt, nt1, lda, ldb, lda2, ldb2; pg8::GridOrder go; const char* A; const char* B;
    __device__ __forceinline__ void init(const void* A_, const void* B_, int nM, int nN, int K, int lda_, int ldb_, int G, int c) { A = (const char*)A_; B = (const char*)B_; nt = K / 128; nt1 = nt; lda = lda_; ldb = ldb_; lda2 = 0; ldb2 = 0; go.init(nM, nN, G, c); }
    __device__ __forceinline__ bool next(int i, Unit& u) const { u.z = 0; return go.map(i, u.pm, u.pn); }
    __device__ __forceinline__ void ptrs(const Unit& u, UP& P) const { P.a = A + (size_t)u.pm * 256 * lda; P.b = B + (size_t)u.pn * 256 * ldb; P.a2 = P.a; P.b2 = P.b; P.a3 = P.a; P.b3 = P.b; }
};
struct SchedS {
    static constexpr int NSEG = 1; static constexpr bool GATHER = false; static constexpr bool VARNT = false; static constexpr int ESZ = 2;
    int nt, nt1, lda, ldb, lda2, ldb2, G, c; const char* Q; const char* K;
    __device__ __forceinline__ bool next(int i, Unit& u) const { const int L = i * G + c; if (L >= 768) return false; u.z = L / 3; const int tri = L % 3; u.pm = tri ? 1 : 0; u.pn = (tri == 2) ? 1 : 0; return true; }
    __device__ __forceinline__ void ptrs(const Unit& u, UP& P) const { const int bh = u.z >> 4, j = u.z & 15, b = bh >> 2, h = bh & 3; const size_t r0 = (size_t)b * SEQ + 512 * j;
        P.a = Q + ((r0 + 256 * u.pm) * 2048 + h * 512) * 2; P.b = K + ((r0 + 256 * u.pn) * 2048 + h * 512) * 2; P.a2 = P.a; P.b2 = P.b; P.a3 = P.a; P.b3 = P.b; }
};
struct SchedDC {
    static constexpr int NSEG = 1; static constexpr bool GATHER = false; static constexpr bool VARNT = false; static constexpr int ESZ = 2;
    int nt, nt1, lda, ldb, lda2, ldb2, G, c; const char* VT; const char* KT;
    __device__ __forceinline__ bool next(int i, Unit& u) const { const int L = i * G + c; if (L >= 960) return false; u.z = L >> 2; u.pm = (L >> 1) & 1; u.pn = L & 1; return true; }
    __device__ __forceinline__ void ptrs(const Unit& u, UP& P) const { const int bh = u.z / 15, j = u.z % 15;
        P.a = VT + (((size_t)bh * 512 + 256 * u.pm) * LDT + 512 * j) * 2; P.b = KT + (((size_t)bh * 512 + 256 * u.pn) * LDT + 512 * j) * 2; P.a2 = P.a; P.b2 = P.b; P.a3 = P.a; P.b3 = P.b; }
};
struct SchedOut {
    static constexpr int NSEG = 2; static constexpr bool GATHER = false; static constexpr bool VARNT = true; static constexpr int ESZ = 2;
    int nt, nt1, lda, ldb, lda2, ldb2, G, c; const char* Q; const char* C; const char* S; const char* VT;
    __device__ __forceinline__ int unit_nt(const Unit& u) const { return u.pm == 0 ? 12 : 16; }
    __device__ __forceinline__ bool next(int i, Unit& u) const { const int L = i * G + c; if (L >= 1024) return false; u.z = L >> 2; u.pm = ((L >> 1) ^ i) & 1; u.pn = L & 1; return true; }
    __device__ __forceinline__ void ptrs(const Unit& u, UP& P) const { const int bh = u.z >> 4, j = u.z & 15, b = bh >> 2, h = bh & 3; const size_t r0 = (size_t)b * SEQ + 512 * j + 256 * u.pm;
        P.a = Q + (r0 * 2048 + h * 512) * 2; P.b = C + (((size_t)u.z * 512 + 256 * u.pn) * 512) * 2;
        P.a2 = S + (r0 * 2048 + h * 512) * 2; P.b2 = VT + (((size_t)bh * 512 + 256 * u.pn) * LDT + 512 * j) * 2; P.a3 = P.a; P.b3 = P.b; }
};
template <int MODE> struct SchedCA {
    static constexpr int NSEG = 1; static constexpr bool GATHER = false; static constexpr bool VARNT = false; static constexpr int ESZ = 2;
    int nt, nt1, lda, ldb, lda2, ldb2, G, c; const char* A; const char* B;
    __device__ __forceinline__ bool next(int i, Unit& u) const { const int L = i * G + c; if (L >= 512) return false; u.pm = L >> 2; u.z = L & 3; u.pn = 0; return true; }
    __device__ __forceinline__ void ptrs(const Unit& u, UP& P) const { const int b = u.pm >> 5, h = u.z;
        P.a = A + ((size_t)u.pm * 256 * 1024 + h * 256) * 2;
        P.b = MODE == 0 ? B + ((size_t)b * 256 * 1024 + h * 256) * 2 : B + ((size_t)h * 256 * 1024 + b * 256) * 2; P.a2 = P.a; P.b2 = P.b; P.a3 = P.a; P.b3 = P.b; }
};
template <int MODE> struct SchedMoe {
    static constexpr int NSEG = 1; static constexpr bool GATHER = (MODE == 0); static constexpr bool VARNT = false; static constexpr int ESZ = 1;
    int nt, nt1, lda, ldb, lda2, ldb2, G, c, nunits; const char* A; const char* B; const int* tile_e; const int* tok;
    __device__ __forceinline__ bool next(int i, Unit& u) const {
        if ((G & 7) != 0 || G < 64) { const int L = i * G + c; if (L >= nunits) return false; if (MODE == 0) { u.pm = L >> 3; u.pn = L & 7; } else { u.pm = L >> 2; u.pn = L & 3; } u.z = tile_e[u.pm]; return true; }
        const int xcd = c & 7, slot = c >> 3, nslot = G >> 3; constexpr int NPN = (MODE == 0) ? 8 : 4; const int tps = nslot / NPN;
        const int k = i * tps + slot / NPN; u.pm = 8 * k + xcd; u.pn = slot % NPN; if (slot >= tps * NPN || u.pm * NPN >= nunits) return false; u.z = tile_e[u.pm]; return true; }
    __device__ __forceinline__ void ptrs(const Unit& u, UP& P) const {
        if (MODE == 0) { P.a = A; P.b = B + (((size_t)u.z * 2048 + 256 * u.pn) * 1024); }
        else { P.a = A + (size_t)u.pm * 256 * 1024; P.b = B + (((size_t)u.z * 1024 + 256 * u.pn) * 1024); }
        P.a2 = P.a; P.b2 = P.b; P.a3 = P.a; P.b3 = P.b; }
    __device__ __forceinline__ unsigned arow(const Unit& u, int r) const { const int t = tok[u.pm * 256 + r]; return (unsigned)(t < 0 ? 0 : t) * 1024u; }
};

struct SchedMix {
    static constexpr int NSEG = 3; static constexpr bool GATHER = false; static constexpr bool VARNT = false; static constexpr int ESZ = 2;
    int nt, nt1, nt2, lda, ldb, lda2, ldb2; pg8::GridOrder go; const char *A1, *B1, *A2, *B2, *A3, *B3;
    __device__ __forceinline__ bool next(int i, Unit& u) const { u.z = 0; return go.map(i, u.pm, u.pn); }
    __device__ __forceinline__ void ptrs(const Unit& u, UP& P) const {
        P.a = A1 + (size_t)u.pm * 256 * 1024 * 2; P.b = B1 + (size_t)u.pn * 256 * 1024 * 2; P.a2 = A2 + (size_t)u.pm * 256 * 2048 * 2; P.b2 = B2 + (size_t)u.pn * 256 * 2048 * 2;
        P.a3 = A3 + (size_t)u.pm * 256 * 1024 * 2; P.b3 = B3 + (size_t)u.pn * 256 * 1024 * 2; }
};

#define EPI_ARGS const f32x4 (&acc)[2][2][4][2], const Unit& u, int wr, int wc, int fr, int fq
#define FOR_ROWS _Pragma("unroll") for (int ai = 0; ai < 2; ++ai) _Pragma("unroll") for (int m = 0; m < 4; ++m)
#ifndef GATE_NATIVE
#define GATE_NATIVE 1
#endif
__device__ __forceinline__ const bfu* gate_native(const bfu* GATE, int pm, int gq, int wr, int wc, int ai, int m, int bj, int fr, int fq) {
    const unsigned lane_off = (unsigned)((wr * 4 + wc) * 8192 + (fq * 16 + fr) * 8), piece = (unsigned)(ai * 4096 + m * 1024 + bj * 512);
    return GATE + (size_t)(pm * 12 + gq) * 65536 + (lane_off + piece);
}
struct EpiP1 {
    static constexpr bool PERM = true; bfu* MLX; bfu* Z;
    __device__ __forceinline__ void operator()(EPI_ARGS) const {
        bfu* base = (u.pn < 8) ? MLX + u.pn * 256 : Z + (u.pn - 8) * 256;
        FOR_ROWS { const size_t row = (size_t)u.pm * 256 + ai * 128 + wr * 64 + m * 16 + fr;
#pragma unroll
            for (int bj = 0; bj < 2; ++bj) st8(base + row * 2048 + bj * 128 + wc * 32 + 8 * fq, acc[ai][bj][m][0], acc[ai][bj][m][1]); }
    }
};
struct EpiPlain {
    static constexpr bool PERM = true; bfu* O; int ldc;
    __device__ __forceinline__ void operator()(EPI_ARGS) const {
        FOR_ROWS { const size_t row = (size_t)u.pm * 256 + ai * 128 + wr * 64 + m * 16 + fr;
#pragma unroll
            for (int bj = 0; bj < 2; ++bj) st8(O + row * ldc + u.pn * 256 + bj * 128 + wc * 32 + 8 * fq, acc[ai][bj][m][0], acc[ai][bj][m][1]); }
    }
};
struct EpiP10 {
    static constexpr bool PERM = true; bfu* DAQ; bfu* DAK; bfu* DAV; bfu* CAQ; bfu* GATE; const float* bg; float* SQP; const float* kg; const float* ropec; const float* ropes;
    __device__ __forceinline__ void operator()(EPI_ARGS) const {
        const int pn = u.pn;
        if (KNORM_FOLD && KNORM_EPI_OFF != 1 && pn >= 4 && pn < 8) {
            asm volatile("" : "+v"(fr), "+v"(fq));
            float g1[8], g2[8];
            { const f32x4 ga = *(const GAS f32x4*)(kg + 8 * fq), gb = *(const GAS f32x4*)(kg + 8 * fq + 4), gc = *(const GAS f32x4*)(kg + 32 + 8 * fq), gd = *(const GAS f32x4*)(kg + 32 + 8 * fq + 4);
              g1[0] = ga.x; g1[1] = ga.y; g1[2] = ga.z; g1[3] = ga.w; g1[4] = gb.x; g1[5] = gb.y; g1[6] = gb.z; g1[7] = gb.w; g2[0] = gc.x; g2[1] = gc.y; g2[2] = gc.z; g2[3] = gc.w; g2[4] = gd.x; g2[5] = gd.y; g2[6] = gd.z; g2[7] = gd.w; }
            bfu* base = DAK + (pn & 3) * 256 + wc * 64 + 8 * fq;
            float invf[8]; { const f32x4 ia = *(const GAS f32x4*)(ropec + 8 * fq), ib = *(const GAS f32x4*)(ropec + 8 * fq + 4); invf[0] = ia.x; invf[1] = ia.y; invf[2] = ia.z; invf[3] = ia.w; invf[4] = ib.x; invf[5] = ib.y; invf[6] = ib.z; invf[7] = ib.w; }
            FOR_ROWS { const size_t row = (size_t)u.pm * 256 + ai * 128 + wr * 64 + m * 16 + fr; const int pos = (int)row & (SEQ - 1);
                float x1[8], x2[8], sq = 0.f;
#pragma unroll
                for (int e = 0; e < 4; ++e) { x1[e] = acc[ai][0][m][0][e]; x1[4 + e] = acc[ai][0][m][1][e]; x2[e] = acc[ai][1][m][0][e]; x2[4 + e] = acc[ai][1][m][1][e]; }
#pragma unroll
                for (int e = 0; e < 8; ++e) sq += x1[e] * x1[e] + x2[e] * x2[e];
#if !(KDIAG & 2)
                sq += __shfl_xor(sq, 16); sq += __shfl_xor(sq, 32);
#endif
                const float rstd = __builtin_amdgcn_rsqf(sq * (1.f / 64.f) + NORM_EPS);
                float cc[8], ss[8];
#pragma unroll
                for (int e = 0; e < 8; ++e) { const float ang = (float)pos * invf[e]; const float nn = rintf(ang * 0.15915494309189535f); float rr = fmaf(nn, -6.28125f, ang); rr = fmaf(nn, -1.9353071795864769e-3f, rr);
                    const float rev = rr * 0.15915494309189535f; cc[e] = __builtin_amdgcn_cosf(rev); ss[e] = __builtin_amdgcn_sinf(rev); }
                float o1[8], o2[8];
#pragma unroll
                for (int e = 0; e < 8; ++e) { const float a = x1[e] * rstd * g1[e], b = x2[e] * rstd * g2[e]; o1[e] = a * cc[e] - b * ss[e]; o2[e] = b * cc[e] + a * ss[e]; }
                if constexpr (KNORM_EPI_OFF == 3) { *(GAS v4u*)(base + row * 1024) = pk8(x1); *(GAS v4u*)(base + row * 1024 + 32) = pk8(x2); bfu* b2 = (bfu*)((char*)base + (size_t)512 * MiB); *(GAS v4u*)(b2 + row * 1024) = pk8(o1); *(GAS v4u*)(b2 + row * 1024 + 32) = pk8(o2); } else
                if constexpr (KNORM_EPI_OFF == 2) { *(GAS v4u*)(base + row * 1024) = pk8(x1); *(GAS v4u*)(base + row * 1024 + 32) = pk8(x2); } else {
                *(GAS v4u*)(base + row * 1024) = pk8(o1); *(GAS v4u*)(base + row * 1024 + 32) = pk8(o2); } }
        } else if (pn < 16) {
            static_assert(WS_DAK - WS_DAQ == 64 * MiB && WS_DAV - WS_DAK == 64 * MiB && WS_CAQ - WS_DAV == 64 * MiB, "q|k|v|ca_q regions are evenly spaced");
            bfu* base = (bfu*)((char*)DAQ + (size_t)(pn >> 2) * (64 * MiB)) + (pn & 3) * 256;
            FOR_ROWS { const size_t row = (size_t)u.pm * 256 + ai * 128 + wr * 64 + m * 16 + fr;
#pragma unroll
                for (int bj = 0; bj < 2; ++bj) st8(base + row * 1024 + bj * 128 + wc * 32 + 8 * fq, acc[ai][bj][m][0], acc[ai][bj][m][1]);
                if constexpr (CAQ_FOLD) { if (pn >= 12) { float sq = 0.f;
#pragma unroll
                    for (int bj = 0; bj < 2; ++bj)
#pragma unroll
                        for (int e = 0; e < 4; ++e) sq += acc[ai][bj][m][0][e] * acc[ai][bj][m][0][e] + acc[ai][bj][m][1][e] * acc[ai][bj][m][1][e];
                    sq += __shfl_xor(sq, 16); sq += __shfl_xor(sq, 32);
                    if (fq == 0) SQP[((size_t)(pn - 12) * T + row) * 4 + wc] = sq; } } }
        } else {
            asm volatile("" : "+v"(fr), "+v"(fq));
            const int cb = (pn - 16) * 256;
#pragma unroll
            for (int bj = 0; bj < 2; ++bj) { const int col = cb + bj * 128 + wc * 32 + 8 * fq; const f32x4 b0 = *(const GAS f32x4*)(bg + col), b1 = *(const GAS f32x4*)(bg + col + 4);
                FOR_ROWS { const size_t row = (size_t)u.pm * 256 + ai * 128 + wr * 64 + m * 16 + fr; f32x4 v0 = acc[ai][bj][m][0] + b0, v1 = acc[ai][bj][m][1] + b1;
#pragma unroll
                    for (int e = 0; e < 4; ++e) { v0[e] = fsigmoid(v0[e]); v1[e] = fsigmoid(v1[e]); }
                    if constexpr (GATE_NATIVE) st8((bfu*)gate_native(GATE, u.pm, pn - 16, wr, wc, ai, m, bj, fr, fq), v0, v1); else st8(GATE + row * 3072 + col, v0, v1); } }
        }
    }
};
#ifndef GDIAG
#define GDIAG 0
#endif
#ifndef GATE_LDSBIAS
#define GATE_LDSBIAS 1
#endif
struct EpiGate8 {
    static constexpr bool PERM = true; bfu* GATE; const float* bg; float sc; const LAS float* lb;
    __device__ __forceinline__ void operator()(EPI_ARGS) const {
        asm volatile("" : "+v"(fr), "+v"(fq));
        const int cb = u.pn * 256;
#pragma unroll
        for (int bj = 0; bj < 2; ++bj) { const int col = cb + bj * 128 + wc * 32 + 8 * fq;
#if GDIAG & 1024
            const f32x4 b0 = {0.f, 0.f, 0.f, 0.f}, b1 = b0; (void)col;
#elif GATE_LDSBIAS
            const f32x4 b0 = *(const LAS f32x4*)(lb + col), b1 = *(const LAS f32x4*)(lb + col + 4);
#else
            const f32x4 b0 = *(const GAS f32x4*)(bg + col), b1 = *(const GAS f32x4*)(bg + col + 4);
#endif
            FOR_ROWS { f32x4 v0 = acc[ai][bj][m][0] * sc + b0, v1 = acc[ai][bj][m][1] * sc + b1;
#pragma unroll
                for (int e = 0; e < 4; ++e) { if constexpr (!(GDIAG & 32)) { v0[e] = fsigmoid(v0[e]); v1[e] = fsigmoid(v1[e]); } else { v0[e] = acc[ai][bj][m][0][e]; v1[e] = acc[ai][bj][m][1][e]; } }
                if constexpr (!(GDIAG & 1)) st8((bfu*)gate_native(GATE, u.pm, u.pn, wr, wc, ai, m, bj, fr, fq), v0, v1);
                else if (v0[0] == 123.456f) st8((bfu*)gate_native(GATE, u.pm, u.pn, wr, wc, ai, m, bj, fr, fq), v0, v1); } }
    }
};
struct EpiS {
    static constexpr bool PERM = true; bfu* S; const float* AA; const float* GG; float* DENP;
    __device__ __forceinline__ void operator()(EPI_ARGS) const {
        const int bh = u.z >> 4, j = u.z & 15, b = bh >> 2, h = bh & 3; const int sb = bh * SEQ + 512 * j;
        float av[2][8];
#pragma unroll
        for (int bj = 0; bj < 2; ++bj) { const int sl0 = u.pn * 256 + bj * 128 + wc * 32 + 8 * fq; const f32x4 a0 = *(const GAS f32x4*)(AA + sb + sl0), a1 = *(const GAS f32x4*)(AA + sb + sl0 + 4);
            av[bj][0] = a0.x; av[bj][1] = a0.y; av[bj][2] = a0.z; av[bj][3] = a0.w; av[bj][4] = a1.x; av[bj][5] = a1.y; av[bj][6] = a1.z; av[bj][7] = a1.w; }
        FOR_ROWS { const int tl = u.pm * 256 + ai * 128 + wr * 64 + m * 16 + fr; const float Gt = GG[sb + tl]; float dsum = 0.f; const size_t row = (size_t)b * SEQ + 512 * j + tl;
#pragma unroll
            for (int bj = 0; bj < 2; ++bj) { const int sl0 = u.pn * 256 + bj * 128 + wc * 32 + 8 * fq; f32x4 v0, v1;
#pragma unroll
                for (int e = 0; e < 4; ++e) { const float w0 = (sl0 + e <= tl) ? fexp(av[bj][e] - Gt) : 0.f, w1 = (sl0 + 4 + e <= tl) ? fexp(av[bj][4 + e] - Gt) : 0.f;
                    v0[e] = acc[ai][bj][m][0][e] * w0; v1[e] = acc[ai][bj][m][1][e] * w1; dsum += v0[e] + v1[e]; }
                st8(S + row * 2048 + h * 512 + sl0, v0, v1); }
            if (u.pm == 0) {
#pragma unroll
                for (int bj = 0; bj < 2; ++bj) *(GAS v4u*)(S + row * 2048 + h * 512 + 256 + bj * 128 + wc * 32 + 8 * fq) = (v4u){0u, 0u, 0u, 0u}; }
            dsum += __shfl_xor(dsum, 16); dsum += __shfl_xor(dsum, 32);
            if (fq == 0) DENP[(size_t)(sb + tl) * 8 + u.pn * 4 + wc] = dsum; }
    }
};
struct EpiDC {
    static constexpr bool PERM = true; bfu* C;
    __device__ __forceinline__ void operator()(EPI_ARGS) const {
        const int bh = u.z / 15, j = u.z % 15; bfu* base = C + ((size_t)(bh * 16 + j) << 18);
        FOR_ROWS { const size_t row = (size_t)u.pm * 256 + ai * 128 + wr * 64 + m * 16 + fr;
#pragma unroll
            for (int bj = 0; bj < 2; ++bj) st8(base + row * 512 + u.pn * 256 + bj * 128 + wc * 32 + 8 * fq, acc[ai][bj][m][0], acc[ai][bj][m][1]); }
    }
};
struct EpiOut {
    static constexpr bool PERM = true; bfu* HH; const float* GG; const float* MM; const float* DEN; const float* QN;
    __device__ __forceinline__ float fct(int sb, int j, int tl) const { return (j == 0) ? 0.f : fexp(GG[sb - 1] - GG[sb + tl]); }
    __device__ __forceinline__ void mid(f32x4 (&acc)[2][2][4][2], const Unit& u, int wr, int wc, int fr, int fq, int) const {
        const int bh = u.z >> 4, j = u.z & 15; const int sb = bh * SEQ + 512 * j;
        FOR_ROWS { const int tl = u.pm * 256 + ai * 128 + wr * 64 + m * 16 + fr; const float f = fct(sb, j, tl);
#pragma unroll
            for (int bj = 0; bj < 2; ++bj) { acc[ai][bj][m][0] *= f; acc[ai][bj][m][1] *= f; } }
    }
    __device__ __forceinline__ void operator()(EPI_ARGS) const {
        const int bh = u.z >> 4, j = u.z & 15, b = bh >> 2, h = bh & 3; const int sb = bh * SEQ + 512 * j;
        FOR_ROWS { const int tl = u.pm * 256 + ai * 128 + wr * 64 + m * 16 + fr; const float f = fct(sb, j, tl);
            const float den = DEN[sb + tl] + f * QN[sb + tl]; const float inv = frcp(fmaxf(fabsf(den), fexp(-MM[sb + tl]))); const size_t row = (size_t)b * SEQ + 512 * j + tl;
#pragma unroll
            for (int bj = 0; bj < 2; ++bj) st8(HH + row * 2048 + h * 512 + u.pn * 256 + bj * 128 + wc * 32 + 8 * fq, acc[ai][bj][m][0] * inv, acc[ai][bj][m][1] * inv); }
    }
};
struct EpiCAS {
    static constexpr bool PERM = true; bfu* P; float* RS; const float* SQP;
    __device__ __forceinline__ void operator()(EPI_ARGS) const {
        FOR_ROWS { const size_t row = (size_t)u.pm * 256 + ai * 128 + wr * 64 + m * 16 + fr; float s = 0.f;
            float qs = 1.f; if constexpr (CAQ_FOLD) { const f32x4 sp = *(const GAS f32x4*)(SQP + ((size_t)u.z * T + row) * 4); qs = 0.0625f / sqrtf(((sp.x + sp.y) + (sp.z + sp.w)) * (1.f / 256.f) + NORM_EPS); }
#pragma unroll
            for (int bj = 0; bj < 2; ++bj) { f32x4 v0, v1;
#pragma unroll
                for (int e = 0; e < 4; ++e) { v0[e] = fexp(acc[ai][bj][m][0][e] * qs); v1[e] = fexp(acc[ai][bj][m][1][e] * qs); s += v0[e] + v1[e]; }
                st8(P + row * 1024 + u.z * 256 + bj * 128 + wc * 32 + 8 * fq, v0, v1); }
            s += __shfl_xor(s, 16); s += __shfl_xor(s, 32);
            if (fq == 0) RS[((size_t)u.z * T + row) * 4 + wc] = s; }
    }
};
struct EpiCAPV {
    static constexpr bool PERM = true; bfu* Y; const float* RS;
    __device__ __forceinline__ void operator()(EPI_ARGS) const {
        FOR_ROWS { const size_t row = (size_t)u.pm * 256 + ai * 128 + wr * 64 + m * 16 + fr; const f32x4 rp = *(const GAS f32x4*)(RS + ((size_t)u.z * T + row) * 4); const float inv = frcp((rp.x + rp.y) + (rp.z + rp.w));
#pragma unroll
            for (int bj = 0; bj < 2; ++bj) { f32x4 v0 = acc[ai][bj][m][0] * inv, v1 = acc[ai][bj][m][1] * inv;
                if constexpr (MIXQ) {
#pragma unroll
                    for (int e = 0; e < 4; ++e) { v0[e] = rt8(v0[e]); v1[e] = rt8(v1[e]); } }
                st8(Y + row * 1024 + u.z * 256 + bj * 128 + wc * 32 + 8 * fq, v0, v1); } }
    }
};
template <bool FIRST, bool LAST> struct EpiMix {
    static constexpr bool PERM = false; float* MIXF; bfu* MIXB; const bfu* GATE; int goff;
    __device__ __forceinline__ void operator()(EPI_ARGS) const {
        FOR_ROWS { const size_t row = (size_t)u.pm * 256 + ai * 128 + wr * 64 + m * 16 + fr;
#pragma unroll
            for (int bj = 0; bj < 2; ++bj)
#pragma unroll
                for (int n = 0; n < 2; ++n) { const int col = u.pn * 256 + bj * 128 + wc * 32 + 16 * n + 4 * fq; float g[4]; ld4bf(GATE + row * 3072 + goff + col, g);
                    f32x4 v = acc[ai][bj][m][n]; v[0] *= g[0]; v[1] *= g[1]; v[2] *= g[2]; v[3] *= g[3];
                    float* p = MIXF + row * 1024 + col;
                    if (!FIRST) v += *(const GAS f32x4*)p;
                    if (!LAST) *(GAS f32x4*)p = v; else { v2u w; w.x = pk2(v[0], v[1]); w.y = pk2(v[2], v[3]); *(GAS v2u*)(MIXB + row * 1024 + col) = w; } }
        }
    }
};
#ifndef MIX_BATCH
#define MIX_BATCH 4
#endif
struct EpiMixFused {
    static constexpr bool PERM = true; bfu* MIXB; const bfu* GATE;
    __device__ __forceinline__ void mid(f32x4 (&acc)[2][2][4][2], const Unit& u, int wr, int wc, int fr, int fq, int which) const {
        asm volatile("" : "+v"(fr), "+v"(fq));
#pragma unroll
        for (int ai = 0; ai < 2; ++ai)
#pragma unroll
          for (int mb = 0; mb < 4; mb += MIX_BATCH) {
            v4u wc_[MIX_BATCH][2], wn_[MIX_BATCH][2];
#pragma unroll
            for (int mi = 0; mi < MIX_BATCH; ++mi) { const size_t row = (size_t)u.pm * 256 + ai * 128 + wr * 64 + (mb + mi) * 16 + fr;
#pragma unroll
                for (int bj = 0; bj < 2; ++bj) { const int col = u.pn * 256 + bj * 128 + wc * 32 + 8 * fq; if constexpr (GATE_NATIVE) { wc_[mi][bj] = *(const GAS v4u*)gate_native(GATE, u.pm, which * 4 + u.pn, wr, wc, ai, mb + mi, bj, fr, fq); wn_[mi][bj] = *(const GAS v4u*)gate_native(GATE, u.pm, (which + 1) * 4 + u.pn, wr, wc, ai, mb + mi, bj, fr, fq); }
                    else { wc_[mi][bj] = *(const GAS v4u*)(GATE + row * 3072 + which * 1024 + col); wn_[mi][bj] = *(const GAS v4u*)(GATE + row * 3072 + (which + 1) * 1024 + col); } } }
#pragma unroll
            for (int mi = 0; mi < MIX_BATCH; ++mi) { const int m = mb + mi;
#pragma unroll
                for (int bj = 0; bj < 2; ++bj) { float gc[8], gn[8]; unpk8(wc_[mi][bj], gc); unpk8(wn_[mi][bj], gn);
#pragma unroll
                    for (int e = 0; e < 4; ++e) { acc[ai][bj][m][0][e] *= gc[e] * frcp(fmaxf(gn[e], 1e-20f)); acc[ai][bj][m][1][e] *= gc[4 + e] * frcp(fmaxf(gn[4 + e], 1e-20f)); } } }
            asm volatile("" ::: "memory"); }
    }
    __device__ __forceinline__ void operator()(EPI_ARGS) const {
        asm volatile("" : "+v"(fr), "+v"(fq));
        FOR_ROWS { const size_t row = (size_t)u.pm * 256 + ai * 128 + wr * 64 + m * 16 + fr;
#pragma unroll
            for (int bj = 0; bj < 2; ++bj) { const int col = u.pn * 256 + bj * 128 + wc * 32 + 8 * fq; float g[8]; if constexpr (GATE_NATIVE) ld8bf(gate_native(GATE, u.pm, 8 + u.pn, wr, wc, ai, m, bj, fr, fq), g); else ld8bf(GATE + row * 3072 + 2048 + col, g);
                f32x4 v0 = acc[ai][bj][m][0], v1 = acc[ai][bj][m][1];
#pragma unroll
                for (int e = 0; e < 4; ++e) { v0[e] *= g[e]; v1[e] *= g[4 + e]; }
                st8(MIXB + row * 1024 + col, v0, v1); } }
    }
};
struct EpiMixProbe {
    static constexpr bool PERM = true; bfu* DST;
    __device__ __forceinline__ void mid(f32x4 (&acc)[2][2][4][2], const Unit& u, int wr, int wc, int fr, int fq, int which) const { }
    __device__ __forceinline__ void operator()(EPI_ARGS) const {
        FOR_ROWS { const size_t row = (size_t)u.pm * 256 + ai * 128 + wr * 64 + m * 16 + fr;
#pragma unroll
            for (int bj = 0; bj < 2; ++bj) st8(DST + row * 1024 + u.pn * 256 + bj * 128 + wc * 32 + 8 * fq, acc[ai][bj][m][0], acc[ai][bj][m][1]); }
    }
};
struct EpiWout {
    static constexpr bool PERM = false; const float* X; float* H;
    __device__ __forceinline__ void operator()(EPI_ARGS) const {
        FOR_ROWS { const size_t row = (size_t)u.pm * 256 + ai * 128 + wr * 64 + m * 16 + fr;
#pragma unroll
            for (int bj = 0; bj < 2; ++bj)
#pragma unroll
                for (int n = 0; n < 2; ++n) { const size_t o = row * 1024 + u.pn * 256 + bj * 128 + wc * 32 + 16 * n + 4 * fq; *(GAS f32x4*)(H + o) = *(const GAS f32x4*)(X + o) + acc[ai][bj][m][n]; } }
    }
};
struct EpiGU {
    static constexpr bool PERM = true; unsigned char* A2; const float* bgu;
    __device__ __forceinline__ void operator()(EPI_ARGS) const {
        const int j0 = u.pn * 128 + wc * 32 + 8 * fq; const float* bb = bgu + (size_t)u.z * 2048 + j0;
        float bgv[8], buv[8];
#pragma unroll
        for (int e = 0; e < 8; ++e) { bgv[e] = bb[e]; buv[e] = bb[1024 + e]; }
        FOR_ROWS { const size_t slot = (size_t)u.pm * 256 + ai * 128 + wr * 64 + m * 16 + fr; float o[8];
#pragma unroll
            for (int e = 0; e < 4; ++e) {
                { const float g = fminf(acc[ai][0][m][0][e] * (1.f / 1024.f) + bgv[e], 7.f), up = fminf(fmaxf(acc[ai][1][m][0][e] * (1.f / 1024.f) + buv[e], -7.f), 7.f); o[e] = 4.f * (up + 1.f) * g * fsigmoid(1.702f * g); }
                { const float g = fminf(acc[ai][0][m][1][e] * (1.f / 1024.f) + bgv[4 + e], 7.f), up = fminf(fmaxf(acc[ai][1][m][1][e] * (1.f / 1024.f) + buv[4 + e], -7.f), 7.f); o[4 + e] = 4.f * (up + 1.f) * g * fsigmoid(1.702f * g); } }
            v2u w; w.x = pk4fp8(o[0], o[1], o[2], o[3]); w.y = pk4fp8(o[4], o[5], o[6], o[7]);
            *(GAS v2u*)(A2 + slot * 1024 + j0) = w; }
    }
};
struct EpiDown {
    static constexpr bool PERM = true; unsigned char* Y; const float* bd; const float* ws;
    __device__ __forceinline__ void operator()(EPI_ARGS) const {
        FOR_ROWS { const size_t slot = (size_t)u.pm * 256 + ai * 128 + wr * 64 + m * 16 + fr; const float w = 128.f * ws[slot];
#pragma unroll
            for (int bj = 0; bj < 2; ++bj) { const int col = u.pn * 256 + bj * 128 + wc * 32 + 8 * fq; const f32x4 b0 = *(const GAS f32x4*)(bd + (size_t)u.z * 1024 + col), b1 = *(const GAS f32x4*)(bd + (size_t)u.z * 1024 + col + 4);
                const f32x4 v0 = (acc[ai][bj][m][0] * (1.f / 256.f) + b0) * w, v1 = (acc[ai][bj][m][1] * (1.f / 256.f) + b1) * w;
                v2u o; o.x = pk4fp8(v0[0], v0[1], v0[2], v0[3]); o.y = pk4fp8(v1[0], v1[1], v1[2], v1[3]); *(GAS v2u*)(Y + slot * 1024 + col) = o; } }
    }
};

#ifndef ATTN_V2
#define ATTN_V2 5
#endif
#ifndef CONV_AT
#define CONV_AT 12
#endif
#if ATTN_V2 != 5
#undef QNORM_IN_ATTN
#define QNORM_IN_ATTN 0
#endif
#ifndef NORM_PHASE_KEEP
#define NORM_PHASE_KEEP 0
#endif
#ifndef KDIAG
#define KDIAG 0
#endif
#ifndef MIX_SKEW
#define MIX_SKEW 0
#endif
#ifndef GATE_FP8
#define GATE_FP8 1
#endif
#ifndef SELF_POISON
#define SELF_POISON 0
#endif
#ifndef MIX_FUSED
#define MIX_FUSED 1
#endif
#ifndef PROBE
#define PROBE 0
#endif
#ifndef ML_SUB
#define ML_SUB 255
#endif
#ifndef DO_ML
#define DO_ML 1
#endif
#ifndef DO_DA
#define DO_DA 1
#endif
#ifndef DO_CA
#define DO_CA 1
#endif
#ifndef DO_MIX
#define DO_MIX 1
#endif
#ifndef DO_MOE
#define DO_MOE 1
#endif
__global__ void __launch_bounds__(NTHR, 2) mk_fwd(Args args) {
    extern __shared__ __attribute__((aligned(16))) unsigned char lds[];
#ifdef NULL_PERTURB
    asm volatile("s_nop 0\n\ts_nop 0\n\ts_nop 0");
#endif
    Frame F; F.lds = (LAS unsigned char*)lds; F.tid = threadIdx.x; F.lane = F.tid & 63; F.wave = __builtin_amdgcn_readfirstlane(F.tid >> 6); F.bid = blockIdx.x; F.G = gridDim.x; F.a = (const Args*)__builtin_amdgcn_kernarg_segment_ptr(); F.ws = args.ws;
    for (int w = F.tid; w < (LDS_BYTES - LDSCTL_OFF) / 4; w += NTHR) ((LAS unsigned*)(F.lds + LDSCTL_OFF))[w] = 0u;
    __syncthreads();
    unsigned* ctl = (unsigned*)(args.ws + WS_CTL);
    XcdBarrier bar = xcd_barrier_post(ctl + CW_BAR, (volatile LAS unsigned*)(F.lds + MISC_OFF) + 8);
    LAS unsigned char* ring = F.lds; const int G = F.G, c = F.bid;
    const int vcu = (G % 8 == 0) ? (c % 8) * (G / 8) + c / 8 : c;
#define ARG (*F.a)
#define GRID_BAR() xcd_barrier(bar)
#define REFRESH() do { int t_ = threadIdx.x; asm volatile("" : "+v"(t_)); F.tid = t_; F.lane = t_ & 63; const Args* a_ = (const Args*)__builtin_amdgcn_kernarg_segment_ptr(); asm volatile("" : "+s"(a_)); F.a = a_; } while (0)

    { REFRESH(); p0_prologue(F); }
    if constexpr (PROBE & 1) { REFRESH(); p0_prologue(F); }
    GRID_BAR();
#if DO_MIX
    { REFRESH(); SchedDense S; S.init(WSP(bfu, WS_XN), WSP(bfu, WS_WINT) + (size_t)3072 * 1024, 128, 16, 1024, 1024, 1024, G, c);
      EpiP1 E{WSP(bfu, WS_MLX), (bfu*)ARG.out}; pg8::gemm_phase<EpiP1, SchedDense, true>(ring, S, E);
#ifdef PROBE_DENSE
      pg8::gemm_phase<EpiP1, SchedDense, true>(ring, S, E);
#endif
    }
    GRID_BAR();
#if DO_ML
    if constexpr (ML_SUB & 1) { REFRESH(); p2_gates(F); }
    if constexpr (PROBE & 1) { REFRESH(); p2_gates(F); }
    GRID_BAR();
    if constexpr (ML_SUB & 2) { REFRESH(); p3_scan(F); }
    { REFRESH(); SchedDense S; S.init(WSP(bfu, SM_MEMN), WSP(bfu, WS_CAKVT), 4, 4, 1024, 1024, 1024, G, (c + G - 16) % G);
      EpiPlain E{WSP(bfu, SM_KCA), 1024}; pg8::gemm_phase<EpiPlain, SchedDense, true>(ring, S, E); }
    { REFRESH(); SchedDense S; S.init(WSP(bfu, WS_CAKVT) + (size_t)1024 * 1024, WSP(bfu, SM_MEMN), 4, 4, 1024, 1024, 1024, G, (c + G - 32) % G);
      EpiPlain E{WSP(bfu, SM_VCAT), 1024}; pg8::gemm_phase<EpiPlain, SchedDense, true>(ring, S, E); }
    if constexpr (PROBE & 1) { REFRESH(); p3_scan(F); }
    GRID_BAR();
    if constexpr (ML_SUB & 4) { REFRESH(); p4_materialise(F); }
    if constexpr (PROBE & 2) { REFRESH(); p4_materialise(F); }
    GRID_BAR();
    if constexpr (ML_SUB & 8) { REFRESH(); SchedS S; S.nt = 8; S.nt1 = 8; S.lda = 2048; S.ldb = 2048; S.lda2 = 0; S.ldb2 = 0; S.G = G; S.c = vcu; S.Q = (const char*)WSP(bfu, WS_QNAT); S.K = (const char*)WSP(bfu, WS_KNAT);
      EpiS E{WSP(bfu, WS_S), WSP(float, SM_AA), WSP(float, SM_GG), WSP(float, WS_DENP)}; pg8::gemm_phase<EpiS, SchedS, true>(ring, S, E); }
    if constexpr (ML_SUB & 16) { REFRESH(); SchedDC S; S.nt = 8; S.nt1 = 8; S.lda = LDT; S.ldb = LDT; S.lda2 = 0; S.ldb2 = 0; S.G = G; S.c = vcu; S.VT = (const char*)WSP(bfu, WS_VT); S.KT = (const char*)WSP(bfu, WS_KT);
      EpiDC E{WSP(bfu, WS_C)}; pg8::gemm_phase<EpiDC, SchedDC, true>(ring, S, E); }
    GRID_BAR();
    if constexpr (ML_SUB & 32) { REFRESH(); p6_scan_qn(F); }
    GRID_BAR();
#if KNORM_FOLD && !KNORM_EPI_OFF && CAQ_FOLD && QNORM_IN_ATTN && !NORM_PHASE_KEEP
    { REFRESH(); p11_norms(F, 0); __syncthreads(); }
#endif
    if constexpr (ML_SUB & 64) { REFRESH(); SchedOut S; S.nt = 16; S.nt1 = 8; S.lda = 2048; S.ldb = 512; S.lda2 = 2048; S.ldb2 = LDT; S.G = G; S.c = vcu; S.Q = (const char*)WSP(bfu, WS_QNAT); S.C = (const char*)WSP(bfu, WS_C); S.S = (const char*)WSP(bfu, WS_S); S.VT = (const char*)WSP(bfu, WS_VT);
      EpiOut E{WSP(bfu, WS_HH), WSP(float, SM_GG), WSP(float, SM_MM), WSP(float, WS_DEN), WSP(float, SM_QN)}; pg8::gemm_phase<EpiOut, SchedOut, true>(ring, S, E); }
    GRID_BAR();
    if ((c & 1) == 0) { if constexpr (ML_SUB & 128) { REFRESH(); p9_mlout(F, WSP(bfu, WS_HH)); }
#if CONV_AT == 10
      { REFRESH(); moe_convert(F); }
#endif
      __syncthreads(); }
    if constexpr (PROBE & 4) p9_mlout(F, WSP(bfu, WS_S));
#endif
    { REFRESH(); SchedDense S; S.init(WSP(bfu, WS_XN), WSP(bfu, WS_WINT), 128, (GATE_FP8 && !(GDIAG & 323)) ? 16 : 28, 1024, 1024, 1024, G, c); S.bskip_from = 12; S.bskip = 4096;
      EpiP10 E{WSP(bfu, WS_DAQ), WSP(bfu, WS_DAK), WSP(bfu, WS_DAV), WSP(bfu, WS_CAQ), WSP(bfu, WS_GATE), ARG.in[I_BGATE], WSP(float, WS_CASQP), ARG.in[I_DAKG], WSP(float, SM_INVF), WSP(float, SM_ROPES)}; pg8::gemm_phase<EpiP10, SchedDense, true>(ring, S, E);
#ifdef PROBE_DENSE
      pg8::gemm_phase<EpiP10, SchedDense, true>(ring, S, E);
#endif
    }
#if DO_ML
    if ((c & 1) != 0) { if constexpr (ML_SUB & 128) { REFRESH(); p9_mlout(F, WSP(bfu, WS_HH)); }
#if CONV_AT == 10
      { REFRESH(); moe_convert(F); }
#endif
    }
#endif
    GRID_BAR();
#if !(KNORM_FOLD && !KNORM_EPI_OFF && CAQ_FOLD && QNORM_IN_ATTN) || NORM_PHASE_KEEP
    { REFRESH(); p11_norms(F, 0); }
    GRID_BAR();
#endif
#if CONV_AT == 12
    if ((c & 1) == 0) { REFRESH(); moe_convert(F); if constexpr (GATE_FP8 && !(GDIAG & 64)) { REFRESH(); gate8_convert(F); } __syncthreads(); }
#endif
#if DO_DA
    { REFRESH(); const attn_body::AttnTensors AT{(const attn_body::bf16*)WSP(bfu, WS_DAQ), (const attn_body::bf16*)WSP(bfu, WS_DAK), (const attn_body::bf16*)WSP(bfu, WS_DAV), (attn_body::bf16*)WSP(bfu, WS_O), QNORM_IN_ATTN ? ARG.in[I_DAQG] : nullptr, WSP(float, SM_ROPEC), WSP(float, SM_ROPES)};
#if ATTN_V2 == 2
      const attn_body::StaticOrder2 S(G, c); attn_body::attn3_phase<attn_body::StaticOrder2>((char*)lds, AT, S);
#elif ATTN_V2 == 5
      const attn_body::StaticOrder2 S(G, c); attn_body::attn5_phase<attn_body::StaticOrder2>((char*)lds, AT, S);
#elif ATTN_V2 == 4
      const attn_body::StaticOrder2 S(G, c); attn_body::attn4_phase<attn_body::StaticOrder2>((char*)lds, AT, S);
#elif ATTN_V2
      const attn_body::StaticOrder2 S(G, c); attn_body::attn2_phase<attn_body::StaticOrder2>((char*)lds, AT, S);
#else
      const attn_body::StaticOrder S(G, c); attn_body::attn_phase<attn_body::StaticOrder>((char*)lds, AT, S);
#endif
#ifdef PROBE_ATTN
      attn_body::attn_phase<attn_body::StaticOrder>((char*)lds, AT, S);
#endif
    }
#endif
#if CONV_AT == 12
    if ((c & 1) != 0) { __syncthreads(); REFRESH(); moe_convert(F); if constexpr (GATE_FP8 && !(GDIAG & 64)) { REFRESH(); gate8_convert(F); } __syncthreads(); }
#endif
#if DO_CA
    { REFRESH(); SchedCA<0> S; S.nt = 4; S.nt1 = 4; S.lda = 1024; S.ldb = 1024; S.lda2 = 0; S.ldb2 = 0; S.G = G; S.c = c; S.A = (const char*)WSP(bfu, WS_CAQ); S.B = (const char*)WSP(bfu, SM_KCA);
      EpiCAS E{WSP(bfu, WS_CAQ), WSP(float, WS_CAROWP), WSP(float, WS_CASQP)}; pg8::gemm_phase<EpiCAS, SchedCA<0>, true>(ring, S, E); }
#endif
    GRID_BAR();
#if DO_DA
    { REFRESH(); p13_dacombine(F); }
    if constexpr (PROBE & 16) { REFRESH(); p13_dacombine(F); }
#endif
#if DO_CA
    { REFRESH(); SchedCA<1> S; S.nt = 4; S.nt1 = 4; S.lda = 1024; S.ldb = 1024; S.lda2 = 0; S.ldb2 = 0; S.G = G; S.c = c; S.A = (const char*)WSP(bfu, WS_CAQ); S.B = (const char*)WSP(bfu, SM_VCAT);
      EpiCAPV E{WSP(bfu, WS_CAQ), WSP(float, WS_CAROWP)}; pg8::gemm_phase<EpiCAPV, SchedCA<1>, true>(ring, S, E); }
#endif
#if GATE_FP8
#if GDIAG & 4
    GRID_BAR(); { REFRESH(); gate8_convert(F); __syncthreads(); } GRID_BAR();
#endif
#if (GDIAG & 16) && !(GDIAG & 128)
    { REFRESH(); SchedDense S; S.init(WSP(bfu, WS_XN), WSP(bfu, WS_WINT) + (size_t)8192 * 1024, (GDIAG & 64) ? 32 : 128, 12, 1024, 1024, 1024, G, c);
      EpiGate8 E{(GDIAG & 64) ? (bfu*)(F.ws + (size_t)952 * MiB) : WSP(bfu, WS_GATE), ARG.in[I_BGATE], 1.f, (const LAS float*)(F.lds + BIAS_OFF)}; pg8::gemm_phase<EpiGate8, SchedDense, true>(ring, S, E); }
#elif !(GDIAG & 384)
    { REFRESH(); for (int i_ = F.tid; i_ < 3072 / 4; i_ += NTHR) ((LAS f32x4*)(F.lds + BIAS_OFF))[i_] = ((const GAS f32x4*)ARG.in[I_BGATE])[i_]; __syncthreads(); }
    { REFRESH(); SchedDense8 S; S.init(WSP(unsigned char, WS_XN8), WSP(unsigned char, WS_WG8), 128, 12, 1024, 1024, 1024, G, c);
      EpiGate8 E{WSP(bfu, WS_GATE), ARG.in[I_BGATE], 1.f / 1024.f, (const LAS float*)(F.lds + BIAS_OFF)}; pg8::gemm_phase<EpiGate8, SchedDense8, true>(ring, S, E); }
#endif
#if GDIAG & 8
    GRID_BAR();
#endif
#endif
    GRID_BAR();
#if CHK == 1
    { REFRESH(); chk_region(F, F.ws + WS_GATE, (size_t)192 * MiB); }
#elif CHK == 3
    { REFRESH(); chk_region(F, F.ws + WS_DAQ, (size_t)64 * MiB); }
#elif CHK == 4
    { REFRESH(); chk_region(F, F.ws + WS_CAQ, (size_t)64 * MiB); }
#elif CHK == 5
    { REFRESH(); chk_region(F, F.ws + WS_HH, (size_t)128 * MiB); }
#elif CHK == 6
    { REFRESH(); chk_region(F, F.ws + WS_XN, (size_t)64 * MiB); }
#elif CHK == 8
    { REFRESH(); chk_region(F, F.ws + (size_t)952 * MiB, (size_t)48 * MiB); }
#elif CHK == 7
    { REFRESH(); chk_region(F, F.ws + WS_WINT, (size_t)22 * MiB); }
#endif
#if MIX_FUSED && DO_DA && DO_ML && DO_CA
#if MIX_SKEW
    if (c & 1) { for (int i_ = 0; i_ < MIX_SKEW; ++i_) __builtin_amdgcn_s_sleep(127); }
#endif
    { REFRESH(); SchedMix S; S.nt = 64; S.nt1 = 16; S.nt2 = 48; S.lda = 1024; S.ldb = 1024; S.lda2 = 2048; S.ldb2 = 2048; S.go.init(128, 4, G, c);
      S.A1 = (const char*)WSP(bfu, WS_DAQ); S.B1 = (const char*)WSP(bfu, WS_WBDAT); S.A2 = (const char*)WSP(bfu, WS_HH); S.B2 = (const char*)WSP(bfu, WS_WBMLT); S.A3 = (const char*)WSP(bfu, WS_CAQ); S.B3 = (const char*)WSP(bfu, WS_WBCAT);
      EpiMixFused E{WSP(bfu, WS_MIXBF), WSP(bfu, WS_GATE)}; pg8::gemm_phase<EpiMixFused, SchedMix, true>(ring, S, E);
      if constexpr (PROBE & 128) pg8::gemm_phase<EpiMixFused, SchedMix, true>(ring, S, E);
      if constexpr (PROBE & 512) { EpiMixProbe E2{WSP(bfu, WS_O)}; pg8::gemm_phase<EpiMixProbe, SchedMix, true>(ring, S, E2); } }
#else
    { constexpr bool F0 = true, F1 = !DO_DA, F2 = !DO_DA && !DO_ML, L0 = !DO_ML && !DO_CA, L1 = !DO_CA, L2 = true;
#if DO_DA
      { REFRESH(); SchedDense S; S.init(WSP(bfu, WS_DAQ), WSP(bfu, WS_WBDAT), 128, 4, 1024, 1024, 1024, G, c); EpiMix<F0, L0> E{ARG.out, WSP(bfu, WS_MIXBF), WSP(bfu, WS_GATE), 0}; pg8::gemm_phase<EpiMix<F0, L0>, SchedDense, true>(ring, S, E); }
#endif
#if DO_ML
      { REFRESH(); SchedDense S; S.init(WSP(bfu, WS_HH), WSP(bfu, WS_WBMLT), 128, 4, 2048, 2048, 2048, G, c); EpiMix<F1, L1> E{ARG.out, WSP(bfu, WS_MIXBF), WSP(bfu, WS_GATE), 1024}; pg8::gemm_phase<EpiMix<F1, L1>, SchedDense, true>(ring, S, E); }
#endif
#if DO_CA
      { REFRESH(); SchedDense S; S.init(WSP(bfu, WS_CAQ), WSP(bfu, WS_WBCAT), 128, 4, 1024, 1024, 1024, G, c); EpiMix<F2, L2> E{ARG.out, WSP(bfu, WS_MIXBF), WSP(bfu, WS_GATE), 2048}; pg8::gemm_phase<EpiMix<F2, L2>, SchedDense, true>(ring, S, E); }
#endif
      (void)F0; (void)F1; (void)F2; (void)L0; (void)L1; (void)L2; }
#endif
    GRID_BAR();
#if CHK == 2
    { REFRESH(); chk_region(F, F.ws + WS_MIXBF, (size_t)64 * MiB); }
#elif CHK == 1 || CHK == 3 || CHK == 4 || CHK == 5 || CHK == 6 || CHK == 7 || CHK == 8
    { REFRESH(); chk_decide(F); }
#endif
    { REFRESH(); SchedDense S; S.init(WSP(bfu, WS_MIXBF), WSP(bfu, WS_WOUTT), 128, 4, 1024, 1024, 1024, G, c); EpiWout E{ARG.in[I_X], ARG.out}; pg8::gemm_phase<EpiWout, SchedDense, true>(ring, S, E);
      if constexpr (PROBE & 256) pg8::gemm_phase<EpiWout, SchedDense, true>(ring, S, E); }
    GRID_BAR();
#if GDIAG & 128
    { REFRESH(); SchedDense S; S.init(WSP(bfu, WS_XN), WSP(bfu, WS_WINT) + (size_t)8192 * 1024, 32, 12, 1024, 1024, 1024, G, c);
#if GDIAG & 512
      EpiPlain E{(bfu*)(F.ws + (size_t)952 * MiB), 3072}; pg8::gemm_phase<EpiPlain, SchedDense, true>(ring, S, E); }
#else
      EpiGate8 E{(bfu*)(F.ws + (size_t)952 * MiB), ARG.in[I_BGATE], 1.f, (const LAS float*)(F.lds + BIAS_OFF)}; pg8::gemm_phase<EpiGate8, SchedDense, true>(ring, S, E); }
#endif
    GRID_BAR();
    { REFRESH(); chk_region(F, F.ws + (size_t)952 * MiB, (size_t)48 * MiB); }
    GRID_BAR();
    { REFRESH(); chk_decide(F); }
#endif
#if DO_MOE
#if CHK == 2
    { REFRESH(); chk_decide(F); }
#endif
    { REFRESH(); p16_router(F); }
    if constexpr (PROBE & 32) { REFRESH(); p16_router(F); }
    GRID_BAR();
    { REFRESH(); p17_slots(F); }
    if constexpr (PROBE & 32) { GRID_BAR(); { REFRESH(); p17_slots(F); } }
    GRID_BAR();
    { REFRESH(); const int* META = WSP(int, SM_META); const int NT = __builtin_amdgcn_readfirstlane(META[33]);
      { REFRESH(); SchedMoe<0> S; S.nt = 8; S.nt1 = 8; S.lda = 1024; S.ldb = 1024; S.lda2 = 0; S.ldb2 = 0; S.G = G; S.c = c; S.nunits = NT * 8; S.A = (const char*)WSP(bfu, WS_XN); S.B = (const char*)WSP(bfu, WS_WGUT); S.tile_e = META + 64; S.tok = WSP(int, SM_TOK);
        EpiGU E{WSP(unsigned char, WS_A2), ARG.in[I_BGU]}; pg8::gemm_phase<EpiGU, SchedMoe<0>, true>(ring, S, E);
#ifdef PROBE_MOE
        pg8::gemm_phase<EpiGU, SchedMoe<0>, true>(ring, S, E);
#endif
      }
      GRID_BAR();
      { REFRESH(); SchedMoe<1> S; S.nt = 8; S.nt1 = 8; S.lda = 1024; S.ldb = 1024; S.lda2 = 0; S.ldb2 = 0; S.G = G; S.c = c; S.nunits = NT * 4; S.A = (const char*)WSP(bfu, WS_A2); S.B = (const char*)WSP(bfu, WS_WDT); S.tile_e = META + 64; S.tok = WSP(int, SM_TOK);
        EpiDown E{WSP(unsigned char, WS_Y), ARG.in[I_BD], WSP(float, SM_WSRT)}; pg8::gemm_phase<EpiDown, SchedMoe<1>, true>(ring, S, E);
#ifdef PROBE_MOE
        pg8::gemm_phase<EpiDown, SchedMoe<1>, true>(ring, S, E);
#endif
      }
      GRID_BAR(); }
    if constexpr (PROBE & 64) p20_combine(F, (float*)(F.ws + WS_A2));
    { REFRESH(); p20_combine(F, ARG.out); }
#endif
#else
    { const int gt = F.bid * NTHR + F.tid, NGT = F.G * NTHR; for (int i = gt; i < T * DM / 4; i += NGT) ((GAS f32x4*)ARG.out)[i] = ((const GAS f32x4*)ARG.in[I_X])[i]; }
#endif
#undef ARG
}

extern "C" void kernel_launch(void* const* d_in, const int* in_sizes, int n_in, void* d_out, int out_size, void* d_ws, size_t ws_size, hipStream_t stream) {
    static int grid = 0;
    if (grid == 0) {
        if (n_in != 36 || in_sizes[0] != T * DM || out_size != T * DM || ws_size < WS_END) { fprintf(stderr, "kernel_launch: unexpected shapes (n_in %d, in0 %d, out %d, ws %zu); nothing launched\n", n_in, n_in > 0 ? in_sizes[0] : -1, out_size, ws_size); grid = -1; return; }
        int dev = 0, cus = 0, per_cu = 0;
        if (hipGetDevice(&dev) != hipSuccess || hipDeviceGetAttribute(&cus, hipDeviceAttributeMultiprocessorCount, dev) != hipSuccess) { grid = -1; return; }
        if (hipFuncSetAttribute((const void*)mk_fwd, hipFuncAttributeMaxDynamicSharedMemorySize, LDS_BYTES) != hipSuccess) { fprintf(stderr, "kernel_launch: hipFuncSetAttribute failed\n"); grid = -1; return; }
        if (hipOccupancyMaxActiveBlocksPerMultiprocessor(&per_cu, (const void*)mk_fwd, NTHR, LDS_BYTES) != hipSuccess || per_cu < 1) fprintf(stderr, "kernel_launch: occupancy query reports %d\n", per_cu);
        (void)hipGetLastError();
        grid = cus;
    }
    if (grid < 0) return;
    if (hipMemsetAsync((char*)d_ws + WS_CTL, 0, CTL_ZERO_BYTES, stream) != hipSuccess) return;
#if SELF_POISON
    if (hipMemsetAsync((char*)d_ws + CTL_ZERO_BYTES, 0xAA, (size_t)WS_END - CTL_ZERO_BYTES, stream) != hipSuccess) return;
#endif
    Args a{};
    for (int i = 0; i < 36; ++i) a.in[i] = (const float*)d_in[i];
    a.out = (float*)d_out; a.ws = (unsigned char*)d_ws;
    hipLaunchKernelGGL(mk_fwd, dim3(grid), dim3(NTHR), LDS_BYTES, stream, a);
}
```
